# Optimizing an MI355X kernel written in HIP

```python
import jax, jax.numpy as jnp
from jax import lax
import numpy as np

D_MODEL = 1024
BATCH = 8
SEQ = 2048
DEPTH = 1

GLA_HEADS = 4
GLA_DK = 64
GLA_DV = 128
GLA_LOWRANK = 16
GLA_GATE_NORM = 16.0
GLA_CHUNK = 64
SWA_HEADS = 8
SWA_KV_HEADS = 2
SWA_HD = 64
WINDOW = 128
ROPE_THETA = 500000.0
ROPE_DIMS = SWA_HD // 4
N_GROUPS = 4
EXPERTS_PER_GROUP = 8
TOP_K_IN_GROUP = 2
D_EXPERT = 256

EPS = 1e-6
GLA_WIDTH = GLA_HEADS * GLA_DV
SWA_WIDTH = SWA_HEADS * SWA_HD
MIX_WIDTH = GLA_WIDTH + SWA_WIDTH
IN_SIZES = (GLA_HEADS * GLA_DK,
            GLA_HEADS * GLA_DK,
            GLA_WIDTH,
            GLA_WIDTH,
            GLA_LOWRANK,
            SWA_WIDTH,
            SWA_KV_HEADS * SWA_HD,
            SWA_KV_HEADS * SWA_HD)
IN_WIDTH = sum(IN_SIZES)

kernel_name = "hymba_gla_swa_sink_hier_moe_adaln"


def rmsnorm(x, g):
    x32 = x.astype(jnp.float32)
    y = x32 * lax.rsqrt(jnp.mean(x32 * x32, axis=-1, keepdims=True) + EPS)
    return y.astype(x.dtype) * g


def rope_tables(positions):
    inv_freq = ROPE_THETA ** (-jnp.arange(0, ROPE_DIMS, 2, dtype=jnp.float32) / ROPE_DIMS)
    ang = positions.astype(jnp.float32)[..., None] * inv_freq
    return jnp.cos(ang)[:, :, None, :], jnp.sin(ang)[:, :, None, :]


def partial_rope(x, cos, sin):
    half = ROPE_DIMS // 2
    x32 = x.astype(jnp.float32)
    x1, x2, rest = x32[..., :half], x32[..., half:ROPE_DIMS], x32[..., ROPE_DIMS:]
    out = jnp.concatenate([x1 * cos - x2 * sin, x2 * cos + x1 * sin, rest], axis=-1)
    return out.astype(x.dtype)


def gla_mixer(q, k, v, g_out, a_low, w_a2, b_a2, gn_gain):
    B, S = q.shape[:2]
    nc, C, H, dk, dv = S // GLA_CHUNK, GLA_CHUNK, GLA_HEADS, GLA_DK, GLA_DV
    f32 = jnp.float32
    log_a = jax.nn.log_sigmoid((a_low @ w_a2 + b_a2).astype(f32)) / GLA_GATE_NORM
    log_a = log_a.reshape(B, nc, C, H, dk)
    qc = q.astype(f32).reshape(B, nc, C, H, dk) * (dk ** -0.5)
    kc = k.astype(f32).reshape(B, nc, C, H, dk)
    vc = v.astype(f32).reshape(B, nc, C, H, dv)
    b = jnp.cumsum(log_a, axis=2)
    b_last = b[:, :, -1:]
    q_dec = qc * jnp.exp(b)
    k_dec = kc * jnp.exp(-b)
    causal = jnp.tril(jnp.ones((C, C), dtype=bool))
    scores = jnp.einsum('bnthd,bnshd->bnhts', q_dec, k_dec)
    scores = jnp.where(causal, scores, 0.0)
    o_intra = jnp.einsum('bnhts,bnshe->bnthe', scores, vc)
    kv = jnp.einsum('bnshd,bnshe->bnhde', kc * jnp.exp(b_last - b), vc)
    decay = jnp.exp(b_last[:, :, 0])

    def step(state, inp):
        kv_n, dec_n = inp
        return dec_n[..., None] * state + kv_n, state

    s0 = jnp.zeros((B, H, dk, dv), f32)
    _, s_prev = lax.scan(step, s0, (jnp.moveaxis(kv, 1, 0), jnp.moveaxis(decay, 1, 0)))
    s_prev = jnp.moveaxis(s_prev, 0, 1)
    o_inter = jnp.einsum('bnthd,bnhde->bnthe', q_dec, s_prev)
    o = (o_intra + o_inter).reshape(B, S, H, dv)
    o = rmsnorm(o, gn_gain)
    o = o * jax.nn.silu(g_out.astype(f32).reshape(B, S, H, dv))
    return o.reshape(B, S, H * dv).astype(q.dtype)


def swa_sink_mixer(q, k, v, sinks, cos, sin):
    B, S = q.shape[:2]
    W, hd, Hkv = WINDOW, SWA_HD, SWA_KV_HEADS
    G = SWA_HEADS // Hkv
    nb = S // W
    q = partial_rope(q.reshape(B, S, SWA_HEADS, hd), cos, sin)
    k = partial_rope(k.reshape(B, S, Hkv, hd), cos, sin)
    qb = q.reshape(B, nb, W, Hkv, G, hd) * (hd ** -0.5)
    kb = k.reshape(B, nb, W, Hkv, hd)
    vb = v.reshape(B, nb, W, Hkv, hd)
    pad = ((0, 0), (1, 0), (0, 0), (0, 0), (0, 0))
    kk = jnp.concatenate([jnp.pad(kb, pad)[:, :-1], kb], axis=2)
    vv = jnp.concatenate([jnp.pad(vb, pad)[:, :-1], vb], axis=2)
    scores = jnp.einsum('bnqkgd,bnskd->bnkgqs', qb, kk).astype(jnp.float32)
    q_pos = jnp.arange(W)[:, None] + W
    k_pos = jnp.arange(2 * W)[None, :]
    rel = q_pos - k_pos
    band = (rel >= 0) & (rel < W)
    blk = jnp.arange(nb)[:, None, None]
    valid = band[None] & ((blk > 0) | (k_pos[None] >= W))
    scores = jnp.where(valid[None, :, None, None], scores, -jnp.inf)
    sink = jnp.broadcast_to(sinks.astype(jnp.float32).reshape(Hkv, G)[None, None, :, :, None, None],
                            scores.shape[:-1] + (1,))
    probs = jax.nn.softmax(jnp.concatenate([scores, sink], axis=-1), axis=-1)[..., :-1]
    out = jnp.einsum('bnkgqs,bnskd->bnqkgd', probs.astype(vv.dtype), vv)
    return out.reshape(B, S, SWA_HEADS * hd)


def hier_moe(h, w_grp, b_grp, w_exp, b_exp, w_gate, w_up, w_down):
    T = h.shape[0]
    grp_logits = (h @ w_grp + b_grp).astype(jnp.float32)
    grp_prob = jax.nn.softmax(grp_logits, axis=-1)
    grp_idx = jnp.argmax(grp_logits, axis=-1)
    grp_gate = jnp.take_along_axis(grp_prob, grp_idx[:, None], axis=1)[:, 0]
    exp_logits = (h @ w_exp + b_exp).astype(jnp.float32).reshape(T, N_GROUPS, EXPERTS_PER_GROUP)
    sel_logits = jnp.take_along_axis(exp_logits, grp_idx[:, None, None], axis=1)[:, 0]
    top_vals, top_idx = lax.top_k(sel_logits, TOP_K_IN_GROUP)
    top_w = jax.nn.softmax(top_vals, axis=-1) * grp_gate[:, None]
    within = jnp.sum(jax.nn.one_hot(top_idx, EXPERTS_PER_GROUP, dtype=jnp.float32) * top_w[..., None], axis=1)
    combine = (jax.nn.one_hot(grp_idx, N_GROUPS, dtype=jnp.float32)[:, :, None] * within[:, None, :]).astype(h.dtype)
    out = jnp.zeros_like(h)
    for gi in range(N_GROUPS):
        a = jnp.einsum('td,edf->tef', h, w_gate[gi])
        u = jnp.einsum('td,edf->tef', h, w_up[gi])
        act = jax.nn.silu(a) * u * combine[:, gi, :, None]
        out = out + jnp.einsum('tef,efd->td', act, w_down[gi])
    return out


def setup_inputs(seed: int = 0) -> dict:
    key = jax.random.key(seed)
    ks = jax.random.split(key, 24)
    D, L = D_MODEL, DEPTH
    nrm = lambda k, shape, s: jax.random.normal(k, shape, jnp.float32) * s
    return {
        "x": nrm(ks[0], (BATCH, SEQ, D), 1.0),
        "c": nrm(ks[1], (BATCH, D), 1.0),
        "positions": (jnp.arange(SEQ, dtype=jnp.int32)[None, :]
                      + jax.random.randint(ks[2], (BATCH, 1), 0, 1024, dtype=jnp.int32)),
        "ada_w": nrm(ks[3], (L, D, 6 * D), D ** -0.5),
        "ada_b": nrm(ks[4], (L, 6 * D), 0.02),
        "norm_mix_g": 1.0 + nrm(ks[5], (L, D), 0.02),
        "w_in": nrm(ks[6], (L, D, IN_WIDTH), D ** -0.5),
        "gla_w_a2": nrm(ks[7], (L, GLA_LOWRANK, GLA_HEADS * GLA_DK), GLA_LOWRANK ** -0.5),
        "gla_b_a2": nrm(ks[8], (L, GLA_HEADS * GLA_DK), 0.02),
        "gla_norm_g": 1.0 + nrm(ks[9], (L, GLA_HEADS, GLA_DV), 0.02),
        "swa_sinks": nrm(ks[10], (L, SWA_HEADS), 0.5),
        "w_out": nrm(ks[11], (L, MIX_WIDTH, D), MIX_WIDTH ** -0.5),
        "norm_ffn_g": 1.0 + nrm(ks[12], (L, D), 0.02),
        "w_grp": nrm(ks[13], (L, D, N_GROUPS), D ** -0.5),
        "b_grp": nrm(ks[14], (L, N_GROUPS), 0.01),
        "w_exp": nrm(ks[15], (L, D, N_GROUPS * EXPERTS_PER_GROUP), D ** -0.5),
        "b_exp": nrm(ks[16], (L, N_GROUPS * EXPERTS_PER_GROUP), 0.01),
        "w_gate": nrm(ks[17], (L, N_GROUPS, EXPERTS_PER_GROUP, D, D_EXPERT), D ** -0.5),
        "w_up": nrm(ks[18], (L, N_GROUPS, EXPERTS_PER_GROUP, D, D_EXPERT), D ** -0.5),
        "w_down": nrm(ks[19], (L, N_GROUPS, EXPERTS_PER_GROUP, D_EXPERT, D), D_EXPERT ** -0.5),
        "final_norm_g": 1.0 + nrm(ks[20], (D,), 0.02),
    }


def reference(x, c, positions, ada_w, ada_b, norm_mix_g, w_in, gla_w_a2, gla_b_a2, gla_norm_g,
              swa_sinks, w_out, norm_ffn_g, w_grp, b_grp, w_exp, b_exp, w_gate, w_up, w_down,
              final_norm_g):
    B, S, D = x.shape
    cos, sin = rope_tables(positions)
    c_act = jax.nn.silu(c)
    split_pts = [int(p) for p in np.cumsum(IN_SIZES)[:-1]]
    for l in range(DEPTH):
        mod = (c_act @ ada_w[l] + ada_b[l])[:, None, :]
        sh_a, sc_a, gt_a, sh_f, sc_f, gt_f = jnp.split(mod, 6, axis=-1)
        h = rmsnorm(x, norm_mix_g[l]) * (1.0 + sc_a) + sh_a
        proj = h @ w_in[l]
        g_q, g_k, g_v, g_g, g_a, s_q, s_k, s_v = jnp.split(proj, split_pts, axis=-1)
        o_gla = gla_mixer(g_q, g_k, g_v, g_g, g_a, gla_w_a2[l], gla_b_a2[l], gla_norm_g[l])
        o_swa = swa_sink_mixer(s_q, s_k, s_v, swa_sinks[l], cos, sin)
        mix = jnp.concatenate([o_gla, o_swa], axis=-1) @ w_out[l]
        x = x + gt_a * mix
        h = rmsnorm(x, norm_ffn_g[l]) * (1.0 + sc_f) + sh_f
        y = hier_moe(h.reshape(B * S, D), w_grp[l], b_grp[l], w_exp[l], b_exp[l],
                     w_gate[l], w_up[l], w_down[l]).reshape(B, S, D)
        x = x + gt_f * y
    return rmsnorm(x, final_norm_g)
```

```cpp
#include <hip/hip_runtime.h>
#include <cstdio>
#include <cstdint>
#include <cmath>

typedef unsigned short bf16;
typedef float f32x4 __attribute__((ext_vector_type(4)));
typedef float f32x2 __attribute__((ext_vector_type(2)));
typedef float f32x16 __attribute__((ext_vector_type(16)));
typedef unsigned u32x4 __attribute__((ext_vector_type(4)));
typedef unsigned u32x2 __attribute__((ext_vector_type(2)));
typedef short bf16x8 __attribute__((ext_vector_type(8)));
#define GAS __attribute__((address_space(1)))
#define LAS __attribute__((address_space(3)))

__device__ __forceinline__ float bf2f(bf16 v) { return __uint_as_float(((unsigned)v) << 16); }
__device__ __forceinline__ unsigned f2bf(float f) { unsigned u = __float_as_uint(f); return (u + 0x7fffu + ((u >> 16) & 1u)) >> 16; }
typedef float f32x2_t __attribute__((ext_vector_type(2))); typedef __bf16 bf16x2_t __attribute__((ext_vector_type(2)));
__device__ __forceinline__ unsigned pk2(float lo, float hi) { const f32x2_t v = {lo, hi}; const bf16x2_t b = __builtin_convertvector(v, bf16x2_t); return __builtin_bit_cast(unsigned, b); }
__device__ __forceinline__ float lo_bf16(unsigned w) { return __uint_as_float(w << 16); }
__device__ __forceinline__ float hi_bf16(unsigned w) { return __uint_as_float(w & 0xffff0000u); }
__device__ __forceinline__ float silu_f(float v) { return v / (1.f + __expf(-v)); }
template <int CTRL> __device__ __forceinline__ float dpp_mov(float v) { return __int_as_float(__builtin_amdgcn_update_dpp(0, __float_as_int(v), CTRL, 0xF, 0xF, true)); }
__device__ __forceinline__ float wave_sum(float v) {
    v += dpp_mov<0xB1>(v); v += dpp_mov<0x4E>(v); v += dpp_mov<0x141>(v); v += dpp_mov<0x140>(v);
    const float r0 = __int_as_float(__builtin_amdgcn_readlane(__float_as_int(v), 0)), r1 = __int_as_float(__builtin_amdgcn_readlane(__float_as_int(v), 16));
    const float r2 = __int_as_float(__builtin_amdgcn_readlane(__float_as_int(v), 32)), r3 = __int_as_float(__builtin_amdgcn_readlane(__float_as_int(v), 48));
    return (r0 + r1) + (r2 + r3);
}

constexpr int NB = 8, SEQ = 2048, D = 1024, M = NB * SEQ;
constexpr int PW = 2560;
constexpr int C_GQ = 0, C_GK = 256, C_GV = 512, C_GG = 1024, C_SQ = 1536, C_SK = 2048, C_SV = 2176, C_Z = 2304;
constexpr int INW = 2320;
constexpr float EPS = 1e-6f;
constexpr int NEXP = 32, LCAP = 16384;
constexpr int NWAVES = 8, NTHR = 512, GRID = 256;

constexpr size_t MiB = 1u << 20;
constexpr size_t WS_CTL = 0, CTL_ZERO_BYTES = 256 * 1024;
constexpr int CW_CNT = 0, CW_BAR = 4096;
constexpr size_t WS_MODP = 1 * MiB;
constexpr size_t WS_MOD = 2 * MiB + 512 * 1024;
constexpr size_t WS_ROPE = 3 * MiB;
constexpr size_t WS_WIN = 4 * MiB;
constexpr size_t WS_WOUT = 10 * MiB;
constexpr size_t WS_WGU = 12 * MiB;
constexpr size_t WS_WD = 44 * MiB;
constexpr size_t WS_ROUTE = 60 * MiB;
constexpr size_t WS_H = 64 * MiB;
constexpr size_t WS_SG = 208 * MiB;
constexpr size_t WS_O = 96 * MiB;
constexpr size_t WS_PROJ = 128 * MiB;
constexpr size_t WS_X1 = 160 * MiB;
constexpr size_t WS_Y2 = 64 * MiB;
constexpr size_t WS_DEC = 224 * MiB;
constexpr size_t WS_KVG = 225 * MiB;
constexpr size_t WS_DECG = 229 * MiB;
constexpr size_t WS_WRB = 230 * MiB;
constexpr size_t WS_END = 231 * MiB;

constexpr int LDS_BYTES = 163840;
constexpr int MISC_OFF = LDS_BYTES - 512;
namespace pg8 {
#define PG8_LAS __attribute__((address_space(3)))
constexpr int BM = 256, BK = 64, HALF = 128, HTB = HALF * BK * 2  , STAGE_BYTES = 8 * HTB, NXCD = 8, WGM = 8;

__host__ __device__ __forceinline__ int lds_byte(int r, int c) { const int st = (r >> 4) * 2 + (c >> 5), rr = r & 15, cc = c & 31, ob = rr * 64 + cc * 2; return st * 1024 + (ob ^ (((ob >> 9) & 1) << 5)); }
__host__ __device__ __forceinline__ void stage_rc(int b, int& R, int& C) { const int st = b / 1024, sb = b % 1024, swz = sb ^ (((sb >> 9) & 1) << 5); R = (st >> 1) * 16 + swz / 64; C = (st & 1) * 32 + (swz % 64) / 2; }
__host__ __device__ __forceinline__ int perm32(int rho) { const int n = rho >> 4, i = rho & 15; return 8 * (i >> 2) + 4 * n + (i & 3); }

struct Unit { const char* A; const char* B; int i0, i1, i2, qm; };

__device__ __forceinline__ int xcd_remap(int wgid, int nwg) { const int q = nwg / NXCD, r = nwg % NXCD, xcd = wgid % NXCD, off = wgid / NXCD; return (xcd < r ? xcd * (q + 1) : r * (q + 1) + (xcd - r) * q) + off; }

struct DenseOrder {
    const char* A; const char* Bt; int K, nM, nN, nwg, G, c;
    __device__ void init(const void* A_, const void* Bt_, int M, int N, int K_, int G_, int c_) { A = (const char*)A_; Bt = (const char*)Bt_; K = K_; nM = M / BM; nN = N / BM; nwg = nM * nN; G = G_; c = c_; }
    __device__ __forceinline__ bool next(int i, Unit& u) const {
        const int L = i * G + c; if (L >= nwg) return false;
        const int wgid = xcd_remap(L, nwg);
        const int nig = WGM * nN, gid = wgid / nig, fm = gid * WGM, gsz = (nM - fm) < WGM ? (nM - fm) : WGM;
        const int pm = fm + ((wgid % nig) % gsz), pn = (wgid % nig) / gsz;
        u.A = A + (size_t)pm * BM * K * 2; u.B = Bt + (size_t)pn * BM * K * 2; u.i0 = pm; u.i1 = pn; u.i2 = 0; u.qm = 15; return true;
    }
    __device__ __forceinline__ void a_voff(const Unit&, const int (&R)[2], const int (&C)[2], unsigned (&v)[2][2]) const {
#pragma unroll
        for (int h = 0; h < 2; ++h)
#pragma unroll
            for (int i = 0; i < 2; ++i) v[h][i] = (unsigned)((h * HALF + R[i]) * K + C[i]) * 2u;
    }
};

template <bool GATHER> struct MoeOrder {
    const char* A; const char* Bt; int K, npn, G, c; size_t bstride; const PG8_LAS int* tp; const int* cnt; const int* list;
    __device__ __forceinline__ bool next(int i, Unit& u) const {
        const int ntile = tp[32], nwg = ntile * npn, nfr = nwg / G, nfull = nfr * G, R = nwg - nfull, f = (4 * R <= G) ? 4 : (2 * R <= G) ? 2 : 1;
        int L, qm;
        if (i < nfr) { L = i * G + c; qm = 15; }
        else { if (i > nfr) return false;
            const int P = (f * R + 7) >> 3, x = c & 7, y = c >> 3, j = x * P + y;
            if (y >= P || j >= f * R) return false; L = nfull + j / f; qm = f == 4 ? (1 << (j & 3)) : f == 2 ? ((j & 1) ? 10 : 5) : 15; }
        u.qm = __builtin_amdgcn_readfirstlane(qm);
        const int wgid = xcd_remap(L, nwg); const int T = wgid / npn, pn = wgid % npn;
        const int e = tp[40 + T];
        u.i0 = e; u.i1 = T - tp[e]; u.i2 = pn;
        u.A = GATHER ? A : A + (size_t)T * BM * K * 2; u.B = Bt + (size_t)e * bstride + (size_t)pn * BM * K * 2; return true;
    }
    __device__ __forceinline__ void a_voff(const Unit& u, const int (&R)[2], const int (&C)[2], unsigned (&v)[2][2]) const {
        if (GATHER) {
            const int n = cnt[u.i0]; int tk[2][2];
#pragma unroll
            for (int h = 0; h < 2; ++h)
#pragma unroll
                for (int i = 0; i < 2; ++i) { const int r = u.i1 * BM + h * HALF + R[i]; tk[h][i] = (r < n) ? list[u.i0 * 16384 + r] : 0; }
            asm volatile("s_waitcnt vmcnt(0)" ::: "memory");
#pragma unroll
            for (int h = 0; h < 2; ++h)
#pragma unroll
                for (int i = 0; i < 2; ++i) v[h][i] = (unsigned)((tk[h][i] >> 1) * K + C[i]) * 2u;
            asm volatile("" : "+v"(v[0][0]), "+v"(v[0][1]), "+v"(v[1][0]), "+v"(v[1][1]));
        } else {
#pragma unroll
            for (int h = 0; h < 2; ++h)
#pragma unroll
                for (int i = 0; i < 2; ++i) v[h][i] = (unsigned)((h * HALF + R[i]) * K + C[i]) * 2u;
        }
    }
};

__device__ __forceinline__ unsigned cvt_pk_bf16(float lo, float hi) { unsigned r; asm volatile("v_cvt_pk_bf16_f32 %0, %1, %2" : "=v"(r) : "v"(lo), "v"(hi)); return r; }

struct EpiBf16 {
    static constexpr bool PERM = true;
    bf16* O; int ldc;
    __device__ __forceinline__ void operator()(const f32x4 (&acc)[2][2][4][2], const Unit& u, int wr, int wc, int fr, int fq) const {
        const int row0 = u.i0 * BM + wr * 64 + fr; const int col0 = u.i1 * BM + wc * 32 + 8 * fq;
#pragma unroll
        for (int ai = 0; ai < 2; ++ai)
#pragma unroll
            for (int m = 0; m < 4; ++m) { bf16* rowp = O + (size_t)(row0 + ai * HALF + m * 16) * ldc + col0;
#pragma unroll
                for (int bj = 0; bj < 2; ++bj) { const f32x4 v0 = acc[ai][bj][m][0], v1 = acc[ai][bj][m][1];
                    u32x4 w; w.x = cvt_pk_bf16(v0[0], v0[1]); w.y = cvt_pk_bf16(v0[2], v0[3]); w.z = cvt_pk_bf16(v1[0], v1[1]); w.w = cvt_pk_bf16(v1[2], v1[3]);
                    *(u32x4*)(rowp + bj * HALF) = w; } }
    }
};

struct EpiX1 {
    static constexpr bool PERM = true;
    const float* x; bf16* out; const float* mod;
    __device__ __forceinline__ void operator()(const f32x4 (&acc)[2][2][4][2], const Unit& u, int wr, int wc, int fr, int fq) const {
        const int row0 = u.i0 * BM + wr * 64 + fr; const int col0 = u.i1 * BM + wc * 32 + 8 * fq;
        const float* gt = mod + (u.i0 >> 3) * 6144 + 2048;
        f32x4 gv[2][2];
#pragma unroll
        for (int bj = 0; bj < 2; ++bj)
#pragma unroll
            for (int n = 0; n < 2; ++n) gv[bj][n] = *(const f32x4*)(gt + col0 + bj * HALF + 4 * n);
#pragma unroll
        for (int ai = 0; ai < 2; ++ai) {
            f32x4 xv[4][2][2];
#pragma unroll
            for (int m = 0; m < 4; ++m) { const size_t off = (size_t)(row0 + ai * HALF + m * 16) * 1024 + col0;
#pragma unroll
                for (int bj = 0; bj < 2; ++bj) { xv[m][bj][0] = *(const f32x4*)(x + off + bj * HALF); xv[m][bj][1] = *(const f32x4*)(x + off + bj * HALF + 4); } }
            asm volatile("" ::: "memory");
#pragma unroll
            for (int m = 0; m < 4; ++m) { const size_t off = (size_t)(row0 + ai * HALF + m * 16) * 1024 + col0;
#pragma unroll
                for (int bj = 0; bj < 2; ++bj) { const f32x4 v0 = xv[m][bj][0] + gv[bj][0] * acc[ai][bj][m][0], v1 = xv[m][bj][1] + gv[bj][1] * acc[ai][bj][m][1];
                    u32x4 w; w.x = cvt_pk_bf16(v0[0], v0[1]); w.y = cvt_pk_bf16(v0[2], v0[3]); w.z = cvt_pk_bf16(v1[0], v1[1]); w.w = cvt_pk_bf16(v1[2], v1[3]);
                    *(u32x4*)(out + off + bj * HALF) = w; } }
        }
    }
};

struct EpiAct {
    static constexpr bool PERM = false;
    bf16* act; const int* cnt; const float* lw; const PG8_LAS int* tp;
    __device__ __forceinline__ void operator()(const f32x4 (&acc)[2][2][4][2], const Unit& u, int wr, int wc, int fr, int fq) const {
        const int e = u.i0, n_e = cnt[e]; const int rl0 = u.i1 * BM + wr * 64 + fr; const size_t rbase = (size_t)(tp[e] + u.i1) * BM + wr * 64 + fr;
        const int f0 = u.i2 * 128 + wc * 16 + 4 * fq;
        float wrow[2][4];
#pragma unroll
        for (int ai = 0; ai < 2; ++ai)
#pragma unroll
            for (int m = 0; m < 4; ++m) { const int rl = rl0 + ai * HALF + m * 16; wrow[ai][m] = (rl < n_e) ? lw[e * 16384 + rl] : 0.f; }
        asm volatile("" ::: "memory");
#pragma unroll
        for (int ai = 0; ai < 2; ++ai)
#pragma unroll
            for (int m = 0; m < 4; ++m) { const int rl = rl0 + ai * HALF + m * 16;
                if (rl < n_e) { const float w = wrow[ai][m]; bf16* rowp = act + (rbase + ai * HALF + m * 16) * 256 + f0;
#pragma unroll
                    for (int bj = 0; bj < 2; ++bj) if ((u.qm >> (2 * ai + bj)) & 1) { const f32x4 g = acc[ai][bj][m][0], up = acc[ai][bj][m][1]; u32x2 o;
                        o.x = cvt_pk_bf16(silu_f(g[0]) * up[0] * w, silu_f(g[1]) * up[1] * w); o.y = cvt_pk_bf16(silu_f(g[2]) * up[2] * w, silu_f(g[3]) * up[3] * w);
                        *(u32x2*)(rowp + bj * 64) = o; } } }
    }
};

struct EpiDown {
    static constexpr bool PERM = true;
    bf16* y2; const int* cnt; const int* list;
    __device__ __forceinline__ void operator()(const f32x4 (&acc)[2][2][4][2], const Unit& u, int wr, int wc, int fr, int fq) const {
        const int e = u.i0, n_e = cnt[e]; const int rl0 = u.i1 * BM + wr * 64 + fr; const int col0 = u.i2 * BM + wc * 32 + 8 * fq;
        int tkr[2][4];
#pragma unroll
        for (int ai = 0; ai < 2; ++ai)
#pragma unroll
            for (int m = 0; m < 4; ++m) { const int rl = rl0 + ai * HALF + m * 16; tkr[ai][m] = (rl < n_e) ? list[e * 16384 + rl] : -1; }
        asm volatile("" ::: "memory");
#pragma unroll
        for (int ai = 0; ai < 2; ++ai)
#pragma unroll
            for (int m = 0; m < 4; ++m) { const int tk = tkr[ai][m];
                if (tk >= 0) { bf16* rowp = y2 + (size_t)tk * 1024 + col0;
#pragma unroll
                    for (int bj = 0; bj < 2; ++bj) if ((u.qm >> (2 * ai + bj)) & 1) { const f32x4 v0 = acc[ai][bj][m][0], v1 = acc[ai][bj][m][1];
                        u32x4 w; w.x = cvt_pk_bf16(v0[0], v0[1]); w.y = cvt_pk_bf16(v0[2], v0[3]); w.z = cvt_pk_bf16(v1[0], v1[1]); w.w = cvt_pk_bf16(v1[2], v1[3]);
                        *(u32x4*)(rowp + bj * HALF) = w; } } }
    }
};

template <class Epi, class Sched, bool ALIGN_EPI>
__device__ __forceinline__ void gemm_phase(PG8_LAS unsigned char* lds, const int K, const Sched& S, const Epi& E) {
    const int tid = threadIdx.x, wid = __builtin_amdgcn_readfirstlane(tid >> 6), lane = tid & 63, wr = wid >> 2, wc = wid & 3, fr = lane & 15, fq = lane >> 4;
    const int nt = K / BK;
    int Rr[2], Cc[2]; unsigned voffB[2];
#pragma unroll
    for (int i = 0; i < 2; ++i) { int R, C; stage_rc(tid * 16 + i * 8192, R, C); Rr[i] = R; Cc[i] = C; const int Rb = Epi::PERM ? ((R & ~31) + perm32(R & 31)) : R; voffB[i] = (unsigned)(Rb * K + C) * 2u; }
    const size_t kstep = (size_t)(BK * 2);
    const size_t hstep = (size_t)HALF * K * 2;
    const unsigned ldsw = (unsigned)wid * 1024u;
    const int aoff = lds_byte(wr * 64 + fr, fq * 8), boff = lds_byte(wc * 32 + fr, fq * 8);
#define PG8_SA(b, h) (((b) * 2 + (h)) * HTB)
#define PG8_SB(b, h) ((4 + (b) * 2 + (h)) * HTB)
#define PG8_STG(bufoff, gbase, v0, v1) do { \
        __builtin_amdgcn_global_load_lds((const unsigned*)((const char*)(gbase) + (v0)), (PG8_LAS unsigned*)(lds + (bufoff) + ldsw), 16, 0, 0); \
        __builtin_amdgcn_global_load_lds((const unsigned*)((const char*)(gbase) + (v1)), (PG8_LAS unsigned*)(lds + (bufoff) + ldsw + 8192), 16, 0, 0); } while (0)
#define PG8_STGB(bufoff, gbase) PG8_STG(bufoff, gbase, voffB[0], voffB[1])
#define PG8_LDA(dst, b, h) do { _Pragma("unroll") for (int m = 0; m < 4; ++m) _Pragma("unroll") for (int k = 0; k < 2; ++k) dst[m][k] = *(const PG8_LAS bf16x8*)(lds + PG8_SA(b, h) + aoff + m * 2048 + k * 1024); } while (0)
#define PG8_LDB(dst, b, h) do { _Pragma("unroll") for (int n = 0; n < 2; ++n) _Pragma("unroll") for (int k = 0; k < 2; ++k) dst[n][k] = *(const PG8_LAS bf16x8*)(lds + PG8_SB(b, h) + boff + n * 2048 + k * 1024); } while (0)
#define PG8_MMA(ai, bj, At, Bt) do { __builtin_amdgcn_s_setprio(1); _Pragma("unroll") for (int m = 0; m < 4; ++m) _Pragma("unroll") for (int n = 0; n < 2; ++n) _Pragma("unroll") for (int k = 0; k < 2; ++k) \
        acc[ai][bj][m][n] = __builtin_amdgcn_mfma_f32_16x16x32_bf16(Bt[n][k], At[m][k], acc[ai][bj][m][n], 0, 0, 0); __builtin_amdgcn_s_setprio(0); } while (0)
#define PG8_WAIT_V(n) asm volatile("s_waitcnt vmcnt(" #n ")" ::: "memory")
#define PG8_WAIT_L(n) asm volatile("s_waitcnt lgkmcnt(" #n ")" ::: "memory")
#define PG8_BAR __builtin_amdgcn_s_barrier()
#define PG8_SCHED __builtin_amdgcn_sched_barrier(0)
    Unit cur, nxt; int ui = 0;
    if (!S.next(0, cur)) return;
    unsigned cv[2][2], nv[2][2];
    S.a_voff(cur, Rr, Cc, cv);
#define PG8_QFIX(qm, v) do { if (!((qm) & 3)) { v[0][0] = v[1][0]; v[0][1] = v[1][1]; } if (!((qm) & 12)) { v[1][0] = v[0][0]; v[1][1] = v[0][1]; } } while (0)
    PG8_QFIX(cur.qm, cv);
    size_t chb0 = (cur.qm & 5) ? 0 : hstep, chb1 = (cur.qm & 10) ? hstep : 0;
    f32x4 acc[2][2][4][2];
#pragma unroll
    for (int a = 0; a < 2; ++a)
#pragma unroll
        for (int b = 0; b < 2; ++b)
#pragma unroll
            for (int m = 0; m < 4; ++m)
#pragma unroll
                for (int n = 0; n < 2; ++n) acc[a][b][m][n] = (f32x4){0.f, 0.f, 0.f, 0.f};
    bf16x8 At[4][2], B0[2][2], B1[2][2];
    const char* cA = cur.A; const char* cB = cur.B;
    PG8_STGB(PG8_SB(0, 0), cB + chb0); PG8_STGB(PG8_SB(0, 1), cB + chb1); PG8_STG(PG8_SA(0, 0), cA, cv[0][0], cv[0][1]); PG8_STG(PG8_SA(0, 1), cA, cv[1][0], cv[1][1]);
    if (wr == 1) PG8_BAR;
    PG8_WAIT_V(2); PG8_BAR;
    PG8_STGB(PG8_SB(1, 0), cB + chb0 + kstep); PG8_STG(PG8_SA(1, 0), cA + kstep, cv[0][0], cv[0][1]); PG8_STGB(PG8_SB(1, 1), cB + chb1 + kstep);
    PG8_WAIT_V(6); PG8_BAR;
    for (;;) {
        const bool has_next = S.next(ui + 1, nxt);
        if (has_next) { S.a_voff(nxt, Rr, Cc, nv); PG8_QFIX(nxt.qm, nv); }
        else { nv[0][0] = cv[0][0]; nv[0][1] = cv[0][1]; nv[1][0] = cv[1][0]; nv[1][1] = cv[1][1]; }
        const char* nA = has_next ? nxt.A : cA; const char* nB = has_next ? nxt.B : cB;
        const size_t nhb0 = has_next ? ((nxt.qm & 5) ? 0 : hstep) : chb0, nhb1 = has_next ? ((nxt.qm & 10) ? hstep : 0) : chb1;
        const bool q00 = cur.qm & 1, q01 = cur.qm & 2, q10 = cur.qm & 4, q11 = cur.qm & 8;
#pragma unroll 1
        for (int t = 0; t < nt; t += 2) {
            const bool last = (t == nt - 2);
            const char* a1 = cA + (size_t)(t + 1) * kstep;
            const char* a2 = last ? nA : cA + (size_t)(t + 2) * kstep; const char* b2 = last ? nB : cB + (size_t)(t + 2) * kstep;
            const char* a3 = a2 + kstep; const char* b3 = b2 + kstep;
            const size_t h0 = last ? nhb0 : chb0, h1 = last ? nhb1 : chb1;
            const unsigned x00 = last ? nv[0][0] : cv[0][0], x01 = last ? nv[0][1] : cv[0][1], x10 = last ? nv[1][0] : cv[1][0], x11 = last ? nv[1][1] : cv[1][1];
            PG8_LDB(B0, 0, 0); PG8_LDB(B1, 0, 1); PG8_SCHED; PG8_LDA(At, 0, 0); PG8_STG(PG8_SA(1, 1), a1, cv[1][0], cv[1][1]);
            PG8_WAIT_V(8); PG8_WAIT_L(0); PG8_BAR; if (q00) PG8_MMA(0, 0, At, B0); if (q01) PG8_MMA(0, 1, At, B1); PG8_BAR; PG8_SCHED;
            PG8_LDA(At, 0, 1); PG8_STGB(PG8_SB(0, 0), b2 + h0); PG8_STGB(PG8_SB(0, 1), b2 + h1); PG8_STG(PG8_SA(0, 0), a2, x00, x01);
            PG8_WAIT_V(8); PG8_WAIT_L(0); PG8_BAR; if (q10) PG8_MMA(1, 0, At, B0); if (q11) PG8_MMA(1, 1, At, B1); PG8_BAR; PG8_SCHED;
            PG8_LDB(B0, 1, 0); PG8_LDB(B1, 1, 1); PG8_SCHED; PG8_LDA(At, 1, 0); PG8_STG(PG8_SA(0, 1), a2, x10, x11);
            PG8_WAIT_V(8); PG8_WAIT_L(0); PG8_BAR; if (q00) PG8_MMA(0, 0, At, B0); if (q01) PG8_MMA(0, 1, At, B1); PG8_BAR; PG8_SCHED;
            PG8_LDA(At, 1, 1); PG8_STGB(PG8_SB(1, 0), b3 + h0); PG8_STGB(PG8_SB(1, 1), b3 + h1); PG8_STG(PG8_SA(1, 0), a3, x00, x01);
            PG8_WAIT_V(8); PG8_WAIT_L(0); PG8_BAR; if (q10) PG8_MMA(1, 0, At, B0); if (q11) PG8_MMA(1, 1, At, B1); PG8_BAR; PG8_SCHED;
        }
        if constexpr (ALIGN_EPI) { if (wr == 0) PG8_BAR; }
        E(acc, cur, wr, wc, fr, fq);
        if (!has_next) break;
#pragma unroll
        for (int a = 0; a < 2; ++a)
#pragma unroll
            for (int b = 0; b < 2; ++b)
#pragma unroll
                for (int m = 0; m < 4; ++m)
#pragma unroll
                    for (int n = 0; n < 2; ++n) acc[a][b][m][n] = (f32x4){0.f, 0.f, 0.f, 0.f};
        cur = nxt; cA = nA; cB = nB; ++ui; chb0 = nhb0; chb1 = nhb1;
        cv[0][0] = nv[0][0]; cv[0][1] = nv[0][1]; cv[1][0] = nv[1][0]; cv[1][1] = nv[1][1];
        if constexpr (ALIGN_EPI) { if (wr == 1) PG8_BAR; }
    }
    PG8_WAIT_V(0);
    if constexpr (!ALIGN_EPI) { if (wr == 0) PG8_BAR; }
    PG8_BAR;
#undef PG8_SA
#undef PG8_QFIX
#undef PG8_SB
#undef PG8_STG
#undef PG8_STGB
#undef PG8_LDA
#undef PG8_LDB
#undef PG8_MMA
#undef PG8_WAIT_V
#undef PG8_WAIT_L
#undef PG8_BAR
#undef PG8_SCHED
}
}
#define XB_TMO      128
#define XB_XCNT(j)  (256  + 64 * (j))
#define XB_XSUB(j)  (1280 + 64 * (j))
#define XB_XGEN(j)  (2304 + 64 * (j))
#define XB_TOP      3328
#define XB_TOPGEN   3392
#define XCD_BAR_WORDS 3456
#define XB_SPIN_CAP (1u << 18)

__device__ __forceinline__ unsigned xb_ld(unsigned* p)              { return __hip_atomic_load(p, __ATOMIC_RELAXED, __HIP_MEMORY_SCOPE_AGENT); }
__device__ __forceinline__ unsigned xb_add(unsigned* p, unsigned v) { return __hip_atomic_fetch_add(p, v, __ATOMIC_RELAXED, __HIP_MEMORY_SCOPE_AGENT); }
__device__ __forceinline__ unsigned xb_xcc_id() { return (unsigned)__builtin_amdgcn_s_getreg((3 << 11) | 20) & 0xFu; }
#define XB_SPIN(cond, bar) do { unsigned _sp = 0; while (cond) { __builtin_amdgcn_s_sleep(1); \
    if ((++_sp & 255u) == 0u) { if (xb_ld(&(bar)[XB_TMO])) break; if (_sp > XB_SPIN_CAP) { atomicAdd(&(bar)[XB_TMO], 1u); break; } } } } while (0)

struct XcdBarrier {
    unsigned* bar; unsigned x;
    volatile LAS unsigned* st;
};

__device__ __forceinline__ XcdBarrier xcd_barrier_post(unsigned* bar, volatile LAS unsigned* st) {
    XcdBarrier b; b.bar = bar; b.x = xb_xcc_id(); b.st = st;
    if (threadIdx.x == 0) (void)xb_add(&bar[XB_XCNT(b.x)], 1u);
    return b;
}
__device__ __forceinline__ void xcd_barrier_complete(unsigned* bar, unsigned x, unsigned& nloc, unsigned& nx) {
    const unsigned G = gridDim.x * gridDim.y * gridDim.z;
    unsigned sum, cnt, mine, sp = 0u;
    for (;;) {
        sum = 0u; cnt = 0u; mine = 0u;
#pragma unroll
        for (unsigned j = 0; j < 16; ++j) { const unsigned c = xb_ld(&bar[XB_XCNT(j)]); sum += c; cnt += (c > 0u) ? 1u : 0u; mine = (j == x) ? c : mine; }
        if (sum == G) break;
        __builtin_amdgcn_s_sleep(1);
        if ((++sp & 255u) == 0u) { if (xb_ld(&bar[XB_TMO])) break; if (sp > XB_SPIN_CAP) { atomicAdd(&bar[XB_TMO], 1u); break; } }
    }
    nloc = mine > 0u ? mine : 1u; nx = cnt > 0u ? cnt : 1u;
}

__device__ __forceinline__ void xcd_barrier(const XcdBarrier& b) {
    asm volatile("s_waitcnt vmcnt(0)" ::: "memory");
    __syncthreads();
    if (threadIdx.x == 0) {
        unsigned* bar = b.bar;
        __builtin_amdgcn_s_waitcnt(0);
        unsigned nloc = b.st[0], nx = b.st[1];
        if (nloc == 0u) { xcd_barrier_complete(bar, b.x, nloc, nx); b.st[0] = nloc; b.st[1] = nx; }
        const unsigned old = xb_add(&bar[XB_XSUB(b.x)], 1u);
        const unsigned gen = old / nloc;
        if (old + 1u == (gen + 1u) * nloc) {
            __builtin_amdgcn_fence(__ATOMIC_RELEASE, "agent");
            asm volatile("s_waitcnt vmcnt(0)" ::: "memory");
            const unsigned og = xb_add(&bar[XB_TOP], 1u);
            const unsigned tg = og / nx;
            if (og + 1u == (tg + 1u) * nx) xb_add(&bar[XB_TOPGEN], 1u);
            else XB_SPIN(xb_ld(&bar[XB_TOPGEN]) == tg, bar);
            __builtin_amdgcn_fence(__ATOMIC_ACQUIRE, "agent");
            xb_add(&bar[XB_XGEN(b.x)], 1u);
            asm volatile("s_waitcnt vmcnt(0)" ::: "memory");
        } else {
            __builtin_amdgcn_fence(__ATOMIC_ACQUIRE, "agent");
            XB_SPIN(xb_ld(&bar[XB_XGEN(b.x)]) == gen, bar);
            asm volatile("s_waitcnt vmcnt(0)" ::: "memory");
        }
    }
    __syncthreads();
}
struct RopeTab { float inv_freq[8]; };
struct Args { const void* in[21]; float* out; unsigned char* ws; int ph_lo, ph_hi; RopeTab rt; };

__device__ __forceinline__ void p0_adaln(LAS unsigned char* lds, const float* c, const float* ada_w, const float* ada_b, float* modp, int blk, int tid) {
    LAS float* ca = (LAS float*)lds;
    LAS float* red = (LAS float*)(lds + 4096);
    const int kc = blk >> 5, cc = blk & 31;
    for (int i = tid; i < 1024; i += NTHR) { const int b = i >> 7, k = i & 127; ca[i] = silu_f(c[b * D + kc * 128 + k]); }
    __syncthreads();
    if (tid < 480) {
        const int cq = tid % 48, kr = tid / 48;
        f32x4 acc[8];
#pragma unroll
        for (int b = 0; b < 8; ++b) acc[b] = (f32x4){0.f, 0.f, 0.f, 0.f};
        const float* wp = ada_w + (size_t)(kc * 128) * 6144 + cc * 192 + cq * 4;
        f32x4 wv[13];
#pragma unroll
        for (int i = 0; i < 13; ++i) { const int k = kr + 10 * i; wv[i] = (k < 128) ? *(const f32x4*)(wp + (size_t)k * 6144) : (f32x4){0.f, 0.f, 0.f, 0.f}; }
#pragma unroll
        for (int i = 0; i < 13; ++i) { const int k = (kr + 10 * i) & 127;
#pragma unroll
            for (int b = 0; b < 8; ++b) acc[b] += wv[i] * ca[b * 128 + k]; }
#pragma unroll
        for (int b = 0; b < 8; ++b) *(LAS f32x4*)(red + (kr * 8 + b) * 192 + cq * 4) = acc[b];
    }
    __syncthreads();
    if (tid < 384) { const int b = tid / 48, cq = tid % 48; f32x4 s = (f32x4){0.f, 0.f, 0.f, 0.f};
#pragma unroll
        for (int kr = 0; kr < 10; ++kr) s += *(const LAS f32x4*)(red + (kr * 8 + b) * 192 + cq * 4);
        if (kc == 0) s += *(const f32x4*)(ada_b + cc * 192 + cq * 4);
        *(f32x4*)(modp + (size_t)(kc * 8 + b) * 6144 + cc * 192 + cq * 4) = s; }
    __syncthreads();
}

__device__ __forceinline__ void tr_store(LAS float* scr, bf16* dst, int Kd, int k0, int rowbase, bool gu, int lane) {
    asm volatile("s_waitcnt lgkmcnt(0)" ::: "memory");
    const int c = lane & 7;
#pragma unroll
    for (int j = 0; j < 4; ++j) { const int n = (lane >> 3) + 8 * j; const LAS float* s = scr + (8 * c) * 33 + n;
        u32x4 o; o.x = pk2(s[0 * 33], s[1 * 33]); o.y = pk2(s[2 * 33], s[3 * 33]); o.z = pk2(s[4 * 33], s[5 * 33]); o.w = pk2(s[6 * 33], s[7 * 33]);
        const int row = rowbase + n + ((gu && n >= 16) ? 16 : 0);
        *(u32x4*)(dst + (size_t)row * Kd + k0 + 8 * c) = o; }
    asm volatile("s_waitcnt lgkmcnt(0)" ::: "memory");
}
struct TrItem { const float* src; bf16* dst; int ldw, Kd, k0, rowbase; bool gu; };
__device__ __forceinline__ bool tr_decode(int it, const Args& a, TrItem& t) {
    constexpr int I0 = 16 * 72, I2 = 16 * 32, I3 = 32 * 2 * 128, I4 = 32 * 128, NIT = I0 + I2 + I3 + I4;
    if (it >= NIT) return false;
    unsigned char* ws = a.ws;
    const float* w_in = (const float*)a.in[6]; const float* w_out = (const float*)a.in[11];
    const float* w_gate = (const float*)a.in[17]; const float* w_up = (const float*)a.in[18]; const float* w_down = (const float*)a.in[19];
    bf16* win = (bf16*)(ws + WS_WIN); bf16* wout = (bf16*)(ws + WS_WOUT); bf16* wgu = (bf16*)(ws + WS_WGU); bf16* wd = (bf16*)(ws + WS_WD);
    int r = it;
    if (r < I0) { const int kb = r / 72, nb = r % 72, n0 = nb * 32, k0 = kb * 64; const int sc = n0 + (n0 >= 1536 ? 16 : 0);
        t.src = w_in + (size_t)k0 * INW + sc; t.ldw = INW; t.dst = win; t.Kd = D; t.k0 = k0; t.rowbase = n0; t.gu = false; return true; }
    r -= I0;
    if (r < I2) { const int kb = r / 32, nb = r % 32, n0 = nb * 32, k0 = kb * 64;
        t.src = w_out + (size_t)k0 * D + n0; t.ldw = D; t.dst = wout; t.Kd = D; t.k0 = k0; t.rowbase = n0; t.gu = false; return true; }
    r -= I2;
    if (r < I3) { const int e = r >> 8, ty = (r >> 7) & 1, q = r & 127, kb = q >> 3, nb = q & 7, n0 = nb * 32, k0 = kb * 64;
        t.src = (ty ? w_up : w_gate) + (size_t)e * D * 256 + (size_t)k0 * 256 + n0; t.ldw = 256; t.dst = wgu + (size_t)e * 512 * D; t.Kd = D; t.k0 = k0; t.rowbase = 2 * n0 + 16 * ty; t.gu = true; return true; }
    r -= I3;
    { const int e = r >> 7, q = r & 127, kb = q >> 5, nb = q & 31, n0 = nb * 32, k0 = kb * 64;
        t.src = w_down + (size_t)e * 256 * D + (size_t)k0 * D + n0; t.ldw = D; t.dst = wd + (size_t)e * D * 256; t.Kd = 256; t.k0 = k0; t.rowbase = n0; t.gu = false; return true; }
}
__device__ __forceinline__ void tr_load(const TrItem& t, f32x4 (&v)[8], int lane) {
#pragma unroll
    for (int i = 0; i < 8; ++i) v[i] = *(const f32x4*)(t.src + (size_t)(8 * i + (lane >> 3)) * t.ldw + 4 * (lane & 7));
}
__device__ __forceinline__ void tr_finish(const TrItem& t, const f32x4 (&v)[8], LAS float* scr, int lane) {
#pragma unroll
    for (int i = 0; i < 8; ++i) { LAS float* s = scr + (8 * i + (lane >> 3)) * 33 + 4 * (lane & 7); s[0] = v[i].x; s[1] = v[i].y; s[2] = v[i].z; s[3] = v[i].w; }
    tr_store(scr, t.dst, t.Kd, t.k0, t.rowbase, t.gu, lane);
}
__device__ __forceinline__ void tr_stream(LAS unsigned char* scrbase, const Args& a, int first, int last, int gw, int NGW, int wave, int lane) {
    LAS float* scr = (LAS float*)(scrbase + wave * 8704);
    TrItem cur, nxt; f32x4 va[8], vb[8];
    int it = first + gw;
    bool have = it < last && tr_decode(it, a, cur);
    if (have) tr_load(cur, va, lane);
    while (have) {
        const bool hn = (it + NGW) < last && tr_decode(it + NGW, a, nxt);
        if (hn) tr_load(nxt, vb, lane);
        tr_finish(cur, va, scr, lane);
        if (!hn) break;
        const bool hn2 = (it + 2 * NGW) < last && tr_decode(it + 2 * NGW, a, cur);
        if (hn2) tr_load(cur, va, lane);
        tr_finish(nxt, vb, scr, lane);
        it += 2 * NGW; have = hn2;
    }
}
__device__ __forceinline__ void p0_weights(LAS unsigned char* lds, const Args& a, int blk, int wave, int lane, int tid) {
    unsigned char* ws = a.ws;
    const float* w_in = (const float*)a.in[6]; const float* w_a2 = (const float*)a.in[7]; const float* b_a2 = (const float*)a.in[8];
    bf16* win = (bf16*)(ws + WS_WIN);
    if (tid < 64 && blk < 192) {
        const float* w_grp = (const float*)a.in[13]; const float* w_exp = (const float*)a.in[15]; bf16* wrb = (bf16*)(ws + WS_WRB);
        const int e = blk * 64 + tid, ln = e & 63, hl = (e >> 6) & 1; const bool ex = e < 8192;
        const int k0 = ex ? 128 * (e >> 10) + 16 * ((e >> 7) & 7) + 8 * (ln >> 5) : 128 * ((e - 8192) >> 9) + 32 * ((e >> 7) & 3) + 8 * (ln >> 4);
        const int col = ex ? (ln & 31) : (ln & 15);
        unsigned o[4];
#pragma unroll
        for (int j2 = 0; j2 < 4; ++j2) { unsigned pr[2];
#pragma unroll
            for (int u = 0; u < 2; ++u) { const int k = k0 + 2 * j2 + u; const float wv = ex ? w_exp[k * 32 + col] : (col < 4 ? w_grp[k * 4 + col] : 0.f);
                const unsigned hi = f2bf(wv); const float hf = __uint_as_float(hi << 16); pr[u] = hl ? f2bf(wv - hf) : hi; }
            o[j2] = pr[0] | (pr[1] << 16); }
        *(u32x4*)(wrb + (size_t)e * 8) = (u32x4){o[0], o[1], o[2], o[3]};
    }
    {
        float wa[16];
#pragma unroll
        for (int q = 0; q < 16; ++q) wa[q] = w_a2[q * 256 + blk];
        float s2[2];
#pragma unroll
        for (int u = 0; u < 2; ++u) { const float* wr = w_in + (size_t)(2 * tid + u) * INW + 1536; float s = 0.f;
#pragma unroll
            for (int q4 = 0; q4 < 4; ++q4) { const f32x4 w = *(const f32x4*)(wr + 4 * q4); s = fmaf(w.x, wa[4 * q4], s); s = fmaf(w.y, wa[4 * q4 + 1], s); s = fmaf(w.z, wa[4 * q4 + 2], s); s = fmaf(w.w, wa[4 * q4 + 3], s); }
            s2[u] = s; }
        *(unsigned*)(win + (size_t)(C_Z + blk) * D + 2 * tid) = pk2(s2[0], s2[1]);
    }
}

__device__ __forceinline__ void p1a_rows(LAS unsigned char* lds, const Args& a, int blk, int wave, int lane, int tid) {
    const float* x = (const float*)a.in[0]; const float* g = (const float*)a.in[5];
    const float* modp = (const float*)(a.ws + WS_MODP); float* mod = (float*)(a.ws + WS_MOD); bf16* h = (bf16*)(a.ws + WS_H);
    const int* pos = (const int*)a.in[2]; float* rtab = (float*)(a.ws + WS_ROPE);
    LAS float* ssh = (LAS float*)lds;
    const int b = blk >> 5;
    f32x4 n0[4], n1[4];
    const size_t mb = (size_t)blk * 64 + wave;
#pragma unroll
    for (int j = 0; j < 4; ++j) { n0[j] = *(const f32x4*)(x + mb * D + 4 * lane + 256 * j); n1[j] = *(const f32x4*)(x + (mb + NWAVES) * D + 4 * lane + 256 * j); }
    {
        float pv[4][8];
#pragma unroll
        for (int q = 0; q < 4; ++q)
#pragma unroll
            for (int kc = 0; kc < 8; ++kc) pv[q][kc] = modp[(size_t)(kc * 8 + b) * 6144 + tid + NTHR * q];
#pragma unroll
        for (int q = 0; q < 4; ++q) { const int i = tid + NTHR * q; float s = 0.f;
#pragma unroll
            for (int kc = 0; kc < 8; ++kc) s += pv[q][kc];
            ssh[i] = i < 1024 ? s : (1.f + s) * g[i - 1024]; }
    }
    if (tid < 192) { const int idx = blk * 192 + tid, bb = idx / 6144, col = idx % 6144; float s = 0.f;
#pragma unroll
        for (int kc = 0; kc < 8; ++kc) s += modp[(size_t)(kc * 8 + bb) * 6144 + col];
        mod[idx] = s; }
    { const int m = blk * 64 + (tid >> 3), j = tid & 7; float sn, cs; sincosf((float)pos[m] * a.rt.inv_freq[j], &sn, &cs); rtab[m * 16 + j] = cs; rtab[m * 16 + 8 + j] = sn; }
    __syncthreads();
    for (int r = wave; r < 64; r += NWAVES) {
        const size_t m = (size_t)blk * 64 + r;
        f32x4 v[4]; float ss = 0.f;
#pragma unroll
        for (int j = 0; j < 4; ++j) { v[j] = n0[j]; n0[j] = n1[j]; }
        if (r + 2 * NWAVES < 64) {
#pragma unroll
            for (int j = 0; j < 4; ++j) n1[j] = *(const f32x4*)(x + (m + 2 * NWAVES) * D + 4 * lane + 256 * j);
        }
#pragma unroll
        for (int j = 0; j < 4; ++j) ss += (v[j].x * v[j].x + v[j].y * v[j].y) + (v[j].z * v[j].z + v[j].w * v[j].w);
        const float rinv = rsqrtf(wave_sum(ss) * (1.f / D) + EPS);
#pragma unroll
        for (int j = 0; j < 4; ++j) { const int col = 4 * lane + 256 * j; const f32x4 sh = *(const LAS f32x4*)(ssh + col), gs = *(const LAS f32x4*)(ssh + 1024 + col);
            const f32x4 hv = v[j] * rinv * gs + sh; u32x2 o; o.x = pk2(hv.x, hv.y); o.y = pk2(hv.z, hv.w);
            *(u32x2*)(h + m * D + col) = o; }
    }
    __syncthreads();
}

__device__ __forceinline__ void p3b_route(LAS unsigned char* lds, const Args& a, int blk, int wave, int lane, int tid) {
    const bf16* x1 = (const bf16*)(a.ws + WS_X1); const float* g = (const float*)a.in[12];
    const float* b_grp = (const float*)a.in[14]; const float* b_exp = (const float*)a.in[16];
    const float* mod = (const float*)(a.ws + WS_MOD); bf16* h2 = (bf16*)(a.ws + WS_H); const bf16* wrb = (const bf16*)(a.ws + WS_WRB);
    int* cnt = (int*)(a.ws + WS_CTL) + CW_CNT; int* list = (int*)(a.ws + WS_ROUTE); float* lw = (float*)(a.ws + WS_ROUTE + 2 * MiB);
    LAS unsigned char* Ahi = lds; LAS unsigned char* Alo = lds + 65536;
    LAS float* red = (LAS float*)lds;
    LAS float* lgt = (LAS float*)(lds + 65536);
    LAS float* ssh = (LAS float*)(lds + 131072);
    LAS int* rsel = (LAS int*)(lds + 139264); LAS int* rslot = rsel + 128; LAS float* rwt = (LAS float*)(rslot + 128); LAS int* lcnt = (LAS int*)(rwt + 128); LAS int* lbase = lcnt + 32;
    LAS float* biasL = (LAS float*)(lbase + 32);
    const int b = blk >> 5, l31 = lane & 31, hh = lane >> 5;
    bf16x8 bh[8], bl[8], gh[4], gl[4];
#pragma unroll
    for (int s = 0; s < 8; ++s) { const size_t e = (size_t)(((wave * 8 + s) * 2) * 64 + lane) * 8; bh[s] = *(const bf16x8*)(wrb + e); bl[s] = *(const bf16x8*)(wrb + e + 512); }
#pragma unroll
    for (int s = 0; s < 4; ++s) { const size_t e = (size_t)(8192 + ((wave * 4 + s) * 2) * 64 + lane) * 8; gh[s] = *(const bf16x8*)(wrb + e); gl[s] = *(const bf16x8*)(wrb + e + 512); }
    u32x2 nx[4][4];
#pragma unroll
    for (int rr = 0; rr < 4; ++rr)
#pragma unroll
        for (int j = 0; j < 4; ++j) nx[rr][j] = *(const u32x2*)(x1 + ((size_t)blk * 64 + wave * 4 + rr) * D + 4 * lane + 256 * j);
    {
        float mv[4], gv[4];
#pragma unroll
        for (int q = 0; q < 4; ++q) { const int i = tid + NTHR * q; mv[q] = mod[b * 6144 + 3 * D + i]; gv[q] = i < 1024 ? 0.f : g[i - 1024]; }
#pragma unroll
        for (int q = 0; q < 4; ++q) { const int i = tid + NTHR * q; ssh[i] = i < 1024 ? mv[q] : (1.f + mv[q]) * gv[q]; }
    }
    if (tid < 32) lcnt[tid] = 0;
    if (tid >= 64 && tid < 100) biasL[tid - 64] = (tid < 96) ? b_exp[tid - 64] : b_grp[tid - 96];
    __syncthreads();
#pragma unroll 1
    for (int pass = 0; pass < 2; ++pass) {
#pragma unroll
        for (int rr = 0; rr < 4; ++rr) {
            const int rl = wave * 4 + rr; const int m = blk * 64 + pass * 32 + rl;
            f32x4 v[4]; float ss = 0.f;
#pragma unroll
            for (int j = 0; j < 4; ++j) { v[j].x = lo_bf16(nx[rr][j].x); v[j].y = hi_bf16(nx[rr][j].x); v[j].z = lo_bf16(nx[rr][j].y); v[j].w = hi_bf16(nx[rr][j].y); }
            if (pass == 0) {
#pragma unroll
              for (int j = 0; j < 4; ++j) nx[rr][j] = *(const u32x2*)(x1 + (size_t)(m + 32) * D + 4 * lane + 256 * j); }
#pragma unroll
            for (int j = 0; j < 4; ++j) ss += (v[j].x * v[j].x + v[j].y * v[j].y) + (v[j].z * v[j].z + v[j].w * v[j].w);
            const float rinv = rsqrtf(wave_sum(ss) * (1.f / D) + EPS);
#pragma unroll
            for (int j = 0; j < 4; ++j) { const int col = 4 * lane + 256 * j; const f32x4 sh = *(const LAS f32x4*)(ssh + col), sc = *(const LAS f32x4*)(ssh + 1024 + col);
                v[j] = v[j] * rinv * sc + sh;
                u32x2 hi; hi.x = pk2(v[j].x, v[j].y); hi.y = pk2(v[j].z, v[j].w);
                *(u32x2*)(h2 + (size_t)m * D + col) = hi;
                u32x2 lo; lo.x = pk2(v[j].x - lo_bf16(hi.x), v[j].y - hi_bf16(hi.x)); lo.y = pk2(v[j].z - lo_bf16(hi.y), v[j].w - hi_bf16(hi.y));
                const int c = (lane >> 1) + 32 * j; const int off = rl * 2048 + ((c ^ (rl & 15)) * 16) + 8 * (lane & 1);
                *(LAS u32x2*)(Ahi + off) = hi; *(LAS u32x2*)(Alo + off) = lo; }
        }
        __syncthreads();
        f32x16 acc0; f32x4 accg[2];
#pragma unroll
        for (int r = 0; r < 16; ++r) acc0[r] = 0.f;
        accg[0] = (f32x4){0.f, 0.f, 0.f, 0.f}; accg[1] = (f32x4){0.f, 0.f, 0.f, 0.f};
#pragma unroll
        for (int s = 0; s < 8; ++s) { const int c = 2 * (wave * 8 + s) + hh; const int off = l31 * 2048 + ((c ^ (l31 & 15)) * 16);
            const bf16x8 ah = *(const LAS bf16x8*)(Ahi + off), al = *(const LAS bf16x8*)(Alo + off);
            acc0 = __builtin_amdgcn_mfma_f32_32x32x16_bf16(ah, bh[s], acc0, 0, 0, 0); acc0 = __builtin_amdgcn_mfma_f32_32x32x16_bf16(ah, bl[s], acc0, 0, 0, 0); acc0 = __builtin_amdgcn_mfma_f32_32x32x16_bf16(al, bh[s], acc0, 0, 0, 0); }
#pragma unroll
        for (int s = 0; s < 4; ++s)
#pragma unroll
            for (int mt = 0; mt < 2; ++mt) { const int row = 16 * mt + (lane & 15), c = 16 * wave + 4 * s + (lane >> 4); const int off = row * 2048 + ((c ^ (row & 15)) * 16);
                const bf16x8 ah = *(const LAS bf16x8*)(Ahi + off), al = *(const LAS bf16x8*)(Alo + off);
                accg[mt] = __builtin_amdgcn_mfma_f32_16x16x32_bf16(ah, gh[s], accg[mt], 0, 0, 0); accg[mt] = __builtin_amdgcn_mfma_f32_16x16x32_bf16(ah, gl[s], accg[mt], 0, 0, 0); accg[mt] = __builtin_amdgcn_mfma_f32_16x16x32_bf16(al, gh[s], accg[mt], 0, 0, 0); }
        __syncthreads();
#pragma unroll
        for (int r = 0; r < 16; ++r) { const int row = (r & 3) + 8 * (r >> 2) + 4 * hh; red[(wave * 32 + row) * 36 + l31] = acc0[r]; }
        if ((lane & 15) < 4) {
#pragma unroll
            for (int mt = 0; mt < 2; ++mt)
#pragma unroll
                for (int r = 0; r < 4; ++r) red[(wave * 32 + 16 * mt + 4 * (lane >> 4) + r) * 36 + 32 + (lane & 15)] = accg[mt][r];
        }
        __syncthreads();
#pragma unroll
        for (int q = 0; q < 3; ++q) { const int p = tid + NTHR * q;
            if (p < 32 * 36) { float s = 0.f;
#pragma unroll
                for (int w = 0; w < 8; ++w) s += red[w * (32 * 36) + p];
                lgt[p] = s + biasL[p % 36]; } }
        __syncthreads();
        if (tid < 32) {
            const int row = tid;
            float lg[4];
#pragma unroll
            for (int o = 0; o < 4; ++o) lg[o] = lgt[row * 36 + 32 + o];
            int gi = 0; float gm = lg[0];
#pragma unroll
            for (int o = 1; o < 4; ++o) if (lg[o] > gm) { gm = lg[o]; gi = o; }
            float den = 0.f;
#pragma unroll
            for (int o = 0; o < 4; ++o) den += __expf(lg[o] - gm);
            const float gate = 1.f / den;
            float sl[8];
#pragma unroll
            for (int i = 0; i < 8; ++i) sl[i] = lgt[row * 36 + gi * 8 + i];
            int i1 = 0; float v1 = sl[0];
#pragma unroll
            for (int i = 1; i < 8; ++i) if (sl[i] > v1) { v1 = sl[i]; i1 = i; }
            int i2 = 0; float v2 = -INFINITY;
#pragma unroll
            for (int i = 0; i < 8; ++i) if (i != i1 && sl[i] > v2) { v2 = sl[i]; i2 = i; }
            const float e2 = __expf(v2 - v1), w1 = gate / (1.f + e2), w2 = gate * e2 / (1.f + e2);
            const int ea = gi * 8 + i1, eb = gi * 8 + i2, r2 = 2 * (pass * 32 + row);
            rsel[r2] = ea; rslot[r2] = atomicAdd((int*)(lcnt + ea), 1); rwt[r2] = w1;
            rsel[r2 + 1] = eb; rslot[r2 + 1] = atomicAdd((int*)(lcnt + eb), 1); rwt[r2 + 1] = w2;
        }
        __syncthreads();
    }
    if (tid < 32) { const int c = lcnt[tid]; lbase[tid] = c ? atomicAdd(&cnt[tid], c) : 0; }
    __syncthreads();
    if (tid < 128) { const int e = rsel[tid], slot = lbase[e] + rslot[tid]; list[e * LCAP + slot] = (blk * 64 + (tid >> 1)) * 2 + (tid & 1); lw[e * LCAP + slot] = rwt[tid]; }
    __syncthreads();
}

__device__ __forceinline__ void moe_prefix(LAS int* tp, const int* cnt, int tid) {
    if (tid < 64) {
        const int c = tid < NEXP ? ((__hip_atomic_load(cnt + (tid & 31), __ATOMIC_RELAXED, __HIP_MEMORY_SCOPE_AGENT) + 255) >> 8) : 0;
        int s = c;
#pragma unroll
        for (int o = 1; o < 32; o <<= 1) { const int t = __shfl_up(s, o); if ((tid & 63) >= o) s += t; }
        if (tid < NEXP) { tp[tid] = s - c; for (int t = s - c; t < s; ++t) tp[40 + t] = tid; }
        if (tid == NEXP - 1) tp[NEXP] = s;
    }
    __syncthreads();
}

__device__ __forceinline__ void p6_final(LAS unsigned char* lds, const Args& a, int blk, int wave, int lane, int tid) {
    float* out = a.out; const bf16* x1 = (const bf16*)(a.ws + WS_X1); const float* fg = (const float*)a.in[20]; const float* mod = (const float*)(a.ws + WS_MOD); const bf16* y2 = (const bf16*)(a.ws + WS_Y2);
    LAS float* gt = (LAS float*)lds;
    const int b = blk >> 5;
    for (int i = tid; i < 1024; i += NTHR) gt[i] = mod[b * 6144 + 5 * D + i];
    __syncthreads();
    f32x4 gg[4];
#pragma unroll
    for (int j = 0; j < 4; ++j) gg[j] = *(const f32x4*)(fg + 4 * lane + 256 * j);
    u32x2 nx[4]; u32x2 nya[4], nyb[4];
    {
        const size_t m = (size_t)blk * 64 + wave;
#pragma unroll
        for (int j = 0; j < 4; ++j) { const int col = 4 * lane + 256 * j; nx[j] = *(const u32x2*)(x1 + m * D + col); nya[j] = *(const u32x2*)(y2 + (m * 2) * D + col); nyb[j] = *(const u32x2*)(y2 + (m * 2 + 1) * D + col); }
    }
    for (int r = wave; r < 64; r += NWAVES) {
        const size_t m = (size_t)blk * 64 + r;
        f32x4 v[4]; u32x2 ya4[4], yb4[4]; float ss = 0.f;
#pragma unroll
        for (int j = 0; j < 4; ++j) { v[j].x = lo_bf16(nx[j].x); v[j].y = hi_bf16(nx[j].x); v[j].z = lo_bf16(nx[j].y); v[j].w = hi_bf16(nx[j].y); ya4[j] = nya[j]; yb4[j] = nyb[j]; }
        if (r + NWAVES < 64) {
            const size_t mn = m + NWAVES;
#pragma unroll
            for (int j = 0; j < 4; ++j) { const int col = 4 * lane + 256 * j; nx[j] = *(const u32x2*)(x1 + mn * D + col); nya[j] = *(const u32x2*)(y2 + (mn * 2) * D + col); nyb[j] = *(const u32x2*)(y2 + (mn * 2 + 1) * D + col); }
        }
#pragma unroll
        for (int j = 0; j < 4; ++j) { const int col = 4 * lane + 256 * j; const u32x2 ya = ya4[j], yb = yb4[j];
            f32x4 y; y.x = __uint_as_float(ya.x << 16) + __uint_as_float(yb.x << 16); y.y = __uint_as_float(ya.x & 0xffff0000u) + __uint_as_float(yb.x & 0xffff0000u);
            y.z = __uint_as_float(ya.y << 16) + __uint_as_float(yb.y << 16); y.w = __uint_as_float(ya.y & 0xffff0000u) + __uint_as_float(yb.y & 0xffff0000u);
            v[j] += *(const LAS f32x4*)(gt + col) * y; ss += (v[j].x * v[j].x + v[j].y * v[j].y) + (v[j].z * v[j].z + v[j].w * v[j].w); }
        const float rinv = rsqrtf(wave_sum(ss) * (1.f / D) + EPS);
#pragma unroll
        for (int j = 0; j < 4; ++j) *(f32x4*)(out + m * D + 4 * lane + 256 * j) = v[j] * rinv * gg[j];
    }
    __syncthreads();
}
typedef short v4i16_t __attribute__((ext_vector_type(4)));
constexpr float LOG2E = 1.4426950408889634f;
__device__ __forceinline__ f32x16 mfma32(bf16x8 a, bf16x8 b, f32x16 c) { return __builtin_amdgcn_mfma_f32_32x32x16_bf16(a, b, c, 0, 0, 0); }
__device__ __forceinline__ v4i16_t tr_read(LAS unsigned char* p) { return __builtin_amdgcn_ds_read_tr16_b64_v4i16((LAS v4i16_t*)p); }
__device__ __forceinline__ bf16x8 cat8(v4i16_t a, v4i16_t b) { return (bf16x8){a[0], a[1], a[2], a[3], b[0], b[1], b[2], b[3]}; }
__device__ __forceinline__ unsigned cvtpk(float lo, float hi) { const f32x2_t v = {lo, hi}; const bf16x2_t b = __builtin_convertvector(v, bf16x2_t); return __builtin_bit_cast(unsigned, b); }
__device__ __forceinline__ bf16x8 pack8(const f32x16& v, int s) {
    u32x4 w; w.x = cvtpk(v[8 * s + 0], v[8 * s + 1]); w.y = cvtpk(v[8 * s + 2], v[8 * s + 3]); w.z = cvtpk(v[8 * s + 4], v[8 * s + 5]); w.w = cvtpk(v[8 * s + 6], v[8 * s + 7]);
    return __builtin_bit_cast(bf16x8, w);
}
__device__ __forceinline__ unsigned xor32_u(unsigned x) { const auto r = __builtin_amdgcn_permlane32_swap(x, x, false, false); return (threadIdx.x & 32) ? r[0] : r[1]; }
__device__ __forceinline__ float sum32(float x) { const auto r = __builtin_amdgcn_permlane32_swap(__float_as_uint(x), __float_as_uint(x), false, false); return __uint_as_float(r[0]) + __uint_as_float(r[1]); }
__device__ __forceinline__ float max32(float x) { const auto r = __builtin_amdgcn_permlane32_swap(__float_as_uint(x), __float_as_uint(x), false, false); return fmaxf(__uint_as_float(r[0]), __uint_as_float(r[1])); }
__device__ __forceinline__ float lo_bf(unsigned w) { return __uint_as_float(w << 16); }
__device__ __forceinline__ float hi_bf(unsigned w) { return __uint_as_float(w & 0xffff0000u); }
__device__ __forceinline__ int off256(int row, int ch) { return 256 * row + 16 * (ch ^ (((row & 3) << 2) | ((row >> 2) & 3))); }
__device__ __forceinline__ int off128(int row, int c) { return 128 * row + 16 * (c ^ ((row >> 1) & 7)); }

__device__ __forceinline__ void swa_unit(LAS unsigned char* lds, const bf16* proj, const float* rtab, const float* sinks, bf16* o, int unit, int tid, int lane, int wave) {
    const int b = unit >> 5, kh = (unit >> 4) & 1, qb = unit & 15;
    LAS unsigned char* Ks = lds; LAS unsigned char* Vs = lds + 32768;
    {
        const int key = tid >> 1, half = tid & 1;
        const int jpos = (qb - 1) * 128 + key; const bool valid = jpos >= 0;
        const size_t m = (size_t)b * SEQ + (valid ? jpos : 0);
        const bf16* kp = proj + m * PW + C_SK + kh * 64 + half * 32; const bf16* vp = proj + m * PW + C_SV + kh * 64 + half * 32;
        u32x4 kc[4], vc[4];
#pragma unroll
        for (int c = 0; c < 4; ++c) { kc[c] = *(const u32x4*)(kp + 8 * c); vc[c] = *(const u32x4*)(vp + 8 * c); }
        if (half == 0) {
            const f32x4 c0 = *(const f32x4*)(rtab + m * 16), c1 = *(const f32x4*)(rtab + m * 16 + 4), s0 = *(const f32x4*)(rtab + m * 16 + 8), s1 = *(const f32x4*)(rtab + m * 16 + 12);
            const float cs[8] = {c0.x, c0.y, c0.z, c0.w, c1.x, c1.y, c1.z, c1.w}, sn[8] = {s0.x, s0.y, s0.z, s0.w, s1.x, s1.y, s1.z, s1.w};
#pragma unroll
            for (int w = 0; w < 4; ++w) {
                const float a0 = lo_bf(kc[0][w]), a1 = hi_bf(kc[0][w]), b0 = lo_bf(kc[1][w]), b1 = hi_bf(kc[1][w]);
                kc[0][w] = cvtpk(a0 * cs[2 * w] - b0 * sn[2 * w], a1 * cs[2 * w + 1] - b1 * sn[2 * w + 1]);
                kc[1][w] = cvtpk(b0 * cs[2 * w] + a0 * sn[2 * w], b1 * cs[2 * w + 1] + a1 * sn[2 * w + 1]);
            }
        }
        if (!valid) {
#pragma unroll
            for (int c = 0; c < 4; ++c) { kc[c] = (u32x4){0u, 0u, 0u, 0u}; vc[c] = (u32x4){0u, 0u, 0u, 0u}; }
        }
        const int vsw = (key >> 1) & 1;
#pragma unroll
        for (int c = 0; c < 4; ++c) { const int cc = 4 * half + c;
            *(LAS u32x4*)(Ks + off128(key, cc)) = kc[c];
            *(LAS u32x4*)(Vs + key * 128 + (((cc >> 2) ^ vsw) * 64) + (cc & 3) * 16) = vc[c]; }
    }
    __syncthreads();
    const int g = wave >> 1, qhf = wave & 1, qh = kh * 4 + g;
    const int l31 = lane & 31, h = lane >> 5, i16 = lane & 15, g16 = (lane >> 4) & 1, tq = i16 >> 2, tp = i16 & 3;
    const float sink2 = sinks[qh] * LOG2E, sc = 0.125f * LOG2E;
    const int vbase = (4 * h + tq) * 128 + 32 * g16 + 8 * tp;
#pragma unroll 1
    for (int qs = 0; qs < 2; ++qs) {
        const int q0 = 64 * qhf + 32 * qs;
        const size_t m = (size_t)b * SEQ + qb * 128 + q0 + l31;
        bf16x8 qf[4];
        const bf16* qp = proj + m * PW + C_SQ + qh * 64 + 8 * h;
#pragma unroll
        for (int s = 0; s < 4; ++s) qf[s] = *(const bf16x8*)(qp + 16 * s);
        {
            const f32x4 c0 = *(const f32x4*)(rtab + m * 16), c1 = *(const f32x4*)(rtab + m * 16 + 4), s0 = *(const f32x4*)(rtab + m * 16 + 8), s1 = *(const f32x4*)(rtab + m * 16 + 12);
            const float cs[8] = {c0.x, c0.y, c0.z, c0.w, c1.x, c1.y, c1.z, c1.w}, sn[8] = {s0.x, s0.y, s0.z, s0.w, s1.x, s1.y, s1.z, s1.w};
            u32x4 own = __builtin_bit_cast(u32x4, qf[0]), res;
#pragma unroll
            for (int w = 0; w < 4; ++w) { const unsigned pw = xor32_u(own[w]);
                const float o0 = lo_bf(own[w]), o1 = hi_bf(own[w]), p0 = lo_bf(pw), p1 = hi_bf(pw);
                const float sg = h ? 1.f : -1.f;
                res[w] = cvtpk(o0 * cs[2 * w] + sg * p0 * sn[2 * w], o1 * cs[2 * w + 1] + sg * p1 * sn[2 * w + 1]); }
            qf[0] = __builtin_bit_cast(bf16x8, res);
        }
        const int kt0 = q0 >> 5;
        f32x16 st[5];
#pragma unroll
        for (int i = 0; i < 5; ++i) {
            f32x16 acc;
#pragma unroll
            for (int r = 0; r < 16; ++r) acc[r] = 0.f;
            const int row = 32 * (kt0 + i) + l31;
#pragma unroll
            for (int s = 0; s < 4; ++s) { const bf16x8 kf = *(const LAS bf16x8*)(Ks + off128(row, 2 * s + h)); acc = mfma32(kf, qf[s], acc); }
            st[i] = acc;
        }
        float mx = sink2;
#pragma unroll
        for (int i = 0; i < 5; ++i)
#pragma unroll
            for (int r = 0; r < 16; ++r) { const int krow = (r & 3) + 8 * (r >> 2) + 4 * h; const int dj = 32 * i + krow - l31;
                bool ok = (dj > 0) && (dj <= 128); if (qb == 0) ok = ok && (q0 + 32 * i + krow >= 128);
                const float x = ok ? st[i][r] * sc : -1e30f; st[i][r] = x; mx = fmaxf(mx, x); }
        mx = max32(mx);
        float l = 0.f;
#pragma unroll
        for (int i = 0; i < 5; ++i)
#pragma unroll
            for (int r = 0; r < 16; ++r) { const float p = __builtin_amdgcn_exp2f(st[i][r] - mx); st[i][r] = p; l += p; }
        l = sum32(l); l += __builtin_amdgcn_exp2f(sink2 - mx);
        f32x16 ot[2];
#pragma unroll
        for (int r = 0; r < 16; ++r) { ot[0][r] = 0.f; ot[1][r] = 0.f; }
#pragma unroll
        for (int i = 0; i < 5; ++i)
#pragma unroll
            for (int s2 = 0; s2 < 2; ++s2) { const bf16x8 pf = pack8(st[i], s2);
                LAS unsigned char* vb = Vs + (32 * (kt0 + i) + 16 * s2) * 128 + vbase;
#pragma unroll
                for (int dt = 0; dt < 2; ++dt) { const int xo = (dt ^ (tq >> 1)) * 64;
                    const bf16x8 vf = cat8(tr_read(vb + xo), tr_read(vb + 8 * 128 + xo));
                    ot[dt] = mfma32(vf, pf, ot[dt]); } }
        const float inv = 1.f / l;
        bf16* op = o + m * D + 512 + qh * 64 + 4 * h;
#pragma unroll
        for (int dt = 0; dt < 2; ++dt)
#pragma unroll
            for (int gq = 0; gq < 4; ++gq) { u32x2 w; w.x = cvtpk(ot[dt][4 * gq] * inv, ot[dt][4 * gq + 1] * inv); w.y = cvtpk(ot[dt][4 * gq + 2] * inv, ot[dt][4 * gq + 3] * inv);
                *(u32x2*)(op + dt * 32 + 8 * gq) = w; }
    }
    __syncthreads();
}

constexpr int GLA_CH = 32768, GLA_QD = 16384, GLA_KD = 24576, GLA_K2T = 131072  , GLA_SEG = 147456  , GLA_DECL = 151552  , GLA_DECP = 152064, GLA_S = 131072, GLA_SSQ = 153088;
__device__ __forceinline__ float logsig16(float z) { return (fminf(z, 0.f) - __logf(1.f + __expf(-fabsf(z)))) * (1.f / 16.f); }
__device__ __forceinline__ void gla_kv_group(LAS unsigned char* lds, const bf16* proj, const float* b_a2, bf16* KV, bf16* KVG, float* DECG, int bh, int g, int tid, int lane, int wave) {
    const int b = bh >> 2, hd = bh & 3;
    LAS float* decP = (LAS float*)(lds + GLA_DECP);
    const int et = wave >> 1, dt = wave & 1, l31 = lane & 31, hh = lane >> 5, i16 = lane & 15, g16 = (lane >> 4) & 1, tq = i16 >> 2, tp = i16 & 3;
    const int d = tid & 63, seg = tid >> 6;
    const float zb = b_a2[hd * 64 + d];
    f32x16 grp; float gdec = 1.f;
#pragma unroll
    for (int r = 0; r < 16; ++r) grp[r] = 0.f;
#pragma unroll 1
    for (int jp = 0; jp < 2; ++jp) {
        float la[2][8], qv[2][8], kv[2][8]; u32x4 vld[2][2];
#pragma unroll
        for (int c2 = 0; c2 < 2; ++c2) { const size_t m0 = (size_t)b * SEQ + (4 * g + 2 * jp + c2) * 64;
#pragma unroll
            for (int i = 0; i < 8; ++i) { const size_t mr = (m0 + seg * 8 + i) * PW; la[c2][i] = bf2f(proj[mr + C_Z + hd * 64 + d]); qv[c2][i] = bf2f(proj[mr + C_GQ + hd * 64 + d]) * 0.125f; kv[c2][i] = bf2f(proj[mr + C_GK + hd * 64 + d]); }
#pragma unroll
            for (int i = 0; i < 2; ++i) { const int idx = tid + NTHR * i; vld[c2][i] = *(const u32x4*)(proj + (m0 + (idx >> 4)) * PW + C_GV + hd * 128 + (idx & 15) * 8); } }
#pragma unroll
        for (int c2 = 0; c2 < 2; ++c2) { LAS float* segtot = (LAS float*)(lds + GLA_SEG + 2048 * c2);
#pragma unroll
            for (int i = 0; i < 8; ++i) la[c2][i] = logsig16(la[c2][i] + zb);
#pragma unroll
            for (int i = 1; i < 8; ++i) la[c2][i] += la[c2][i - 1];
            segtot[seg * 64 + d] = la[c2][7]; }
        __syncthreads();
#pragma unroll
        for (int c2 = 0; c2 < 2; ++c2) { const int jn = 2 * jp + c2;
            LAS unsigned char* vS = lds + GLA_CH * jn; LAS unsigned char* qdS = vS + GLA_QD; LAS unsigned char* kdS = vS + GLA_KD;
            LAS unsigned char* k2T = lds + GLA_K2T + 8192 * c2; LAS float* segtot = (LAS float*)(lds + GLA_SEG + 2048 * c2); LAS float* decL = (LAS float*)(lds + GLA_DECL + 256 * c2);
            float pre = 0.f, tot = 0.f;
#pragma unroll
            for (int s = 0; s < 8; ++s) { const float v = segtot[s * 64 + d]; tot += v; pre += (s < seg) ? v : 0.f; }
            u32x4 w; float e[8]; const float etot = __expf(tot);
#pragma unroll
            for (int i = 0; i < 8; ++i) { const int t = seg * 8 + i; const float bb = pre + la[c2][i]; const float en = __expf(-bb);
                e[i] = kv[c2][i] * en * etot;
                *(LAS bf16*)(qdS + off128(t, d >> 3) + (d & 7) * 2) = (bf16)f2bf(qv[c2][i] * __expf(bb));
                *(LAS bf16*)(kdS + off128(t, d >> 3) + (d & 7) * 2) = (bf16)f2bf(kv[c2][i] * en); }
            w.x = cvtpk(e[0], e[1]); w.y = cvtpk(e[2], e[3]); w.z = cvtpk(e[4], e[5]); w.w = cvtpk(e[6], e[7]);
            *(LAS u32x4*)(k2T + off128(d, seg)) = w;
            if (seg == 0) { decL[d] = etot; decP[jn * 64 + d] = etot; }
#pragma unroll
            for (int i = 0; i < 2; ++i) { const int idx = tid + NTHR * i; *(LAS u32x4*)(vS + off256(idx >> 4, idx & 15)) = vld[c2][i]; } }
        __syncthreads();
#pragma unroll
        for (int c2 = 0; c2 < 2; ++c2) { const int jn = 2 * jp + c2; const size_t unit = (size_t)(bh * 32 + 4 * g + jn);
            LAS unsigned char* vS = lds + GLA_CH * jn; LAS unsigned char* k2T = lds + GLA_K2T + 8192 * c2; LAS float* decL = (LAS float*)(lds + GLA_DECL + 256 * c2);
            f32x16 acc;
#pragma unroll
            for (int r = 0; r < 16; ++r) acc[r] = 0.f;
#pragma unroll
            for (int kk = 0; kk < 4; ++kk) {
                const int kb = 16 * kk + 8 * hh;
                const int ch = et * 4 + 2 * g16 + (tp >> 1);
                const bf16x8 af = cat8(tr_read(vS + off256(kb + tq, ch) + 8 * (tp & 1)), tr_read(vS + off256(kb + 4 + tq, ch) + 8 * (tp & 1)));
                const bf16x8 bfr = *(const LAS bf16x8*)(k2T + off128(dt * 32 + l31, 2 * kk + hh));
                acc = mfma32(af, bfr, acc);
            }
            const float dcl = decL[dt * 32 + l31];
            __builtin_amdgcn_sched_barrier(0);
            asm volatile("s_nop 15\n\ts_nop 15" ::: "memory");
            __builtin_amdgcn_sched_barrier(0);
            if (jn < 3 || g < 7) {
                bf16* sp = KV + unit * 8192 + (dt * 32 + l31) * 128 + et * 32 + 4 * hh;
#pragma unroll
                for (int gq = 0; gq < 4; ++gq) { u32x2 w; w.x = cvtpk(acc[4 * gq], acc[4 * gq + 1]); w.y = cvtpk(acc[4 * gq + 2], acc[4 * gq + 3]); *(u32x2*)(sp + 8 * gq) = w; }
            }
#pragma unroll
            for (int r = 0; r < 16; ++r) grp[r] = dcl * grp[r] + acc[r];
            gdec *= dcl; }
        __syncthreads();
    }
    {
        bf16* sp = KVG + (size_t)(bh * 8 + g) * 8192 + (dt * 32 + l31) * 128 + et * 32 + 4 * hh;
#pragma unroll
        for (int gq = 0; gq < 4; ++gq) { u32x2 w; w.x = cvtpk(grp[4 * gq], grp[4 * gq + 1]); w.y = cvtpk(grp[4 * gq + 2], grp[4 * gq + 3]); *(u32x2*)(sp + 8 * gq) = w; }
        if (et == 0 && hh == 0) DECG[(size_t)(bh * 8 + g) * 64 + dt * 32 + l31] = gdec;
    }
}

__device__ __forceinline__ void gla_out_block(LAS unsigned char* lds, const bf16* proj, const bf16* KV, const bf16* KVG, const float* DECG, const float* gn, bf16* o, int bh, int g, int tid, int lane, int wave) {
    const int b = bh >> 2, hd = bh & 3, n0 = 4 * g;
    LAS unsigned char* sS = lds + GLA_S; LAS float* ssq = (LAS float*)(lds + GLA_SSQ); LAS float* decP = (LAS float*)(lds + GLA_DECP);
    const int et = wave >> 1, tt = wave & 1, l31 = lane & 31, hh = lane >> 5, i16 = lane & 15, g16 = (lane >> 4) & 1, tq = i16 >> 2, tp = i16 & 3;
    const int srow = tid >> 4, sch = tid & 15;
    u32x4 kvn[2]; u32x2 gate[4];
#define GLA_LOAD(JN) do { const int n_ = n0 + (JN); const size_t m0_ = (size_t)b * SEQ + n_ * 64; const size_t unit_ = (size_t)(bh * 32 + n_); \
        _Pragma("unroll") for (int i = 0; i < 2; ++i) kvn[i] = ((JN) < 3) ? *(const u32x4*)(KV + unit_ * 8192 + (srow + 32 * i) * 128 + sch * 8) : (u32x4){0u, 0u, 0u, 0u}; \
        _Pragma("unroll") for (int gq = 0; gq < 4; ++gq) gate[gq] = *(const u32x2*)(proj + (m0_ + tt * 32 + l31) * PW + C_GG + hd * 128 + et * 32 + 8 * gq + 4 * hh); } while (0)
    GLA_LOAD(0);
    f32x4 gnv[4];
#pragma unroll
    for (int gq = 0; gq < 4; ++gq) gnv[gq] = *(const f32x4*)(gn + hd * 128 + et * 32 + 4 * hh + 8 * gq);
    float sst[2][8];
#pragma unroll
    for (int i = 0; i < 2; ++i)
#pragma unroll
        for (int j = 0; j < 8; ++j) sst[i][j] = 0.f;
    {
        u32x4 kvl[7][2]; float dcl[7][2];
#pragma unroll
        for (int m = 0; m < 7; ++m)
#pragma unroll
            for (int i = 0; i < 2; ++i) { const size_t u = (size_t)(bh * 8 + m);
                kvl[m][i] = (m < g) ? *(const u32x4*)(KVG + u * 8192 + (srow + 32 * i) * 128 + sch * 8) : (u32x4){0u, 0u, 0u, 0u};
                dcl[m][i] = (m < g) ? DECG[u * 64 + srow + 32 * i] : 1.f; }
#pragma unroll
        for (int m = 0; m < 7; ++m)
#pragma unroll
            for (int i = 0; i < 2; ++i)
#pragma unroll
                for (int w = 0; w < 4; ++w) { sst[i][2 * w] = dcl[m][i] * sst[i][2 * w] + lo_bf(kvl[m][i][w]); sst[i][2 * w + 1] = dcl[m][i] * sst[i][2 * w + 1] + hi_bf(kvl[m][i][w]); }
    }
#pragma unroll 1
    for (int jn = 0; jn < 4; ++jn) {
        const int n = n0 + jn;
        const size_t mt = (size_t)b * SEQ + n * 64 + tt * 32 + l31;
        LAS unsigned char* vS = lds + GLA_CH * jn; LAS unsigned char* qdS = vS + GLA_QD; LAS unsigned char* kdS = vS + GLA_KD;
#pragma unroll
        for (int i = 0; i < 2; ++i) { u32x4 sw; sw.x = cvtpk(sst[i][0], sst[i][1]); sw.y = cvtpk(sst[i][2], sst[i][3]); sw.z = cvtpk(sst[i][4], sst[i][5]); sw.w = cvtpk(sst[i][6], sst[i][7]);
            *(LAS u32x4*)(sS + off256(srow + 32 * i, sch)) = sw; }
        __syncthreads();
        if (jn < 3) {
#pragma unroll
            for (int i = 0; i < 2; ++i) { const float dc = decP[jn * 64 + srow + 32 * i];
#pragma unroll
                for (int w = 0; w < 4; ++w) { sst[i][2 * w] = dc * sst[i][2 * w] + lo_bf(kvn[i][w]); sst[i][2 * w + 1] = dc * sst[i][2 * w + 1] + hi_bf(kvn[i][w]); } }
        }
        u32x2 gcur[4];
#pragma unroll
        for (int gq = 0; gq < 4; ++gq) gcur[gq] = gate[gq];
        if (jn < 3) GLA_LOAD(jn + 1);
        bf16x8 qf[4];
#pragma unroll
        for (int kk = 0; kk < 4; ++kk) qf[kk] = *(const LAS bf16x8*)(qdS + off128(tt * 32 + l31, 2 * kk + hh));
        f32x16 ot;
#pragma unroll
        for (int r = 0; r < 16; ++r) ot[r] = 0.f;
        const int chv = et * 4 + 2 * g16 + (tp >> 1), sub = 8 * (tp & 1);
#pragma unroll
        for (int kk = 0; kk < 4; ++kk) { const int kb = 16 * kk + 8 * hh;
            const bf16x8 af = cat8(tr_read(sS + off256(kb + tq, chv) + sub), tr_read(sS + off256(kb + 4 + tq, chv) + sub));
            ot = mfma32(af, qf[kk], ot); }
#pragma unroll
        for (int st = 0; st < 2; ++st) {
            if (st <= tt) {
                f32x16 at;
#pragma unroll
                for (int r = 0; r < 16; ++r) at[r] = 0.f;
#pragma unroll
                for (int kk = 0; kk < 4; ++kk) { const bf16x8 kf = *(const LAS bf16x8*)(kdS + off128(st * 32 + l31, 2 * kk + hh)); at = mfma32(kf, qf[kk], at); }
                if (st == tt) {
#pragma unroll
                    for (int r = 0; r < 16; ++r) { const int sr = (r & 3) + 8 * (r >> 2) + 4 * hh; at[r] = (sr <= l31) ? at[r] : 0.f; }
                }
#pragma unroll
                for (int s2 = 0; s2 < 2; ++s2) { const bf16x8 pf = pack8(at, s2); const int kb = 32 * st + 16 * s2 + 4 * hh;
                    const bf16x8 vf = cat8(tr_read(vS + off256(kb + tq, chv) + sub), tr_read(vS + off256(kb + 8 + tq, chv) + sub));
                    ot = mfma32(vf, pf, ot); }
            }
        }
        float ss = 0.f;
#pragma unroll
        for (int r = 0; r < 16; ++r) ss += ot[r] * ot[r];
        ss = sum32(ss);
        if (hh == 0) ssq[et * 64 + tt * 32 + l31] = ss;
        __syncthreads();
        const int tl = tt * 32 + l31;
        const float rinv = rsqrtf(((ssq[tl] + ssq[64 + tl]) + (ssq[128 + tl] + ssq[192 + tl])) * (1.f / 128.f) + EPS);
        bf16* op = o + mt * D + hd * 128 + et * 32 + 4 * hh;
#pragma unroll
        for (int gq = 0; gq < 4; ++gq) { const f32x4 gg = gnv[gq];
            const float g0 = lo_bf(gcur[gq].x), g1 = hi_bf(gcur[gq].x), g2 = lo_bf(gcur[gq].y), g3 = hi_bf(gcur[gq].y);
            u32x2 w; w.x = cvtpk(ot[4 * gq] * rinv * gg.x * silu_f(g0), ot[4 * gq + 1] * rinv * gg.y * silu_f(g1)); w.y = cvtpk(ot[4 * gq + 2] * rinv * gg.z * silu_f(g2), ot[4 * gq + 3] * rinv * gg.w * silu_f(g3));
            *(u32x2*)(op + 8 * gq) = w; }
        __syncthreads();
    }
#undef GLA_LOAD
}
constexpr int NPH = 10;
__global__ void __launch_bounds__(NTHR, 2) mk_fwd(Args a) {
    extern __shared__ __attribute__((aligned(16))) unsigned char lds_raw[];
    LAS unsigned char* lds = (LAS unsigned char*)lds_raw;
    volatile LAS unsigned* MISC = (volatile LAS unsigned*)(lds + MISC_OFF);
    const int tid = threadIdx.x, lane = tid & 63, wave = __builtin_amdgcn_readfirstlane(tid >> 6), blk = blockIdx.x;
    if (tid < 128) MISC[tid] = 0u;
    __syncthreads();
    unsigned char* ws = a.ws;
    unsigned* ctl = (unsigned*)(ws + WS_CTL);
    const int lo = a.ph_lo, hi = a.ph_hi;
    XcdBarrier bar = xcd_barrier_post(ctl + CW_BAR + lo * XCD_BAR_WORDS, MISC);
#define IN(k) (lo <= (k) && (k) < hi)
#define SEAM(k) do { if (IN(k) && IN((k) + 1)) xcd_barrier(bar); } while (0)
    LAS int* tp = (LAS int*)(lds + 132096);

    if (IN(0)) {
        TrItem t0; f32x4 tv[8]; const int it0 = blk * NWAVES + wave; const bool h0 = it0 < 16 * 72 + 16 * 32 && tr_decode(it0, a, t0);
        if (h0) tr_load(t0, tv, lane);
        p0_adaln(lds, (const float*)a.in[1], (const float*)a.in[3], (const float*)a.in[4], (float*)(ws + WS_MODP), blk, tid);
        p0_weights(lds, a, blk, wave, lane, tid);
        if (h0) tr_finish(t0, tv, (LAS float*)(lds + 65536 + wave * 8704), lane);
    }
    SEAM(0);
    if (IN(1)) p1a_rows(lds, a, blk, wave, lane, tid);
    SEAM(1);
    if (IN(2)) {
        pg8::DenseOrder S; S.init(ws + WS_H, ws + WS_WIN, M, PW, D, GRID, blk);
        pg8::EpiBf16 E{(bf16*)(ws + WS_PROJ), PW};
        constexpr int TG0 = 16 * 72 + 16 * 32, TG1 = TG0 + 32 * 2 * 128, TGM = TG0 + 32 * 128;
        if (blk >= 128) { tr_stream(lds, a, TG0, TGM, (blk - 128) * NWAVES + wave, 128 * NWAVES, wave, lane); __syncthreads(); }
        pg8::gemm_phase<pg8::EpiBf16, pg8::DenseOrder, true>(lds, D, S, E);
        if (blk >= 128) tr_stream(lds, a, TGM, TG1, (blk - 128) * NWAVES + wave, 128 * NWAVES, wave, lane);
    }
    SEAM(2);
    if (IN(3)) {
        const bf16* proj = (const bf16*)(ws + WS_PROJ); bf16* o = (bf16*)(ws + WS_O);
        swa_unit(lds, proj, (const float*)(ws + WS_ROPE), (const float*)a.in[10], o, blk, tid, lane, wave);
        gla_kv_group(lds, proj, (const float*)a.in[8], (bf16*)(ws + WS_SG), (bf16*)(ws + WS_KVG), (float*)(ws + WS_DECG), blk >> 3, blk & 7, tid, lane, wave);
    }
    SEAM(3);
    if (IN(4)) {
        const bf16* proj = (const bf16*)(ws + WS_PROJ); bf16* o = (bf16*)(ws + WS_O);
        gla_out_block(lds, proj, (const bf16*)(ws + WS_SG), (const bf16*)(ws + WS_KVG), (const float*)(ws + WS_DECG), (const float*)a.in[9], o, blk >> 3, blk & 7, tid, lane, wave);
    }
    SEAM(4);
    if (IN(5)) {
        pg8::DenseOrder S; S.init(ws + WS_O, ws + WS_WOUT, M, D, D, GRID, blk);
        pg8::EpiX1 E{(const float*)a.in[0], (bf16*)(ws + WS_X1), (const float*)(ws + WS_MOD)};
        pg8::gemm_phase<pg8::EpiX1, pg8::DenseOrder, false>(lds, D, S, E);
    }
    SEAM(5);
    if (IN(6)) p3b_route(lds, a, blk, wave, lane, tid);
    SEAM(6);
    if (IN(7)) {
        moe_prefix(tp, (const int*)ctl + CW_CNT, tid);
        pg8::MoeOrder<true> S; S.A = (const char*)(ws + WS_H); S.Bt = (const char*)(ws + WS_WGU); S.K = D; S.npn = 2; S.G = GRID; S.c = blk; S.bstride = (size_t)512 * D * 2;
        S.tp = tp; S.cnt = (const int*)ctl + CW_CNT; S.list = (const int*)(ws + WS_ROUTE);
        pg8::EpiAct E{(bf16*)(ws + WS_PROJ), (const int*)ctl + CW_CNT, (const float*)(ws + WS_ROUTE + 2 * MiB), tp};
        pg8::gemm_phase<pg8::EpiAct, pg8::MoeOrder<true>, true>(lds, D, S, E);
        if (blk >= 128) tr_stream(lds, a, 16 * 72 + 16 * 32 + 32 * 2 * 128, 16 * 72 + 16 * 32 + 32 * 2 * 128 + 32 * 128, (blk - 128) * NWAVES + wave, 128 * NWAVES, wave, lane);
    }
    SEAM(7);
    if (IN(8)) {
        moe_prefix(tp, (const int*)ctl + CW_CNT, tid);
        pg8::MoeOrder<false> S; S.A = (const char*)(ws + WS_PROJ); S.Bt = (const char*)(ws + WS_WD); S.K = 256; S.npn = 4; S.G = GRID; S.c = blk; S.bstride = (size_t)D * 256 * 2;
        S.tp = tp; S.cnt = (const int*)ctl + CW_CNT; S.list = (const int*)(ws + WS_ROUTE);
        pg8::EpiDown E{(bf16*)(ws + WS_Y2), (const int*)ctl + CW_CNT, (const int*)(ws + WS_ROUTE)};
        pg8::gemm_phase<pg8::EpiDown, pg8::MoeOrder<false>, true>(lds, 256, S, E);
    }
    SEAM(8);
    if (IN(9)) p6_final(lds, a, blk, wave, lane, tid);
#undef IN
#undef SEAM
}

extern "C" void kernel_launch(void* const* d_in, const int* in_sizes, int n_in, void* d_out, int out_size, void* d_ws, size_t ws_size, hipStream_t stream) {
    static int grid = 0;
    if (grid == 0) {
        if (n_in != 21 || in_sizes[0] != M * D || out_size != M * D || ws_size < WS_END) { fprintf(stderr, "kernel_launch: unexpected shapes (n_in %d, in0 %d, out %d, ws %zu)\n", n_in, n_in > 0 ? in_sizes[0] : -1, out_size, ws_size); grid = -1; return; }
        int dev = 0, cus = 0, per_cu = 0;
        if (hipGetDevice(&dev) != hipSuccess || hipDeviceGetAttribute(&cus, hipDeviceAttributeMultiprocessorCount, dev) != hipSuccess) { fprintf(stderr, "kernel_launch: device query failed\n"); grid = -1; return; }
        if (hipFuncSetAttribute((const void*)mk_fwd, hipFuncAttributeMaxDynamicSharedMemorySize, LDS_BYTES) != hipSuccess) { fprintf(stderr, "kernel_launch: hipFuncSetAttribute failed\n"); grid = -1; return; }
        if (hipOccupancyMaxActiveBlocksPerMultiprocessor(&per_cu, (const void*)mk_fwd, NTHR, LDS_BYTES) != hipSuccess || per_cu < 1) { fprintf(stderr, "kernel_launch: occupancy query says %d workgroups per CU\n", per_cu); grid = -1; return; }
        if (cus * per_cu < GRID) { fprintf(stderr, "kernel_launch: needs %d co-resident workgroups, device holds %d x %d\n", GRID, cus, per_cu); grid = -1; return; }
        grid = GRID;
    }
    if (grid < 0) return;
    (void)hipMemsetAsync((char*)d_ws + WS_CTL, 0, CTL_ZERO_BYTES, stream);
    Args a{};
    for (int i = 0; i < 21; ++i) a.in[i] = d_in[i];
    a.out = (float*)d_out; a.ws = (unsigned char*)d_ws;
    for (int i = 0; i < 8; ++i) a.rt.inv_freq[i] = (float)pow(500000.0, -(double)(2 * i) / 16.0);
    a.ph_lo = 0; a.ph_hi = NPH;
    void* args[] = {&a};
    const hipError_t e = hipLaunchCooperativeKernel((const void*)mk_fwd, dim3(GRID), dim3(NTHR), args, LDS_BYTES, stream);
    if (e != hipSuccess) fprintf(stderr, "kernel_launch: cooperative launch failed: %s\n", hipGetErrorString(e));
}
```

```cpp
#include <hip/hip_runtime.h>
#include <cstdio>
#include <cstdint>
#include <cmath>

typedef unsigned short bf16;
typedef float f32x4 __attribute__((ext_vector_type(4)));
typedef float f32x2 __attribute__((ext_vector_type(2)));
typedef float f32x16 __attribute__((ext_vector_type(16)));
typedef unsigned u32x4 __attribute__((ext_vector_type(4)));
typedef unsigned u32x2 __attribute__((ext_vector_type(2)));
typedef short bf16x8 __attribute__((ext_vector_type(8)));
#define GAS __attribute__((address_space(1)))
#define LAS __attribute__((address_space(3)))

__device__ __forceinline__ float bf2f(bf16 v) { return __uint_as_float(((unsigned)v) << 16); }
__device__ __forceinline__ unsigned f2bf(float f) { unsigned u = __float_as_uint(f); return (u + 0x7fffu + ((u >> 16) & 1u)) >> 16; }
typedef float f32x2_t __attribute__((ext_vector_type(2))); typedef __bf16 bf16x2_t __attribute__((ext_vector_type(2)));
__device__ __forceinline__ unsigned pk2(float lo, float hi) { const f32x2_t v = {lo, hi}; const bf16x2_t b = __builtin_convertvector(v, bf16x2_t); return __builtin_bit_cast(unsigned, b); }
__device__ __forceinline__ float lo_bf16(unsigned w) { return __uint_as_float(w << 16); }
__device__ __forceinline__ float hi_bf16(unsigned w) { return __uint_as_float(w & 0xffff0000u); }
__device__ __forceinline__ float silu_f(float v) { return v * __builtin_amdgcn_rcpf(1.f + __expf(-v)); }
template <int CTRL> __device__ __forceinline__ float dpp_mov(float v) { return __int_as_float(__builtin_amdgcn_update_dpp(0, __float_as_int(v), CTRL, 0xF, 0xF, true)); }
__device__ __forceinline__ float wave_sum(float v) {
    v += dpp_mov<0xB1>(v); v += dpp_mov<0x4E>(v); v += dpp_mov<0x141>(v); v += dpp_mov<0x140>(v);
    const float r0 = __int_as_float(__builtin_amdgcn_readlane(__float_as_int(v), 0)), r1 = __int_as_float(__builtin_amdgcn_readlane(__float_as_int(v), 16));
    const float r2 = __int_as_float(__builtin_amdgcn_readlane(__float_as_int(v), 32)), r3 = __int_as_float(__builtin_amdgcn_readlane(__float_as_int(v), 48));
    return (r0 + r1) + (r2 + r3);
}

constexpr int NB = 8, SEQ = 2048, D = 1024, M = NB * SEQ;
constexpr int PW = 2560;
constexpr int C_GQ = 0, C_GK = 256, C_GV = 512, C_GG = 1024, C_SQ = 1536, C_SK = 2048, C_SV = 2176, C_Z = 2304;
constexpr int INW = 2320;
constexpr float EPS = 1e-6f;
constexpr int NEXP = 32, LCAP = 16384;
constexpr int NWAVES = 8, NTHR = 512, GRID = 256;

constexpr size_t MiB = 1u << 20;
constexpr size_t WS_CTL = 0, CTL_ZERO_BYTES = 256 * 1024;
constexpr int CW_CNT = 0, CNT_STRIDE = 64, CW_BAR = 4096;
constexpr size_t WS_MODP = 1 * MiB;
constexpr size_t WS_MOD = 2 * MiB + 512 * 1024;
constexpr size_t WS_ROPE = 3 * MiB;
constexpr size_t WS_WIN = 4 * MiB;
constexpr size_t WS_WOUT = 10 * MiB;
constexpr size_t WS_WGU = 12 * MiB;
constexpr size_t WS_WD = 44 * MiB;
constexpr size_t WS_ROUTE = 60 * MiB;
constexpr size_t WS_H = 64 * MiB;
constexpr size_t WS_SG = 208 * MiB;
constexpr size_t WS_O = 96 * MiB;
constexpr size_t WS_PROJ = 128 * MiB;
constexpr size_t WS_X1 = 160 * MiB;
constexpr size_t WS_Y2 = 64 * MiB;
constexpr size_t WS_DEC = 224 * MiB;
constexpr size_t WS_KVG = 225 * MiB;
constexpr size_t WS_DECG = 229 * MiB;
constexpr size_t WS_WRB = 230 * MiB;
constexpr size_t WS_END = 231 * MiB;

constexpr int LDS_BYTES = 163840;
constexpr int MISC_OFF = LDS_BYTES - 512;
namespace pg8 {
#define PG8_LAS __attribute__((address_space(3)))
constexpr int BM = 256, BK = 64, HALF = 128, HTB = HALF * BK * 2  , STAGE_BYTES = 8 * HTB, NXCD = 8, WGM = 8;

__host__ __device__ __forceinline__ int lds_byte(int r, int c) { const int st = (r >> 4) * 2 + (c >> 5), rr = r & 15, cc = c & 31, ob = rr * 64 + cc * 2; return st * 1024 + (ob ^ (((ob >> 9) & 1) << 5)); }
__host__ __device__ __forceinline__ void stage_rc(int b, int& R, int& C) { const int st = b / 1024, sb = b % 1024, swz = sb ^ (((sb >> 9) & 1) << 5); R = (st >> 1) * 16 + swz / 64; C = (st & 1) * 32 + (swz % 64) / 2; }
__host__ __device__ __forceinline__ int perm32(int rho) { const int n = rho >> 4, i = rho & 15; return 8 * (i >> 2) + 4 * n + (i & 3); }

struct Unit { const char* A; const char* B; int i0, i1, i2, qm; };

__device__ __forceinline__ int xcd_remap(int wgid, int nwg) { const int q = nwg / NXCD, r = nwg % NXCD, xcd = wgid % NXCD, off = wgid / NXCD; return (xcd < r ? xcd * (q + 1) : r * (q + 1) + (xcd - r) * q) + off; }

struct DenseOrder {
    const char* A; const char* Bt; int K, nM, nN, nwg, G, c;
    __device__ void init(const void* A_, const void* Bt_, int M, int N, int K_, int G_, int c_) { A = (const char*)A_; Bt = (const char*)Bt_; K = K_; nM = M / BM; nN = N / BM; nwg = nM * nN; G = G_; c = c_; }
    __device__ __forceinline__ bool next(int i, Unit& u) const {
        const int L = i * G + c; if (L >= nwg) return false;
        const int wgid = xcd_remap(L, nwg);
        const int nig = WGM * nN, gid = wgid / nig, fm = gid * WGM, gsz = (nM - fm) < WGM ? (nM - fm) : WGM;
        const int pm = fm + ((wgid % nig) % gsz), pn = (wgid % nig) / gsz;
        u.A = A + (size_t)pm * BM * K * 2; u.B = Bt + (size_t)pn * BM * K * 2; u.i0 = pm; u.i1 = pn; u.i2 = 0; u.qm = 15; return true;
    }
    __device__ __forceinline__ void a_voff(const Unit&, const int (&R)[2], const int (&C)[2], unsigned (&v)[2][2]) const {
#pragma unroll
        for (int h = 0; h < 2; ++h)
#pragma unroll
            for (int i = 0; i < 2; ++i) v[h][i] = (unsigned)((h * HALF + R[i]) * K + C[i]) * 2u;
    }
};

template <bool GATHER> struct MoeOrder {
    const char* A; const char* Bt; int K, npn, G, c; size_t bstride; const PG8_LAS int* tp; const int* cnt; const int* list;
    __device__ __forceinline__ bool next(int i, Unit& u) const {
        const int ntile = tp[32], nwg = ntile * npn, nfr = nwg / G, nfull = nfr * G, R = nwg - nfull, f = (4 * R <= G) ? 4 : (2 * R <= G) ? 2 : 1;
        int L, qm;
        if (i < nfr) { L = i * G + c; qm = 15; }
        else { if (i > nfr) return false;
            const int P = (f * R + 7) >> 3, x = c & 7, y = c >> 3, j = x * P + y;
            if (y >= P || j >= f * R) return false; L = nfull + j / f; qm = f == 4 ? (1 << (j & 3)) : f == 2 ? ((j & 1) ? 10 : 5) : 15; }
        u.qm = __builtin_amdgcn_readfirstlane(qm);
        const int wgid = xcd_remap(L, nwg); const int T = wgid / npn, pn = wgid % npn;
        const int e = tp[40 + T];
        u.i0 = e; u.i1 = T - tp[e]; u.i2 = pn;
        u.A = GATHER ? A : A + (size_t)T * BM * K * 2; u.B = Bt + (size_t)e * bstride + (size_t)pn * BM * K * 2; return true;
    }
    __device__ __forceinline__ void a_voff(const Unit& u, const int (&R)[2], const int (&C)[2], unsigned (&v)[2][2]) const {
        if (GATHER) {
            const int n = tp[208 + u.i0]; int tk[2][2];
#pragma unroll
            for (int h = 0; h < 2; ++h)
#pragma unroll
                for (int i = 0; i < 2; ++i) { const int r = u.i1 * BM + h * HALF + R[i]; tk[h][i] = (r < n) ? list[u.i0 * 16384 + r] : 0; }
            asm volatile("s_waitcnt vmcnt(0)" ::: "memory");
#pragma unroll
            for (int h = 0; h < 2; ++h)
#pragma unroll
                for (int i = 0; i < 2; ++i) v[h][i] = (unsigned)((tk[h][i] >> 1) * K + C[i]) * 2u;
            asm volatile("" : "+v"(v[0][0]), "+v"(v[0][1]), "+v"(v[1][0]), "+v"(v[1][1]));
        } else {
#pragma unroll
            for (int h = 0; h < 2; ++h)
#pragma unroll
                for (int i = 0; i < 2; ++i) v[h][i] = (unsigned)((h * HALF + R[i]) * K + C[i]) * 2u;
        }
    }
};

__device__ __forceinline__ unsigned cvt_pk_bf16(float lo, float hi) { unsigned r; asm volatile("v_cvt_pk_bf16_f32 %0, %1, %2" : "=v"(r) : "v"(lo), "v"(hi)); return r; }

struct EpiBf16 {
    static constexpr bool PERM = true;
    bf16* O; int ldc;
    __device__ __forceinline__ void operator()(const f32x4 (&acc)[2][2][4][2], const Unit& u, int wr, int wc, int fr, int fq) const {
        const int row0 = u.i0 * BM + wr * 64 + fr; const int col0 = u.i1 * BM + wc * 32 + 8 * fq;
#pragma unroll
        for (int ai = 0; ai < 2; ++ai)
#pragma unroll
            for (int m = 0; m < 4; ++m) { bf16* rowp = O + (size_t)(row0 + ai * HALF + m * 16) * ldc + col0;
#pragma unroll
                for (int bj = 0; bj < 2; ++bj) { const f32x4 v0 = acc[ai][bj][m][0], v1 = acc[ai][bj][m][1];
                    u32x4 w; w.x = cvt_pk_bf16(v0[0], v0[1]); w.y = cvt_pk_bf16(v0[2], v0[3]); w.z = cvt_pk_bf16(v1[0], v1[1]); w.w = cvt_pk_bf16(v1[2], v1[3]);
                    *(u32x4*)(rowp + bj * HALF) = w; } }
    }
};

struct EpiX1 {
    static constexpr bool PERM = true;
    const float* x; bf16* out; const float* mod;
    __device__ __forceinline__ void operator()(const f32x4 (&acc)[2][2][4][2], const Unit& u, int wr, int wc, int fr, int fq) const {
        const int row0 = u.i0 * BM + wr * 64 + fr; const int col0 = u.i1 * BM + wc * 32 + 8 * fq;
        const float* gt = mod + (u.i0 >> 3) * 6144 + 2048;
        f32x4 gv[2][2];
#pragma unroll
        for (int bj = 0; bj < 2; ++bj)
#pragma unroll
            for (int n = 0; n < 2; ++n) gv[bj][n] = *(const f32x4*)(gt + col0 + bj * HALF + 4 * n);
#pragma unroll
        for (int ai = 0; ai < 2; ++ai) {
            f32x4 xv[4][2][2];
#pragma unroll
            for (int m = 0; m < 4; ++m) { const size_t off = (size_t)(row0 + ai * HALF + m * 16) * 1024 + col0;
#pragma unroll
                for (int bj = 0; bj < 2; ++bj) { xv[m][bj][0] = *(const f32x4*)(x + off + bj * HALF); xv[m][bj][1] = *(const f32x4*)(x + off + bj * HALF + 4); } }
            asm volatile("" ::: "memory");
#pragma unroll
            for (int m = 0; m < 4; ++m) { const size_t off = (size_t)(row0 + ai * HALF + m * 16) * 1024 + col0;
#pragma unroll
                for (int bj = 0; bj < 2; ++bj) { const f32x4 v0 = xv[m][bj][0] + gv[bj][0] * acc[ai][bj][m][0], v1 = xv[m][bj][1] + gv[bj][1] * acc[ai][bj][m][1];
                    u32x4 w; w.x = cvt_pk_bf16(v0[0], v0[1]); w.y = cvt_pk_bf16(v0[2], v0[3]); w.z = cvt_pk_bf16(v1[0], v1[1]); w.w = cvt_pk_bf16(v1[2], v1[3]);
                    *(u32x4*)(out + off + bj * HALF) = w; } }
        }
    }
};

struct EpiAct {
    static constexpr bool PERM = false;
    bf16* act; const int* cnt; const float* lw; const PG8_LAS int* tp;
    __device__ __forceinline__ void operator()(const f32x4 (&acc)[2][2][4][2], const Unit& u, int wr, int wc, int fr, int fq) const {
        const int e = u.i0, n_e = tp[208 + e]; const int rl0 = u.i1 * BM + wr * 64 + fr; const size_t rbase = (size_t)(tp[e] + u.i1) * BM + wr * 64 + fr;
        const int f0 = u.i2 * 128 + wc * 16 + 4 * fq;
        float wrow[2][4];
#pragma unroll
        for (int ai = 0; ai < 2; ++ai)
#pragma unroll
            for (int m = 0; m < 4; ++m) { const int rl = rl0 + ai * HALF + m * 16; wrow[ai][m] = (rl < n_e) ? lw[e * 16384 + rl] : 0.f; }
        asm volatile("" ::: "memory");
#pragma unroll
        for (int ai = 0; ai < 2; ++ai)
#pragma unroll
            for (int m = 0; m < 4; ++m) { const int rl = rl0 + ai * HALF + m * 16;
                if (rl < n_e) { const float w = wrow[ai][m]; bf16* rowp = act + (rbase + ai * HALF + m * 16) * 256 + f0;
#pragma unroll
                    for (int bj = 0; bj < 2; ++bj) if ((u.qm >> (2 * ai + bj)) & 1) { const f32x4 g = acc[ai][bj][m][0], up = acc[ai][bj][m][1]; u32x2 o;
                        o.x = cvt_pk_bf16(silu_f(g[0]) * up[0] * w, silu_f(g[1]) * up[1] * w); o.y = cvt_pk_bf16(silu_f(g[2]) * up[2] * w, silu_f(g[3]) * up[3] * w);
                        *(u32x2*)(rowp + bj * 64) = o; } } }
    }
};

struct EpiDown {
    static constexpr bool PERM = true;
    bf16* y2; const int* cnt; const int* list; const PG8_LAS int* tp;
    __device__ __forceinline__ void operator()(const f32x4 (&acc)[2][2][4][2], const Unit& u, int wr, int wc, int fr, int fq) const {
        const int e = u.i0, n_e = tp[208 + e]; const int rl0 = u.i1 * BM + wr * 64 + fr; const int col0 = u.i2 * BM + wc * 32 + 8 * fq;
        int tkr[2][4];
#pragma unroll
        for (int ai = 0; ai < 2; ++ai)
#pragma unroll
            for (int m = 0; m < 4; ++m) { const int rl = rl0 + ai * HALF + m * 16; tkr[ai][m] = (rl < n_e) ? list[e * 16384 + rl] : -1; }
        asm volatile("" ::: "memory");
#pragma unroll
        for (int ai = 0; ai < 2; ++ai)
#pragma unroll
            for (int m = 0; m < 4; ++m) { const int tk = tkr[ai][m];
                if (tk >= 0) { bf16* rowp = y2 + (size_t)tk * 1024 + col0;
#pragma unroll
                    for (int bj = 0; bj < 2; ++bj) if ((u.qm >> (2 * ai + bj)) & 1) { const f32x4 v0 = acc[ai][bj][m][0], v1 = acc[ai][bj][m][1];
                        u32x4 w; w.x = cvt_pk_bf16(v0[0], v0[1]); w.y = cvt_pk_bf16(v0[2], v0[3]); w.z = cvt_pk_bf16(v1[0], v1[1]); w.w = cvt_pk_bf16(v1[2], v1[3]);
                        *(u32x4*)(rowp + bj * HALF) = w; } } }
    }
};

template <class Epi, class Sched, bool ALIGN_EPI>
__device__ __forceinline__ void gemm_phase(PG8_LAS unsigned char* lds, const int K, const Sched& S, const Epi& E) {
    const int tid = threadIdx.x, wid = __builtin_amdgcn_readfirstlane(tid >> 6), lane = tid & 63, wr = wid >> 2, wc = wid & 3, fr = lane & 15, fq = lane >> 4;
    const int nt = K / BK;
    int Rr[2], Cc[2]; unsigned voffB[2];
#pragma unroll
    for (int i = 0; i < 2; ++i) { int R, C; stage_rc(tid * 16 + i * 8192, R, C); Rr[i] = R; Cc[i] = C; const int Rb = Epi::PERM ? ((R & ~31) + perm32(R & 31)) : R; voffB[i] = (unsigned)(Rb * K + C) * 2u; }
    const size_t kstep = (size_t)(BK * 2);
    const size_t hstep = (size_t)HALF * K * 2;
    const unsigned ldsw = (unsigned)wid * 1024u;
    const int aoff = lds_byte(wr * 64 + fr, fq * 8), boff = lds_byte(wc * 32 + fr, fq * 8);
#define PG8_SA(b, h) (((b) * 2 + (h)) * HTB)
#define PG8_SB(b, h) ((4 + (b) * 2 + (h)) * HTB)
#define PG8_STG(bufoff, gbase, v0, v1) do { \
        __builtin_amdgcn_global_load_lds((const unsigned*)((const char*)(gbase) + (v0)), (PG8_LAS unsigned*)(lds + (bufoff) + ldsw), 16, 0, 0); \
        __builtin_amdgcn_global_load_lds((const unsigned*)((const char*)(gbase) + (v1)), (PG8_LAS unsigned*)(lds + (bufoff) + ldsw + 8192), 16, 0, 0); } while (0)
#define PG8_STGB(bufoff, gbase) PG8_STG(bufoff, gbase, voffB[0], voffB[1])
#define PG8_LDA(dst, b, h) do { _Pragma("unroll") for (int m = 0; m < 4; ++m) _Pragma("unroll") for (int k = 0; k < 2; ++k) dst[m][k] = *(const PG8_LAS bf16x8*)(lds + PG8_SA(b, h) + aoff + m * 2048 + k * 1024); } while (0)
#define PG8_LDB(dst, b, h) do { _Pragma("unroll") for (int n = 0; n < 2; ++n) _Pragma("unroll") for (int k = 0; k < 2; ++k) dst[n][k] = *(const PG8_LAS bf16x8*)(lds + PG8_SB(b, h) + boff + n * 2048 + k * 1024); } while (0)
#define PG8_MMA(ai, bj, At, Bt) do { __builtin_amdgcn_s_setprio(1); _Pragma("unroll") for (int m = 0; m < 4; ++m) _Pragma("unroll") for (int n = 0; n < 2; ++n) _Pragma("unroll") for (int k = 0; k < 2; ++k) \
        acc[ai][bj][m][n] = __builtin_amdgcn_mfma_f32_16x16x32_bf16(Bt[n][k], At[m][k], acc[ai][bj][m][n], 0, 0, 0); __builtin_amdgcn_s_setprio(0); } while (0)
#define PG8_WAIT_V(n) asm volatile("s_waitcnt vmcnt(" #n ")" ::: "memory")
#define PG8_WAIT_L(n) asm volatile("s_waitcnt lgkmcnt(" #n ")" ::: "memory")
#define PG8_BAR __builtin_amdgcn_s_barrier()
#define PG8_SCHED __builtin_amdgcn_sched_barrier(0)
    Unit cur, nxt; int ui = 0;
    if (!S.next(0, cur)) return;
    unsigned cv[2][2], nv[2][2];
    S.a_voff(cur, Rr, Cc, cv);
#define PG8_QFIX(qm, v) do { if (!((qm) & 3)) { v[0][0] = v[1][0]; v[0][1] = v[1][1]; } if (!((qm) & 12)) { v[1][0] = v[0][0]; v[1][1] = v[0][1]; } } while (0)
    PG8_QFIX(cur.qm, cv);
    size_t chb0 = (cur.qm & 5) ? 0 : hstep, chb1 = (cur.qm & 10) ? hstep : 0;
    f32x4 acc[2][2][4][2];
#pragma unroll
    for (int a = 0; a < 2; ++a)
#pragma unroll
        for (int b = 0; b < 2; ++b)
#pragma unroll
            for (int m = 0; m < 4; ++m)
#pragma unroll
                for (int n = 0; n < 2; ++n) acc[a][b][m][n] = (f32x4){0.f, 0.f, 0.f, 0.f};
    bf16x8 At[4][2], B0[2][2], B1[2][2];
    const char* cA = cur.A; const char* cB = cur.B;
    PG8_STGB(PG8_SB(0, 0), cB + chb0); PG8_STGB(PG8_SB(0, 1), cB + chb1); PG8_STG(PG8_SA(0, 0), cA, cv[0][0], cv[0][1]); PG8_STG(PG8_SA(0, 1), cA, cv[1][0], cv[1][1]);
    if (wr == 1) PG8_BAR;
    PG8_WAIT_V(2); PG8_BAR;
    PG8_STGB(PG8_SB(1, 0), cB + chb0 + kstep); PG8_STG(PG8_SA(1, 0), cA + kstep, cv[0][0], cv[0][1]); PG8_STGB(PG8_SB(1, 1), cB + chb1 + kstep);
    PG8_WAIT_V(6); PG8_BAR;
    for (;;) {
        const bool has_next = S.next(ui + 1, nxt);
        if (has_next) { S.a_voff(nxt, Rr, Cc, nv); PG8_QFIX(nxt.qm, nv); }
        else { nv[0][0] = cv[0][0]; nv[0][1] = cv[0][1]; nv[1][0] = cv[1][0]; nv[1][1] = cv[1][1]; }
        const char* nA = has_next ? nxt.A : cA; const char* nB = has_next ? nxt.B : cB;
        const size_t nhb0 = has_next ? ((nxt.qm & 5) ? 0 : hstep) : chb0, nhb1 = has_next ? ((nxt.qm & 10) ? hstep : 0) : chb1;
        const bool q00 = cur.qm & 1, q01 = cur.qm & 2, q10 = cur.qm & 4, q11 = cur.qm & 8;
#pragma unroll 1
        for (int t = 0; t < nt; t += 2) {
            const bool last = (t == nt - 2);
            const char* a1 = cA + (size_t)(t + 1) * kstep;
            const char* a2 = last ? nA : cA + (size_t)(t + 2) * kstep; const char* b2 = last ? nB : cB + (size_t)(t + 2) * kstep;
            const char* a3 = a2 + kstep; const char* b3 = b2 + kstep;
            const size_t h0 = last ? nhb0 : chb0, h1 = last ? nhb1 : chb1;
            const unsigned x00 = last ? nv[0][0] : cv[0][0], x01 = last ? nv[0][1] : cv[0][1], x10 = last ? nv[1][0] : cv[1][0], x11 = last ? nv[1][1] : cv[1][1];
            PG8_LDB(B0, 0, 0); PG8_LDB(B1, 0, 1); PG8_SCHED; PG8_LDA(At, 0, 0); PG8_STG(PG8_SA(1, 1), a1, cv[1][0], cv[1][1]);
            PG8_WAIT_V(8); PG8_WAIT_L(0); PG8_BAR; if (q00) PG8_MMA(0, 0, At, B0); if (q01) PG8_MMA(0, 1, At, B1); PG8_BAR; PG8_SCHED;
            PG8_LDA(At, 0, 1); PG8_STGB(PG8_SB(0, 0), b2 + h0); PG8_STGB(PG8_SB(0, 1), b2 + h1); PG8_STG(PG8_SA(0, 0), a2, x00, x01);
            PG8_WAIT_V(8); PG8_WAIT_L(0); PG8_BAR; if (q10) PG8_MMA(1, 0, At, B0); if (q11) PG8_MMA(1, 1, At, B1); PG8_BAR; PG8_SCHED;
            PG8_LDB(B0, 1, 0); PG8_LDB(B1, 1, 1); PG8_SCHED; PG8_LDA(At, 1, 0); PG8_STG(PG8_SA(0, 1), a2, x10, x11);
            PG8_WAIT_V(8); PG8_WAIT_L(0); PG8_BAR; if (q00) PG8_MMA(0, 0, At, B0); if (q01) PG8_MMA(0, 1, At, B1); PG8_BAR; PG8_SCHED;
            PG8_LDA(At, 1, 1); PG8_STGB(PG8_SB(1, 0), b3 + h0); PG8_STGB(PG8_SB(1, 1), b3 + h1); PG8_STG(PG8_SA(1, 0), a3, x00, x01);
            PG8_WAIT_V(8); PG8_WAIT_L(0); PG8_BAR; if (q10) PG8_MMA(1, 0, At, B0); if (q11) PG8_MMA(1, 1, At, B1); PG8_BAR; PG8_SCHED;
        }
        if constexpr (ALIGN_EPI) { if (wr == 0) PG8_BAR; }
        E(acc, cur, wr, wc, fr, fq);
        if (!has_next) break;
#pragma unroll
        for (int a = 0; a < 2; ++a)
#pragma unroll
            for (int b = 0; b < 2; ++b)
#pragma unroll
                for (int m = 0; m < 4; ++m)
#pragma unroll
                    for (int n = 0; n < 2; ++n) acc[a][b][m][n] = (f32x4){0.f, 0.f, 0.f, 0.f};
        cur = nxt; cA = nA; cB = nB; ++ui; chb0 = nhb0; chb1 = nhb1;
        cv[0][0] = nv[0][0]; cv[0][1] = nv[0][1]; cv[1][0] = nv[1][0]; cv[1][1] = nv[1][1];
        if constexpr (ALIGN_EPI) { if (wr == 1) PG8_BAR; }
    }
    PG8_WAIT_V(0);
    if constexpr (!ALIGN_EPI) { if (wr == 0) PG8_BAR; }
    PG8_BAR;
#undef PG8_SA
#undef PG8_QFIX
#undef PG8_SB
#undef PG8_STG
#undef PG8_STGB
#undef PG8_LDA
#undef PG8_LDB
#undef PG8_MMA
#undef PG8_WAIT_V
#undef PG8_WAIT_L
#undef PG8_BAR
#undef PG8_SCHED
}
}
#define XB_TMO      128
#define XB_XCNT(j)  (256  + 64 * (j))
#define XB_XSUB(j)  (1280 + 64 * (j))
#define XB_XGEN(j)  (2304 + 64 * (j))
#define XB_TOP      3328
#define XB_TOPGEN   3392
#define XCD_BAR_WORDS 3456
#define XB_SPIN_CAP (1u << 18)

__device__ __forceinline__ unsigned xb_ld(unsigned* p)              { return __hip_atomic_load(p, __ATOMIC_RELAXED, __HIP_MEMORY_SCOPE_AGENT); }
__device__ __forceinline__ unsigned xb_add(unsigned* p, unsigned v) { return __hip_atomic_fetch_add(p, v, __ATOMIC_RELAXED, __HIP_MEMORY_SCOPE_AGENT); }
__device__ __forceinline__ unsigned xb_xcc_id() { return (unsigned)__builtin_amdgcn_s_getreg((3 << 11) | 20) & 0xFu; }
#define XB_SPIN(cond, bar) do { unsigned _sp = 0; while (cond) { __builtin_amdgcn_s_sleep(1); \
    if ((++_sp & 255u) == 0u) { if (xb_ld(&(bar)[XB_TMO])) break; if (_sp > XB_SPIN_CAP) { atomicAdd(&(bar)[XB_TMO], 1u); break; } } } } while (0)

struct XcdBarrier {
    unsigned* bar; unsigned x;
    volatile LAS unsigned* st;
};

__device__ __forceinline__ XcdBarrier xcd_barrier_post(unsigned* bar, volatile LAS unsigned* st) {
    XcdBarrier b; b.bar = bar; b.x = xb_xcc_id(); b.st = st;
    if (threadIdx.x == 0) (void)xb_add(&bar[XB_XCNT(b.x)], 1u);
    return b;
}
__device__ __forceinline__ void xcd_barrier_complete(unsigned* bar, unsigned x, unsigned& nloc, unsigned& nx) {
    const unsigned G = gridDim.x * gridDim.y * gridDim.z;
    unsigned sum, cnt, mine, sp = 0u;
    for (;;) {
        sum = 0u; cnt = 0u; mine = 0u;
#pragma unroll
        for (unsigned j = 0; j < 16; ++j) { const unsigned c = xb_ld(&bar[XB_XCNT(j)]); sum += c; cnt += (c > 0u) ? 1u : 0u; mine = (j == x) ? c : mine; }
        if (sum == G) break;
        __builtin_amdgcn_s_sleep(1);
        if ((++sp & 255u) == 0u) { if (xb_ld(&bar[XB_TMO])) break; if (sp > XB_SPIN_CAP) { atomicAdd(&bar[XB_TMO], 1u); break; } }
    }
    nloc = mine > 0u ? mine : 1u; nx = cnt > 0u ? cnt : 1u;
}

__device__ __forceinline__ void xcd_barrier(const XcdBarrier& b) {
    asm volatile("s_waitcnt vmcnt(0)" ::: "memory");
    __syncthreads();
    if (threadIdx.x == 0) {
        unsigned* bar = b.bar;
        __builtin_amdgcn_s_waitcnt(0);
        unsigned nloc = b.st[0], nx = b.st[1];
        if (nloc == 0u) { xcd_barrier_complete(bar, b.x, nloc, nx); b.st[0] = nloc; b.st[1] = nx; }
        const unsigned old = xb_add(&bar[XB_XSUB(b.x)], 1u);
        const unsigned gen = old / nloc;
        if (old + 1u == (gen + 1u) * nloc) {
            __builtin_amdgcn_fence(__ATOMIC_RELEASE, "agent");
            asm volatile("s_waitcnt vmcnt(0)" ::: "memory");
            const unsigned og = xb_add(&bar[XB_TOP], 1u);
            const unsigned tg = og / nx;
            if (og + 1u == (tg + 1u) * nx) xb_add(&bar[XB_TOPGEN], 1u);
            else XB_SPIN(xb_ld(&bar[XB_TOPGEN]) == tg, bar);
            __builtin_amdgcn_fence(__ATOMIC_ACQUIRE, "agent");
            xb_add(&bar[XB_XGEN(b.x)], 1u);
            asm volatile("s_waitcnt vmcnt(0)" ::: "memory");
        } else {
            __builtin_amdgcn_fence(__ATOMIC_ACQUIRE, "agent");
            XB_SPIN(xb_ld(&bar[XB_XGEN(b.x)]) == gen, bar);
            asm volatile("s_waitcnt vmcnt(0)" ::: "memory");
        }
    }
    __syncthreads();
}
struct RopeTab { float inv_freq[8]; };
struct Args { const void* in[21]; float* out; unsigned char* ws; int ph_lo, ph_hi; RopeTab rt; };

__device__ __forceinline__ void p0_adaln(LAS unsigned char* lds, const float* c, const float* ada_w, const float* ada_b, float* modp, int blk, int tid) {
    LAS float* ca = (LAS float*)lds;
    LAS float* red = (LAS float*)(lds + 4096);
    const int kc = blk >> 5, cc = blk & 31;
    for (int i = tid; i < 1024; i += NTHR) { const int b = i >> 7, k = i & 127; ca[i] = silu_f(c[b * D + kc * 128 + k]); }
    __syncthreads();
    if (tid < 480) {
        const int cq = tid % 48, kr = tid / 48;
        f32x4 acc[8];
#pragma unroll
        for (int b = 0; b < 8; ++b) acc[b] = (f32x4){0.f, 0.f, 0.f, 0.f};
        const float* wp = ada_w + (size_t)(kc * 128) * 6144 + cc * 192 + cq * 4;
        f32x4 wv[13];
#pragma unroll
        for (int i = 0; i < 13; ++i) { const int k = kr + 10 * i; wv[i] = (k < 128) ? *(const f32x4*)(wp + (size_t)k * 6144) : (f32x4){0.f, 0.f, 0.f, 0.f}; }
#pragma unroll
        for (int i = 0; i < 13; ++i) { const int k = (kr + 10 * i) & 127;
#pragma unroll
            for (int b = 0; b < 8; ++b) acc[b] += wv[i] * ca[b * 128 + k]; }
#pragma unroll
        for (int b = 0; b < 8; ++b) *(LAS f32x4*)(red + (kr * 8 + b) * 192 + cq * 4) = acc[b];
    }
    __syncthreads();
    if (tid < 384) { const int b = tid / 48, cq = tid % 48; f32x4 s = (f32x4){0.f, 0.f, 0.f, 0.f};
#pragma unroll
        for (int kr = 0; kr < 10; ++kr) s += *(const LAS f32x4*)(red + (kr * 8 + b) * 192 + cq * 4);
        if (kc == 0) s += *(const f32x4*)(ada_b + cc * 192 + cq * 4);
        *(f32x4*)(modp + (size_t)(kc * 8 + b) * 6144 + cc * 192 + cq * 4) = s; }
    __syncthreads();
}

__device__ __forceinline__ void tr_store(LAS float* scr, bf16* dst, int Kd, int k0, int rowbase, bool gu, int lane) {
    asm volatile("s_waitcnt lgkmcnt(0)" ::: "memory");
    const int c = lane & 7;
#pragma unroll
    for (int j = 0; j < 4; ++j) { const int n = (lane >> 3) + 8 * j; const LAS float* s = scr + (8 * c) * 33 + n;
        u32x4 o; o.x = pk2(s[0 * 33], s[1 * 33]); o.y = pk2(s[2 * 33], s[3 * 33]); o.z = pk2(s[4 * 33], s[5 * 33]); o.w = pk2(s[6 * 33], s[7 * 33]);
        const int row = rowbase + n + ((gu && n >= 16) ? 16 : 0);
        *(u32x4*)(dst + (size_t)row * Kd + k0 + 8 * c) = o; }
    asm volatile("s_waitcnt lgkmcnt(0)" ::: "memory");
}
struct TrItem { const float* src; bf16* dst; int ldw, Kd, k0, rowbase; bool gu; };
__device__ __forceinline__ bool tr_decode(int it, const Args& a, TrItem& t) {
    constexpr int I0 = 16 * 72, I2 = 16 * 32, I3 = 32 * 2 * 128, I4 = 32 * 128, NIT = I0 + I2 + I3 + I4;
    if (it >= NIT) return false;
    unsigned char* ws = a.ws;
    const float* w_in = (const float*)a.in[6]; const float* w_out = (const float*)a.in[11];
    const float* w_gate = (const float*)a.in[17]; const float* w_up = (const float*)a.in[18]; const float* w_down = (const float*)a.in[19];
    bf16* win = (bf16*)(ws + WS_WIN); bf16* wout = (bf16*)(ws + WS_WOUT); bf16* wgu = (bf16*)(ws + WS_WGU); bf16* wd = (bf16*)(ws + WS_WD);
    int r = it;
    if (r < I0) { const int kb = r / 72, nb = r % 72, n0 = nb * 32, k0 = kb * 64; const int sc = n0 + (n0 >= 1536 ? 16 : 0);
        t.src = w_in + (size_t)k0 * INW + sc; t.ldw = INW; t.dst = win; t.Kd = D; t.k0 = k0; t.rowbase = n0; t.gu = false; return true; }
    r -= I0;
    if (r < I2) { const int kb = r / 32, nb = r % 32, n0 = nb * 32, k0 = kb * 64;
        t.src = w_out + (size_t)k0 * D + n0; t.ldw = D; t.dst = wout; t.Kd = D; t.k0 = k0; t.rowbase = n0; t.gu = false; return true; }
    r -= I2;
    if (r < I3) { const int e = r >> 8, ty = (r >> 7) & 1, q = r & 127, kb = q >> 3, nb = q & 7, n0 = nb * 32, k0 = kb * 64;
        t.src = (ty ? w_up : w_gate) + (size_t)e * D * 256 + (size_t)k0 * 256 + n0; t.ldw = 256; t.dst = wgu + (size_t)e * 512 * D; t.Kd = D; t.k0 = k0; t.rowbase = 2 * n0 + 16 * ty; t.gu = true; return true; }
    r -= I3;
    { const int e = r >> 7, q = r & 127, kb = q >> 5, nb = q & 31, n0 = nb * 32, k0 = kb * 64;
        t.src = w_down + (size_t)e * 256 * D + (size_t)k0 * D + n0; t.ldw = D; t.dst = wd + (size_t)e * D * 256; t.Kd = 256; t.k0 = k0; t.rowbase = n0; t.gu = false; return true; }
}
__device__ __forceinline__ void tr_load(const TrItem& t, f32x4 (&v)[8], int lane) {
#pragma unroll
    for (int i = 0; i < 8; ++i) v[i] = *(const f32x4*)(t.src + (size_t)(8 * i + (lane >> 3)) * t.ldw + 4 * (lane & 7));
}
__device__ __forceinline__ void tr_finish(const TrItem& t, const f32x4 (&v)[8], LAS float* scr, int lane) {
#pragma unroll
    for (int i = 0; i < 8; ++i) { LAS float* s = scr + (8 * i + (lane >> 3)) * 33 + 4 * (lane & 7); s[0] = v[i].x; s[1] = v[i].y; s[2] = v[i].z; s[3] = v[i].w; }
    tr_store(scr, t.dst, t.Kd, t.k0, t.rowbase, t.gu, lane);
}
__device__ __forceinline__ void tr_stream(LAS unsigned char* scrbase, const Args& a, int first, int last, int gw, int NGW, int wave, int lane) {
    LAS float* scr = (LAS float*)(scrbase + wave * 8704);
    TrItem cur, nxt; f32x4 va[8], vb[8];
    int it = first + gw;
    bool have = it < last && tr_decode(it, a, cur);
    if (have) tr_load(cur, va, lane);
    while (have) {
        const bool hn = (it + NGW) < last && tr_decode(it + NGW, a, nxt);
        if (hn) tr_load(nxt, vb, lane);
        tr_finish(cur, va, scr, lane);
        if (!hn) break;
        const bool hn2 = (it + 2 * NGW) < last && tr_decode(it + 2 * NGW, a, cur);
        if (hn2) tr_load(cur, va, lane);
        tr_finish(nxt, vb, scr, lane);
        it += 2 * NGW; have = hn2;
    }
}
__device__ __forceinline__ void p0_weights(LAS unsigned char* lds, const Args& a, int blk, int wave, int lane, int tid) {
    unsigned char* ws = a.ws;
    const float* w_in = (const float*)a.in[6]; const float* w_a2 = (const float*)a.in[7]; const float* b_a2 = (const float*)a.in[8];
    bf16* win = (bf16*)(ws + WS_WIN);
    if (tid < 64 && blk < 192) {
        const float* w_grp = (const float*)a.in[13]; const float* w_exp = (const float*)a.in[15]; bf16* wrb = (bf16*)(ws + WS_WRB);
        const int e = blk * 64 + tid, ln = e & 63, hl = (e >> 6) & 1; const bool ex = e < 8192;
        const int k0 = ex ? 128 * (e >> 10) + 16 * ((e >> 7) & 7) + 8 * (ln >> 5) : 128 * ((e - 8192) >> 9) + 32 * ((e >> 7) & 3) + 8 * (ln >> 4);
        const int col = ex ? (ln & 31) : (ln & 15);
        unsigned o[4];
#pragma unroll
        for (int j2 = 0; j2 < 4; ++j2) { unsigned pr[2];
#pragma unroll
            for (int u = 0; u < 2; ++u) { const int k = k0 + 2 * j2 + u; const float wv = ex ? w_exp[k * 32 + col] : (col < 4 ? w_grp[k * 4 + col] : 0.f);
                const unsigned hi = f2bf(wv); const float hf = __uint_as_float(hi << 16); pr[u] = hl ? f2bf(wv - hf) : hi; }
            o[j2] = pr[0] | (pr[1] << 16); }
        *(u32x4*)(wrb + (size_t)e * 8) = (u32x4){o[0], o[1], o[2], o[3]};
    }
    {
        float wa[16];
#pragma unroll
        for (int q = 0; q < 16; ++q) wa[q] = w_a2[q * 256 + blk];
        float s2[2];
#pragma unroll
        for (int u = 0; u < 2; ++u) { const float* wr = w_in + (size_t)(2 * tid + u) * INW + 1536; float s = 0.f;
#pragma unroll
            for (int q4 = 0; q4 < 4; ++q4) { const f32x4 w = *(const f32x4*)(wr + 4 * q4); s = fmaf(w.x, wa[4 * q4], s); s = fmaf(w.y, wa[4 * q4 + 1], s); s = fmaf(w.z, wa[4 * q4 + 2], s); s = fmaf(w.w, wa[4 * q4 + 3], s); }
            s2[u] = s; }
        *(unsigned*)(win + (size_t)(C_Z + blk) * D + 2 * tid) = pk2(s2[0], s2[1]);
    }
}

__device__ __forceinline__ void p1a_rows(LAS unsigned char* lds, const Args& a, int blk, int wave, int lane, int tid) {
    const float* x = (const float*)a.in[0]; const float* g = (const float*)a.in[5];
    const float* modp = (const float*)(a.ws + WS_MODP); float* mod = (float*)(a.ws + WS_MOD); bf16* h = (bf16*)(a.ws + WS_H);
    const int* pos = (const int*)a.in[2]; float* rtab = (float*)(a.ws + WS_ROPE);
    LAS float* ssh = (LAS float*)lds;
    const int b = blk >> 5;
    f32x4 n0[4], n1[4];
    const size_t mb = (size_t)blk * 64 + wave;
#pragma unroll
    for (int j = 0; j < 4; ++j) { n0[j] = *(const f32x4*)(x + mb * D + 4 * lane + 256 * j); n1[j] = *(const f32x4*)(x + (mb + NWAVES) * D + 4 * lane + 256 * j); }
    {
        float pv[4][8];
#pragma unroll
        for (int q = 0; q < 4; ++q)
#pragma unroll
            for (int kc = 0; kc < 8; ++kc) pv[q][kc] = modp[(size_t)(kc * 8 + b) * 6144 + tid + NTHR * q];
#pragma unroll
        for (int q = 0; q < 4; ++q) { const int i = tid + NTHR * q; float s = 0.f;
#pragma unroll
            for (int kc = 0; kc < 8; ++kc) s += pv[q][kc];
            ssh[i] = i < 1024 ? s : (1.f + s) * g[i - 1024]; }
    }
    if (tid < 192) { const int idx = blk * 192 + tid, bb = idx / 6144, col = idx % 6144; float s = 0.f;
#pragma unroll
        for (int kc = 0; kc < 8; ++kc) s += modp[(size_t)(kc * 8 + bb) * 6144 + col];
        mod[idx] = s; }
    { const int m = blk * 64 + (tid >> 3), j = tid & 7; float sn, cs; sincosf((float)pos[m] * a.rt.inv_freq[j], &sn, &cs); rtab[m * 16 + j] = cs; rtab[m * 16 + 8 + j] = sn; }
    __syncthreads();
    for (int r = wave; r < 64; r += NWAVES) {
        const size_t m = (size_t)blk * 64 + r;
        f32x4 v[4]; float ss = 0.f;
#pragma unroll
        for (int j = 0; j < 4; ++j) { v[j] = n0[j]; n0[j] = n1[j]; }
        if (r + 2 * NWAVES < 64) {
#pragma unroll
            for (int j = 0; j < 4; ++j) n1[j] = *(const f32x4*)(x + (m + 2 * NWAVES) * D + 4 * lane + 256 * j);
        }
#pragma unroll
        for (int j = 0; j < 4; ++j) ss += (v[j].x * v[j].x + v[j].y * v[j].y) + (v[j].z * v[j].z + v[j].w * v[j].w);
        const float rinv = rsqrtf(wave_sum(ss) * (1.f / D) + EPS);
#pragma unroll
        for (int j = 0; j < 4; ++j) { const int col = 4 * lane + 256 * j; const f32x4 sh = *(const LAS f32x4*)(ssh + col), gs = *(const LAS f32x4*)(ssh + 1024 + col);
            const f32x4 hv = v[j] * rinv * gs + sh; u32x2 o; o.x = pk2(hv.x, hv.y); o.y = pk2(hv.z, hv.w);
            *(u32x2*)(h + m * D + col) = o; }
    }
    __syncthreads();
}

__device__ __forceinline__ void p3b_route(LAS unsigned char* lds, const Args& a, int blk, int wave, int lane, int tid) {
    const bf16* x1 = (const bf16*)(a.ws + WS_X1); const float* g = (const float*)a.in[12];
    const float* b_grp = (const float*)a.in[14]; const float* b_exp = (const float*)a.in[16];
    const float* mod = (const float*)(a.ws + WS_MOD); bf16* h2 = (bf16*)(a.ws + WS_H); const bf16* wrb = (const bf16*)(a.ws + WS_WRB);
    int* cnt = (int*)(a.ws + WS_CTL) + CW_CNT; int* list = (int*)(a.ws + WS_ROUTE); float* lw = (float*)(a.ws + WS_ROUTE + 2 * MiB);
    LAS unsigned char* Ahi = lds; LAS unsigned char* Alo = lds + 65536;
    LAS float* red = (LAS float*)lds;
    LAS float* lgt = (LAS float*)(lds + 65536);
    LAS float* ssh = (LAS float*)(lds + 131072);
    LAS int* rsel = (LAS int*)(lds + 139264); LAS int* rslot = rsel + 128; LAS float* rwt = (LAS float*)(rslot + 128); LAS int* lcnt = (LAS int*)(rwt + 128); LAS int* lbase = lcnt + 32;
    LAS float* biasL = (LAS float*)(lbase + 32);
    const int b = blk >> 5, l31 = lane & 31, hh = lane >> 5;
    bf16x8 bh[8], bl[8], gh[4], gl[4];
#pragma unroll
    for (int s = 0; s < 8; ++s) { const size_t e = (size_t)(((wave * 8 + s) * 2) * 64 + lane) * 8; bh[s] = *(const bf16x8*)(wrb + e); bl[s] = *(const bf16x8*)(wrb + e + 512); }
#pragma unroll
    for (int s = 0; s < 4; ++s) { const size_t e = (size_t)(8192 + ((wave * 4 + s) * 2) * 64 + lane) * 8; gh[s] = *(const bf16x8*)(wrb + e); gl[s] = *(const bf16x8*)(wrb + e + 512); }
    u32x2 nx[4][4];
#pragma unroll
    for (int rr = 0; rr < 4; ++rr)
#pragma unroll
        for (int j = 0; j < 4; ++j) nx[rr][j] = *(const u32x2*)(x1 + ((size_t)blk * 64 + wave * 4 + rr) * D + 4 * lane + 256 * j);
    {
        float mv[4], gv[4];
#pragma unroll
        for (int q = 0; q < 4; ++q) { const int i = tid + NTHR * q; mv[q] = mod[b * 6144 + 3 * D + i]; gv[q] = i < 1024 ? 0.f : g[i - 1024]; }
#pragma unroll
        for (int q = 0; q < 4; ++q) { const int i = tid + NTHR * q; ssh[i] = i < 1024 ? mv[q] : (1.f + mv[q]) * gv[q]; }
    }
    if (tid < 32) lcnt[tid] = 0;
    if (tid >= 64 && tid < 100) biasL[tid - 64] = (tid < 96) ? b_exp[tid - 64] : b_grp[tid - 96];
    __syncthreads();
#pragma unroll 1
    for (int pass = 0; pass < 2; ++pass) {
#pragma unroll
        for (int rr = 0; rr < 4; ++rr) {
            const int rl = wave * 4 + rr; const int m = blk * 64 + pass * 32 + rl;
            f32x4 v[4]; float ss = 0.f;
#pragma unroll
            for (int j = 0; j < 4; ++j) { v[j].x = lo_bf16(nx[rr][j].x); v[j].y = hi_bf16(nx[rr][j].x); v[j].z = lo_bf16(nx[rr][j].y); v[j].w = hi_bf16(nx[rr][j].y); }
            if (pass == 0) {
#pragma unroll
              for (int j = 0; j < 4; ++j) nx[rr][j] = *(const u32x2*)(x1 + (size_t)(m + 32) * D + 4 * lane + 256 * j); }
#pragma unroll
            for (int j = 0; j < 4; ++j) ss += (v[j].x * v[j].x + v[j].y * v[j].y) + (v[j].z * v[j].z + v[j].w * v[j].w);
            const float rinv = rsqrtf(wave_sum(ss) * (1.f / D) + EPS);
#pragma unroll
            for (int j = 0; j < 4; ++j) { const int col = 4 * lane + 256 * j; const f32x4 sh = *(const LAS f32x4*)(ssh + col), sc = *(const LAS f32x4*)(ssh + 1024 + col);
                v[j] = v[j] * rinv * sc + sh;
                u32x2 hi; hi.x = pk2(v[j].x, v[j].y); hi.y = pk2(v[j].z, v[j].w);
                *(u32x2*)(h2 + (size_t)m * D + col) = hi;
                u32x2 lo; lo.x = pk2(v[j].x - lo_bf16(hi.x), v[j].y - hi_bf16(hi.x)); lo.y = pk2(v[j].z - lo_bf16(hi.y), v[j].w - hi_bf16(hi.y));
                const int c = (lane >> 1) + 32 * j; const int off = rl * 2048 + ((c ^ (rl & 15)) * 16) + 8 * (lane & 1);
                *(LAS u32x2*)(Ahi + off) = hi; *(LAS u32x2*)(Alo + off) = lo; }
        }
        __syncthreads();
        f32x16 acc0; f32x4 accg[2];
#pragma unroll
        for (int r = 0; r < 16; ++r) acc0[r] = 0.f;
        accg[0] = (f32x4){0.f, 0.f, 0.f, 0.f}; accg[1] = (f32x4){0.f, 0.f, 0.f, 0.f};
#pragma unroll
        for (int s = 0; s < 8; ++s) { const int c = 2 * (wave * 8 + s) + hh; const int off = l31 * 2048 + ((c ^ (l31 & 15)) * 16);
            const bf16x8 ah = *(const LAS bf16x8*)(Ahi + off), al = *(const LAS bf16x8*)(Alo + off);
            acc0 = __builtin_amdgcn_mfma_f32_32x32x16_bf16(ah, bh[s], acc0, 0, 0, 0); acc0 = __builtin_amdgcn_mfma_f32_32x32x16_bf16(ah, bl[s], acc0, 0, 0, 0); acc0 = __builtin_amdgcn_mfma_f32_32x32x16_bf16(al, bh[s], acc0, 0, 0, 0); }
#pragma unroll
        for (int s = 0; s < 4; ++s)
#pragma unroll
            for (int mt = 0; mt < 2; ++mt) { const int row = 16 * mt + (lane & 15), c = 16 * wave + 4 * s + (lane >> 4); const int off = row * 2048 + ((c ^ (row & 15)) * 16);
                const bf16x8 ah = *(const LAS bf16x8*)(Ahi + off), al = *(const LAS bf16x8*)(Alo + off);
                accg[mt] = __builtin_amdgcn_mfma_f32_16x16x32_bf16(ah, gh[s], accg[mt], 0, 0, 0); accg[mt] = __builtin_amdgcn_mfma_f32_16x16x32_bf16(ah, gl[s], accg[mt], 0, 0, 0); accg[mt] = __builtin_amdgcn_mfma_f32_16x16x32_bf16(al, gh[s], accg[mt], 0, 0, 0); }
        __syncthreads();
#pragma unroll
        for (int r = 0; r < 16; ++r) { const int row = (r & 3) + 8 * (r >> 2) + 4 * hh; red[(wave * 32 + row) * 36 + l31] = acc0[r]; }
        if ((lane & 15) < 4) {
#pragma unroll
            for (int mt = 0; mt < 2; ++mt)
#pragma unroll
                for (int r = 0; r < 4; ++r) red[(wave * 32 + 16 * mt + 4 * (lane >> 4) + r) * 36 + 32 + (lane & 15)] = accg[mt][r];
        }
        __syncthreads();
#pragma unroll
        for (int q = 0; q < 3; ++q) { const int p = tid + NTHR * q;
            if (p < 32 * 36) { float s = 0.f;
#pragma unroll
                for (int w = 0; w < 8; ++w) s += red[w * (32 * 36) + p];
                lgt[p] = s + biasL[p % 36]; } }
        __syncthreads();
        if (tid < 32) {
            const int row = tid;
            float lg[4];
#pragma unroll
            for (int o = 0; o < 4; ++o) lg[o] = lgt[row * 36 + 32 + o];
            int gi = 0; float gm = lg[0];
#pragma unroll
            for (int o = 1; o < 4; ++o) if (lg[o] > gm) { gm = lg[o]; gi = o; }
            float den = 0.f;
#pragma unroll
            for (int o = 0; o < 4; ++o) den += __expf(lg[o] - gm);
            const float gate = 1.f / den;
            float sl[8];
#pragma unroll
            for (int i = 0; i < 8; ++i) sl[i] = lgt[row * 36 + gi * 8 + i];
            int i1 = 0; float v1 = sl[0];
#pragma unroll
            for (int i = 1; i < 8; ++i) if (sl[i] > v1) { v1 = sl[i]; i1 = i; }
            int i2 = 0; float v2 = -INFINITY;
#pragma unroll
            for (int i = 0; i < 8; ++i) if (i != i1 && sl[i] > v2) { v2 = sl[i]; i2 = i; }
            const float e2 = __expf(v2 - v1), w1 = gate / (1.f + e2), w2 = gate * e2 / (1.f + e2);
            const int ea = gi * 8 + i1, eb = gi * 8 + i2, r2 = 2 * (pass * 32 + row);
            rsel[r2] = ea; rslot[r2] = atomicAdd((int*)(lcnt + ea), 1); rwt[r2] = w1;
            rsel[r2 + 1] = eb; rslot[r2 + 1] = atomicAdd((int*)(lcnt + eb), 1); rwt[r2 + 1] = w2;
        }
        __syncthreads();
    }
    if (tid < 32) { const int c = lcnt[tid]; lbase[tid] = c ? atomicAdd(&cnt[tid * CNT_STRIDE], c) : 0; }
    __syncthreads();
    if (tid < 128) { const int e = rsel[tid], slot = lbase[e] + rslot[tid]; list[e * LCAP + slot] = (blk * 64 + (tid >> 1)) * 2 + (tid & 1); lw[e * LCAP + slot] = rwt[tid]; }
    __syncthreads();
}

__device__ __forceinline__ void moe_prefix(LAS int* tp, const int* cnt, int tid) {
    if (tid < 64) {
        const int craw = __hip_atomic_load(cnt + (tid & 31) * CNT_STRIDE, __ATOMIC_RELAXED, __HIP_MEMORY_SCOPE_AGENT);
        if (tid < NEXP) tp[208 + tid] = craw;
        const int c = tid < NEXP ? ((craw + 255) >> 8) : 0;
        int s = c;
#pragma unroll
        for (int o = 1; o < 32; o <<= 1) { const int t = __shfl_up(s, o); if ((tid & 63) >= o) s += t; }
        if (tid < NEXP) { tp[tid] = s - c; for (int t = s - c; t < s; ++t) tp[40 + t] = tid; }
        if (tid == NEXP - 1) tp[NEXP] = s;
    }
    __syncthreads();
}

__device__ __forceinline__ void p6_final(LAS unsigned char* lds, const Args& a, int blk, int wave, int lane, int tid) {
    float* out = a.out; const bf16* x1 = (const bf16*)(a.ws + WS_X1); const float* fg = (const float*)a.in[20]; const float* mod = (const float*)(a.ws + WS_MOD); const bf16* y2 = (const bf16*)(a.ws + WS_Y2);
    LAS float* gt = (LAS float*)lds;
    const int b = blk >> 5;
    for (int i = tid; i < 1024; i += NTHR) gt[i] = mod[b * 6144 + 5 * D + i];
    __syncthreads();
    f32x4 gg[4];
#pragma unroll
    for (int j = 0; j < 4; ++j) gg[j] = *(const f32x4*)(fg + 4 * lane + 256 * j);
    u32x2 nx[4]; u32x2 nya[4], nyb[4];
    {
        const size_t m = (size_t)blk * 64 + wave;
#pragma unroll
        for (int j = 0; j < 4; ++j) { const int col = 4 * lane + 256 * j; nx[j] = *(const u32x2*)(x1 + m * D + col); nya[j] = *(const u32x2*)(y2 + (m * 2) * D + col); nyb[j] = *(const u32x2*)(y2 + (m * 2 + 1) * D + col); }
    }
    for (int r = wave; r < 64; r += NWAVES) {
        const size_t m = (size_t)blk * 64 + r;
        f32x4 v[4]; u32x2 ya4[4], yb4[4]; float ss = 0.f;
#pragma unroll
        for (int j = 0; j < 4; ++j) { v[j].x = lo_bf16(nx[j].x); v[j].y = hi_bf16(nx[j].x); v[j].z = lo_bf16(nx[j].y); v[j].w = hi_bf16(nx[j].y); ya4[j] = nya[j]; yb4[j] = nyb[j]; }
        if (r + NWAVES < 64) {
            const size_t mn = m + NWAVES;
#pragma unroll
            for (int j = 0; j < 4; ++j) { const int col = 4 * lane + 256 * j; nx[j] = *(const u32x2*)(x1 + mn * D + col); nya[j] = *(const u32x2*)(y2 + (mn * 2) * D + col); nyb[j] = *(const u32x2*)(y2 + (mn * 2 + 1) * D + col); }
        }
#pragma unroll
        for (int j = 0; j < 4; ++j) { const int col = 4 * lane + 256 * j; const u32x2 ya = ya4[j], yb = yb4[j];
            f32x4 y; y.x = __uint_as_float(ya.x << 16) + __uint_as_float(yb.x << 16); y.y = __uint_as_float(ya.x & 0xffff0000u) + __uint_as_float(yb.x & 0xffff0000u);
            y.z = __uint_as_float(ya.y << 16) + __uint_as_float(yb.y << 16); y.w = __uint_as_float(ya.y & 0xffff0000u) + __uint_as_float(yb.y & 0xffff0000u);
            v[j] += *(const LAS f32x4*)(gt + col) * y; ss += (v[j].x * v[j].x + v[j].y * v[j].y) + (v[j].z * v[j].z + v[j].w * v[j].w); }
        const float rinv = rsqrtf(wave_sum(ss) * (1.f / D) + EPS);
#pragma unroll
        for (int j = 0; j < 4; ++j) *(f32x4*)(out + m * D + 4 * lane + 256 * j) = v[j] * rinv * gg[j];
    }
    __syncthreads();
}
typedef short v4i16_t __attribute__((ext_vector_type(4)));
constexpr float LOG2E = 1.4426950408889634f;
__device__ __forceinline__ f32x16 mfma32(bf16x8 a, bf16x8 b, f32x16 c) { return __builtin_amdgcn_mfma_f32_32x32x16_bf16(a, b, c, 0, 0, 0); }
__device__ __forceinline__ v4i16_t tr_read(LAS unsigned char* p) { return __builtin_amdgcn_ds_read_tr16_b64_v4i16((LAS v4i16_t*)p); }
__device__ __forceinline__ bf16x8 cat8(v4i16_t a, v4i16_t b) { return (bf16x8){a[0], a[1], a[2], a[3], b[0], b[1], b[2], b[3]}; }
__device__ __forceinline__ unsigned cvtpk(float lo, float hi) { const f32x2_t v = {lo, hi}; const bf16x2_t b = __builtin_convertvector(v, bf16x2_t); return __builtin_bit_cast(unsigned, b); }
__device__ __forceinline__ bf16x8 pack8(const f32x16& v, int s) {
    u32x4 w; w.x = cvtpk(v[8 * s + 0], v[8 * s + 1]); w.y = cvtpk(v[8 * s + 2], v[8 * s + 3]); w.z = cvtpk(v[8 * s + 4], v[8 * s + 5]); w.w = cvtpk(v[8 * s + 6], v[8 * s + 7]);
    return __builtin_bit_cast(bf16x8, w);
}
__device__ __forceinline__ unsigned xor32_u(unsigned x) { const auto r = __builtin_amdgcn_permlane32_swap(x, x, false, false); return (threadIdx.x & 32) ? r[0] : r[1]; }
__device__ __forceinline__ float sum32(float x) { const auto r = __builtin_amdgcn_permlane32_swap(__float_as_uint(x), __float_as_uint(x), false, false); return __uint_as_float(r[0]) + __uint_as_float(r[1]); }
__device__ __forceinline__ float max32(float x) { const auto r = __builtin_amdgcn_permlane32_swap(__float_as_uint(x), __float_as_uint(x), false, false); return fmaxf(__uint_as_float(r[0]), __uint_as_float(r[1])); }
__device__ __forceinline__ float lo_bf(unsigned w) { return __uint_as_float(w << 16); }
__device__ __forceinline__ float hi_bf(unsigned w) { return __uint_as_float(w & 0xffff0000u); }
__device__ __forceinline__ int off256(int row, int ch) { return 256 * row + 16 * (ch ^ (((row & 3) << 2) | ((row >> 2) & 3))); }
__device__ __forceinline__ int off128(int row, int c) { return 128 * row + 16 * (c ^ ((row >> 1) & 7)); }

__device__ __forceinline__ void swa_unit(LAS unsigned char* lds, const bf16* proj, const float* rtab, const float* sinks, bf16* o, int unit, int tid, int lane, int wave) {
    const int b = unit >> 5, kh = (unit >> 4) & 1, qb = unit & 15;
    LAS unsigned char* Ks = lds; LAS unsigned char* Vs = lds + 32768;
    {
        const int key = tid >> 1, half = tid & 1;
        const int jpos = (qb - 1) * 128 + key; const bool valid = jpos >= 0;
        const size_t m = (size_t)b * SEQ + (valid ? jpos : 0);
        const bf16* kp = proj + m * PW + C_SK + kh * 64 + half * 32; const bf16* vp = proj + m * PW + C_SV + kh * 64 + half * 32;
        u32x4 kc[4], vc[4];
#pragma unroll
        for (int c = 0; c < 4; ++c) { kc[c] = *(const u32x4*)(kp + 8 * c); vc[c] = *(const u32x4*)(vp + 8 * c); }
        if (half == 0) {
            const f32x4 c0 = *(const f32x4*)(rtab + m * 16), c1 = *(const f32x4*)(rtab + m * 16 + 4), s0 = *(const f32x4*)(rtab + m * 16 + 8), s1 = *(const f32x4*)(rtab + m * 16 + 12);
            const float cs[8] = {c0.x, c0.y, c0.z, c0.w, c1.x, c1.y, c1.z, c1.w}, sn[8] = {s0.x, s0.y, s0.z, s0.w, s1.x, s1.y, s1.z, s1.w};
#pragma unroll
            for (int w = 0; w < 4; ++w) {
                const float a0 = lo_bf(kc[0][w]), a1 = hi_bf(kc[0][w]), b0 = lo_bf(kc[1][w]), b1 = hi_bf(kc[1][w]);
                kc[0][w] = cvtpk(a0 * cs[2 * w] - b0 * sn[2 * w], a1 * cs[2 * w + 1] - b1 * sn[2 * w + 1]);
                kc[1][w] = cvtpk(b0 * cs[2 * w] + a0 * sn[2 * w], b1 * cs[2 * w + 1] + a1 * sn[2 * w + 1]);
            }
        }
        if (!valid) {
#pragma unroll
            for (int c = 0; c < 4; ++c) { kc[c] = (u32x4){0u, 0u, 0u, 0u}; vc[c] = (u32x4){0u, 0u, 0u, 0u}; }
        }
        const int vsw = (key >> 1) & 1;
#pragma unroll
        for (int c = 0; c < 4; ++c) { const int cc = 4 * half + c;
            *(LAS u32x4*)(Ks + off128(key, cc)) = kc[c];
            *(LAS u32x4*)(Vs + key * 128 + (((cc >> 2) ^ vsw) * 64) + (cc & 3) * 16) = vc[c]; }
    }
    __syncthreads();
    const int g = wave >> 1, qhf = wave & 1, qh = kh * 4 + g;
    const int l31 = lane & 31, h = lane >> 5, i16 = lane & 15, g16 = (lane >> 4) & 1, tq = i16 >> 2, tp = i16 & 3;
    const float sink2 = sinks[qh] * LOG2E, sc = 0.125f * LOG2E;
    const int vbase = (4 * h + tq) * 128 + 32 * g16 + 8 * tp;
#pragma unroll 1
    for (int qs = 0; qs < 2; ++qs) {
        const int q0 = 64 * qhf + 32 * qs;
        const size_t m = (size_t)b * SEQ + qb * 128 + q0 + l31;
        bf16x8 qf[4];
        const bf16* qp = proj + m * PW + C_SQ + qh * 64 + 8 * h;
#pragma unroll
        for (int s = 0; s < 4; ++s) qf[s] = *(const bf16x8*)(qp + 16 * s);
        {
            const f32x4 c0 = *(const f32x4*)(rtab + m * 16), c1 = *(const f32x4*)(rtab + m * 16 + 4), s0 = *(const f32x4*)(rtab + m * 16 + 8), s1 = *(const f32x4*)(rtab + m * 16 + 12);
            const float cs[8] = {c0.x, c0.y, c0.z, c0.w, c1.x, c1.y, c1.z, c1.w}, sn[8] = {s0.x, s0.y, s0.z, s0.w, s1.x, s1.y, s1.z, s1.w};
            u32x4 own = __builtin_bit_cast(u32x4, qf[0]), res;
#pragma unroll
            for (int w = 0; w < 4; ++w) { const unsigned pw = xor32_u(own[w]);
                const float o0 = lo_bf(own[w]), o1 = hi_bf(own[w]), p0 = lo_bf(pw), p1 = hi_bf(pw);
                const float sg = h ? 1.f : -1.f;
                res[w] = cvtpk(o0 * cs[2 * w] + sg * p0 * sn[2 * w], o1 * cs[2 * w + 1] + sg * p1 * sn[2 * w + 1]); }
            qf[0] = __builtin_bit_cast(bf16x8, res);
        }
        const int kt0 = q0 >> 5;
        f32x16 st[5];
#pragma unroll
        for (int i = 0; i < 5; ++i) {
            f32x16 acc;
#pragma unroll
            for (int r = 0; r < 16; ++r) acc[r] = 0.f;
            const int row = 32 * (kt0 + i) + l31;
#pragma unroll
            for (int s = 0; s < 4; ++s) { const bf16x8 kf = *(const LAS bf16x8*)(Ks + off128(row, 2 * s + h)); acc = mfma32(kf, qf[s], acc); }
            st[i] = acc;
        }
        float mx = sink2;
#pragma unroll
        for (int i = 0; i < 5; ++i)
#pragma unroll
            for (int r = 0; r < 16; ++r) { const int krow = (r & 3) + 8 * (r >> 2) + 4 * h; const int dj = 32 * i + krow - l31;
                bool ok = (dj > 0) && (dj <= 128); if (qb == 0) ok = ok && (q0 + 32 * i + krow >= 128);
                const float x = ok ? st[i][r] * sc : -1e30f; st[i][r] = x; mx = fmaxf(mx, x); }
        mx = max32(mx);
        float l = 0.f;
#pragma unroll
        for (int i = 0; i < 5; ++i)
#pragma unroll
            for (int r = 0; r < 16; ++r) { const float p = __builtin_amdgcn_exp2f(st[i][r] - mx); st[i][r] = p; l += p; }
        l = sum32(l); l += __builtin_amdgcn_exp2f(sink2 - mx);
        f32x16 ot[2];
#pragma unroll
        for (int r = 0; r < 16; ++r) { ot[0][r] = 0.f; ot[1][r] = 0.f; }
#pragma unroll
        for (int i = 0; i < 5; ++i)
#pragma unroll
            for (int s2 = 0; s2 < 2; ++s2) { const bf16x8 pf = pack8(st[i], s2);
                LAS unsigned char* vb = Vs + (32 * (kt0 + i) + 16 * s2) * 128 + vbase;
#pragma unroll
                for (int dt = 0; dt < 2; ++dt) { const int xo = (dt ^ (tq >> 1)) * 64;
                    const bf16x8 vf = cat8(tr_read(vb + xo), tr_read(vb + 8 * 128 + xo));
                    ot[dt] = mfma32(vf, pf, ot[dt]); } }
        const float inv = __builtin_amdgcn_rcpf(l);
        bf16* op = o + m * D + 512 + qh * 64 + 4 * h;
#pragma unroll
        for (int dt = 0; dt < 2; ++dt)
#pragma unroll
            for (int gq = 0; gq < 4; ++gq) { u32x2 w; w.x = cvtpk(ot[dt][4 * gq] * inv, ot[dt][4 * gq + 1] * inv); w.y = cvtpk(ot[dt][4 * gq + 2] * inv, ot[dt][4 * gq + 3] * inv);
                *(u32x2*)(op + dt * 32 + 8 * gq) = w; }
    }
    __syncthreads();
}

constexpr int GLA_CH = 32768, GLA_QD = 16384, GLA_KD = 24576, GLA_K2T = 131072  , GLA_SEG = 147456  , GLA_DECL = 151552  , GLA_DECP = 152064, GLA_S = 131072, GLA_SSQ = 153088;
__device__ __forceinline__ float logsig16(float z) { return (fminf(z, 0.f) - __logf(1.f + __expf(-fabsf(z)))) * (1.f / 16.f); }
__device__ __forceinline__ void gla_kv_group(LAS unsigned char* lds, const bf16* proj, const float* b_a2, bf16* KV, bf16* KVG, float* DECG, int bh, int g, int tid, int lane, int wave) {
    const int b = bh >> 2, hd = bh & 3;
    LAS float* decP = (LAS float*)(lds + GLA_DECP);
    const int et = wave >> 1, dt = wave & 1, l31 = lane & 31, hh = lane >> 5, i16 = lane & 15, g16 = (lane >> 4) & 1, tq = i16 >> 2, tp = i16 & 3;
    const int d = tid & 63, seg = tid >> 6;
    const float zb = b_a2[hd * 64 + d];
    f32x16 grp; float gdec = 1.f;
#pragma unroll
    for (int r = 0; r < 16; ++r) grp[r] = 0.f;
#pragma unroll 1
    for (int jp = 0; jp < 2; ++jp) {
        float la[2][8], qv[2][8], kv[2][8]; u32x4 vld[2][2];
#pragma unroll
        for (int c2 = 0; c2 < 2; ++c2) { const size_t m0 = (size_t)b * SEQ + (4 * g + 2 * jp + c2) * 64;
#pragma unroll
            for (int i = 0; i < 8; ++i) { const size_t mr = (m0 + seg * 8 + i) * PW; la[c2][i] = bf2f(proj[mr + C_Z + hd * 64 + d]); qv[c2][i] = bf2f(proj[mr + C_GQ + hd * 64 + d]) * 0.125f; kv[c2][i] = bf2f(proj[mr + C_GK + hd * 64 + d]); }
#pragma unroll
            for (int i = 0; i < 2; ++i) { const int idx = tid + NTHR * i; vld[c2][i] = *(const u32x4*)(proj + (m0 + (idx >> 4)) * PW + C_GV + hd * 128 + (idx & 15) * 8); } }
#pragma unroll
        for (int c2 = 0; c2 < 2; ++c2) { LAS float* segtot = (LAS float*)(lds + GLA_SEG + 2048 * c2);
#pragma unroll
            for (int i = 0; i < 8; ++i) la[c2][i] = logsig16(la[c2][i] + zb);
#pragma unroll
            for (int i = 1; i < 8; ++i) la[c2][i] += la[c2][i - 1];
            segtot[seg * 64 + d] = la[c2][7]; }
        __syncthreads();
#pragma unroll
        for (int c2 = 0; c2 < 2; ++c2) { const int jn = 2 * jp + c2;
            LAS unsigned char* vS = lds + GLA_CH * jn; LAS unsigned char* qdS = vS + GLA_QD; LAS unsigned char* kdS = vS + GLA_KD;
            LAS unsigned char* k2T = lds + GLA_K2T + 8192 * c2; LAS float* segtot = (LAS float*)(lds + GLA_SEG + 2048 * c2); LAS float* decL = (LAS float*)(lds + GLA_DECL + 256 * c2);
            float pre = 0.f, tot = 0.f;
#pragma unroll
            for (int s = 0; s < 8; ++s) { const float v = segtot[s * 64 + d]; tot += v; pre += (s < seg) ? v : 0.f; }
            u32x4 w; float e[8]; const float etot = __expf(tot);
#pragma unroll
            for (int i = 0; i < 8; ++i) { const int t = seg * 8 + i; const float bb = pre + la[c2][i]; const float en = __expf(-bb);
                e[i] = kv[c2][i] * en * etot;
                *(LAS bf16*)(qdS + off128(t, d >> 3) + (d & 7) * 2) = (bf16)f2bf(qv[c2][i] * __expf(bb));
                *(LAS bf16*)(kdS + off128(t, d >> 3) + (d & 7) * 2) = (bf16)f2bf(kv[c2][i] * en); }
            w.x = cvtpk(e[0], e[1]); w.y = cvtpk(e[2], e[3]); w.z = cvtpk(e[4], e[5]); w.w = cvtpk(e[6], e[7]);
            *(LAS u32x4*)(k2T + off128(d, seg)) = w;
            if (seg == 0) { decL[d] = etot; decP[jn * 64 + d] = etot; }
#pragma unroll
            for (int i = 0; i < 2; ++i) { const int idx = tid + NTHR * i; *(LAS u32x4*)(vS + off256(idx >> 4, idx & 15)) = vld[c2][i]; } }
        __syncthreads();
#pragma unroll
        for (int c2 = 0; c2 < 2; ++c2) { const int jn = 2 * jp + c2; const size_t unit = (size_t)(bh * 32 + 4 * g + jn);
            LAS unsigned char* vS = lds + GLA_CH * jn; LAS unsigned char* k2T = lds + GLA_K2T + 8192 * c2; LAS float* decL = (LAS float*)(lds + GLA_DECL + 256 * c2);
            f32x16 acc;
#pragma unroll
            for (int r = 0; r < 16; ++r) acc[r] = 0.f;
#pragma unroll
            for (int kk = 0; kk < 4; ++kk) {
                const int kb = 16 * kk + 8 * hh;
                const int ch = et * 4 + 2 * g16 + (tp >> 1);
                const bf16x8 af = cat8(tr_read(vS + off256(kb + tq, ch) + 8 * (tp & 1)), tr_read(vS + off256(kb + 4 + tq, ch) + 8 * (tp & 1)));
                const bf16x8 bfr = *(const LAS bf16x8*)(k2T + off128(dt * 32 + l31, 2 * kk + hh));
                acc = mfma32(af, bfr, acc);
            }
            const float dcl = decL[dt * 32 + l31];
            __builtin_amdgcn_sched_barrier(0);
            asm volatile("s_nop 15\n\ts_nop 15" ::: "memory");
            __builtin_amdgcn_sched_barrier(0);
            if (jn < 3 || g < 7) {
                bf16* sp = KV + unit * 8192 + (dt * 32 + l31) * 128 + et * 32 + 4 * hh;
#pragma unroll
                for (int gq = 0; gq < 4; ++gq) { u32x2 w; w.x = cvtpk(acc[4 * gq], acc[4 * gq + 1]); w.y = cvtpk(acc[4 * gq + 2], acc[4 * gq + 3]); *(u32x2*)(sp + 8 * gq) = w; }
            }
#pragma unroll
            for (int r = 0; r < 16; ++r) grp[r] = dcl * grp[r] + acc[r];
            gdec *= dcl; }
        __syncthreads();
    }
    {
        bf16* sp = KVG + (size_t)(bh * 8 + g) * 8192 + (dt * 32 + l31) * 128 + et * 32 + 4 * hh;
#pragma unroll
        for (int gq = 0; gq < 4; ++gq) { u32x2 w; w.x = cvtpk(grp[4 * gq], grp[4 * gq + 1]); w.y = cvtpk(grp[4 * gq + 2], grp[4 * gq + 3]); *(u32x2*)(sp + 8 * gq) = w; }
        if (et == 0 && hh == 0) DECG[(size_t)(bh * 8 + g) * 64 + dt * 32 + l31] = gdec;
    }
}

__device__ __forceinline__ void gla_out_block(LAS unsigned char* lds, const bf16* proj, const bf16* KV, const bf16* KVG, const float* DECG, const float* gn, bf16* o, int bh, int g, int tid, int lane, int wave) {
    const int b = bh >> 2, hd = bh & 3, n0 = 4 * g;
    LAS unsigned char* sS = lds + GLA_S; LAS float* ssq = (LAS float*)(lds + GLA_SSQ); LAS float* decP = (LAS float*)(lds + GLA_DECP);
    const int et = wave >> 1, tt = wave & 1, l31 = lane & 31, hh = lane >> 5, i16 = lane & 15, g16 = (lane >> 4) & 1, tq = i16 >> 2, tp = i16 & 3;
    const int srow = tid >> 4, sch = tid & 15;
    u32x4 kvn[2]; u32x2 gate[4];
#define GLA_LOAD(JN) do { const int n_ = n0 + (JN); const size_t m0_ = (size_t)b * SEQ + n_ * 64; const size_t unit_ = (size_t)(bh * 32 + n_); \
        _Pragma("unroll") for (int i = 0; i < 2; ++i) kvn[i] = ((JN) < 3) ? *(const u32x4*)(KV + unit_ * 8192 + (srow + 32 * i) * 128 + sch * 8) : (u32x4){0u, 0u, 0u, 0u}; \
        _Pragma("unroll") for (int gq = 0; gq < 4; ++gq) gate[gq] = *(const u32x2*)(proj + (m0_ + tt * 32 + l31) * PW + C_GG + hd * 128 + et * 32 + 8 * gq + 4 * hh); } while (0)
    GLA_LOAD(0);
    f32x4 gnv[4];
#pragma unroll
    for (int gq = 0; gq < 4; ++gq) gnv[gq] = *(const f32x4*)(gn + hd * 128 + et * 32 + 4 * hh + 8 * gq);
    float sst[2][8];
#pragma unroll
    for (int i = 0; i < 2; ++i)
#pragma unroll
        for (int j = 0; j < 8; ++j) sst[i][j] = 0.f;
    {
        u32x4 kvl[7][2]; float dcl[7][2];
#pragma unroll
        for (int m = 0; m < 7; ++m)
#pragma unroll
            for (int i = 0; i < 2; ++i) { const size_t u = (size_t)(bh * 8 + m);
                kvl[m][i] = (m < g) ? *(const u32x4*)(KVG + u * 8192 + (srow + 32 * i) * 128 + sch * 8) : (u32x4){0u, 0u, 0u, 0u};
                dcl[m][i] = (m < g) ? DECG[u * 64 + srow + 32 * i] : 1.f; }
#pragma unroll
        for (int m = 0; m < 7; ++m)
#pragma unroll
            for (int i = 0; i < 2; ++i)
#pragma unroll
                for (int w = 0; w < 4; ++w) { sst[i][2 * w] = dcl[m][i] * sst[i][2 * w] + lo_bf(kvl[m][i][w]); sst[i][2 * w + 1] = dcl[m][i] * sst[i][2 * w + 1] + hi_bf(kvl[m][i][w]); }
    }
#pragma unroll 1
    for (int jn = 0; jn < 4; ++jn) {
        const int n = n0 + jn;
        const size_t mt = (size_t)b * SEQ + n * 64 + tt * 32 + l31;
        LAS unsigned char* vS = lds + GLA_CH * jn; LAS unsigned char* qdS = vS + GLA_QD; LAS unsigned char* kdS = vS + GLA_KD;
#pragma unroll
        for (int i = 0; i < 2; ++i) { u32x4 sw; sw.x = cvtpk(sst[i][0], sst[i][1]); sw.y = cvtpk(sst[i][2], sst[i][3]); sw.z = cvtpk(sst[i][4], sst[i][5]); sw.w = cvtpk(sst[i][6], sst[i][7]);
            *(LAS u32x4*)(sS + off256(srow + 32 * i, sch)) = sw; }
        __syncthreads();
        if (jn < 3) {
#pragma unroll
            for (int i = 0; i < 2; ++i) { const float dc = decP[jn * 64 + srow + 32 * i];
#pragma unroll
                for (int w = 0; w < 4; ++w) { sst[i][2 * w] = dc * sst[i][2 * w] + lo_bf(kvn[i][w]); sst[i][2 * w + 1] = dc * sst[i][2 * w + 1] + hi_bf(kvn[i][w]); } }
        }
        u32x2 gcur[4];
#pragma unroll
        for (int gq = 0; gq < 4; ++gq) gcur[gq] = gate[gq];
        if (jn < 3) GLA_LOAD(jn + 1);
        bf16x8 qf[4];
#pragma unroll
        for (int kk = 0; kk < 4; ++kk) qf[kk] = *(const LAS bf16x8*)(qdS + off128(tt * 32 + l31, 2 * kk + hh));
        f32x16 ot;
#pragma unroll
        for (int r = 0; r < 16; ++r) ot[r] = 0.f;
        const int chv = et * 4 + 2 * g16 + (tp >> 1), sub = 8 * (tp & 1);
#pragma unroll
        for (int kk = 0; kk < 4; ++kk) { const int kb = 16 * kk + 8 * hh;
            const bf16x8 af = cat8(tr_read(sS + off256(kb + tq, chv) + sub), tr_read(sS + off256(kb + 4 + tq, chv) + sub));
            ot = mfma32(af, qf[kk], ot); }
#pragma unroll
        for (int st = 0; st < 2; ++st) {
            if (st <= tt) {
                f32x16 at;
#pragma unroll
                for (int r = 0; r < 16; ++r) at[r] = 0.f;
#pragma unroll
                for (int kk = 0; kk < 4; ++kk) { const bf16x8 kf = *(const LAS bf16x8*)(kdS + off128(st * 32 + l31, 2 * kk + hh)); at = mfma32(kf, qf[kk], at); }
                if (st == tt) {
#pragma unroll
                    for (int r = 0; r < 16; ++r) { const int sr = (r & 3) + 8 * (r >> 2) + 4 * hh; at[r] = (sr <= l31) ? at[r] : 0.f; }
                }
#pragma unroll
                for (int s2 = 0; s2 < 2; ++s2) { const bf16x8 pf = pack8(at, s2); const int kb = 32 * st + 16 * s2 + 4 * hh;
                    const bf16x8 vf = cat8(tr_read(vS + off256(kb + tq, chv) + sub), tr_read(vS + off256(kb + 8 + tq, chv) + sub));
                    ot = mfma32(vf, pf, ot); }
            }
        }
        float ss = 0.f;
#pragma unroll
        for (int r = 0; r < 16; ++r) ss += ot[r] * ot[r];
        ss = sum32(ss);
        if (hh == 0) ssq[et * 64 + tt * 32 + l31] = ss;
        __syncthreads();
        const int tl = tt * 32 + l31;
        const float rinv = rsqrtf(((ssq[tl] + ssq[64 + tl]) + (ssq[128 + tl] + ssq[192 + tl])) * (1.f / 128.f) + EPS);
        bf16* op = o + mt * D + hd * 128 + et * 32 + 4 * hh;
#pragma unroll
        for (int gq = 0; gq < 4; ++gq) { const f32x4 gg = gnv[gq];
            const float g0 = lo_bf(gcur[gq].x), g1 = hi_bf(gcur[gq].x), g2 = lo_bf(gcur[gq].y), g3 = hi_bf(gcur[gq].y);
            u32x2 w; w.x = cvtpk(ot[4 * gq] * rinv * gg.x * silu_f(g0), ot[4 * gq + 1] * rinv * gg.y * silu_f(g1)); w.y = cvtpk(ot[4 * gq + 2] * rinv * gg.z * silu_f(g2), ot[4 * gq + 3] * rinv * gg.w * silu_f(g3));
            *(u32x2*)(op + 8 * gq) = w; }
        __syncthreads();
    }
#undef GLA_LOAD
}
constexpr int NPH = 10;
__global__ void __launch_bounds__(NTHR, 2) mk_fwd(Args a) {
    extern __shared__ __attribute__((aligned(16))) unsigned char lds_raw[];
    LAS unsigned char* lds = (LAS unsigned char*)lds_raw;
    volatile LAS unsigned* MISC = (volatile LAS unsigned*)(lds + MISC_OFF);
    const int tid = threadIdx.x, lane = tid & 63, wave = __builtin_amdgcn_readfirstlane(tid >> 6), blk = blockIdx.x;
    if (tid < 128) MISC[tid] = 0u;
    __syncthreads();
    unsigned char* ws = a.ws;
    unsigned* ctl = (unsigned*)(ws + WS_CTL);
    const int lo = a.ph_lo, hi = a.ph_hi;
    XcdBarrier bar = xcd_barrier_post(ctl + CW_BAR + lo * XCD_BAR_WORDS, MISC);
#define IN(k) (lo <= (k) && (k) < hi)
#define SEAM(k) do { if (IN(k) && IN((k) + 1)) xcd_barrier(bar); } while (0)
    LAS int* tp = (LAS int*)(lds + 132096);

    if (IN(0)) {
        TrItem t0; f32x4 tv[8]; const int it0 = blk * NWAVES + wave; const bool h0 = it0 < 16 * 72 + 16 * 32 && tr_decode(it0, a, t0);
        if (h0) tr_load(t0, tv, lane);
        p0_adaln(lds, (const float*)a.in[1], (const float*)a.in[3], (const float*)a.in[4], (float*)(ws + WS_MODP), blk, tid);
        p0_weights(lds, a, blk, wave, lane, tid);
        if (h0) tr_finish(t0, tv, (LAS float*)(lds + 65536 + wave * 8704), lane);
    }
    SEAM(0);
    if (IN(1)) p1a_rows(lds, a, blk, wave, lane, tid);
    SEAM(1);
    if (IN(2)) {
        pg8::DenseOrder S; S.init(ws + WS_H, ws + WS_WIN, M, PW, D, GRID, blk);
        pg8::EpiBf16 E{(bf16*)(ws + WS_PROJ), PW};
        constexpr int TG0 = 16 * 72 + 16 * 32, TG1 = TG0 + 32 * 2 * 128, TGM = TG0 + 32 * 128;
        if (blk >= 128) { tr_stream(lds, a, TG0, TGM, (blk - 128) * NWAVES + wave, 128 * NWAVES, wave, lane); __syncthreads(); }
        pg8::gemm_phase<pg8::EpiBf16, pg8::DenseOrder, true>(lds, D, S, E);
        if (blk >= 128) tr_stream(lds, a, TGM, TG1, (blk - 128) * NWAVES + wave, 128 * NWAVES, wave, lane);
    }
    SEAM(2);
    if (IN(3)) {
        const bf16* proj = (const bf16*)(ws + WS_PROJ); bf16* o = (bf16*)(ws + WS_O);
        swa_unit(lds, proj, (const float*)(ws + WS_ROPE), (const float*)a.in[10], o, blk, tid, lane, wave);
        gla_kv_group(lds, proj, (const float*)a.in[8], (bf16*)(ws + WS_SG), (bf16*)(ws + WS_KVG), (float*)(ws + WS_DECG), blk >> 3, blk & 7, tid, lane, wave);
    }
    SEAM(3);
    if (IN(4)) {
        const bf16* proj = (const bf16*)(ws + WS_PROJ); bf16* o = (bf16*)(ws + WS_O);
        gla_out_block(lds, proj, (const bf16*)(ws + WS_SG), (const bf16*)(ws + WS_KVG), (const float*)(ws + WS_DECG), (const float*)a.in[9], o, blk >> 3, blk & 7, tid, lane, wave);
    }
    SEAM(4);
    if (IN(5)) {
        pg8::DenseOrder S; S.init(ws + WS_O, ws + WS_WOUT, M, D, D, GRID, blk);
        pg8::EpiX1 E{(const float*)a.in[0], (bf16*)(ws + WS_X1), (const float*)(ws + WS_MOD)};
        pg8::gemm_phase<pg8::EpiX1, pg8::DenseOrder, false>(lds, D, S, E);
    }
    SEAM(5);
    if (IN(6)) p3b_route(lds, a, blk, wave, lane, tid);
    SEAM(6);
    if (IN(7)) {
        moe_prefix(tp, (const int*)ctl + CW_CNT, tid);
        pg8::MoeOrder<true> S; S.A = (const char*)(ws + WS_H); S.Bt = (const char*)(ws + WS_WGU); S.K = D; S.npn = 2; S.G = GRID; S.c = blk; S.bstride = (size_t)512 * D * 2;
        S.tp = tp; S.cnt = (const int*)ctl + CW_CNT; S.list = (const int*)(ws + WS_ROUTE);
        pg8::EpiAct E{(bf16*)(ws + WS_PROJ), (const int*)ctl + CW_CNT, (const float*)(ws + WS_ROUTE + 2 * MiB), tp};
        pg8::gemm_phase<pg8::EpiAct, pg8::MoeOrder<true>, true>(lds, D, S, E);
        if (blk >= 128) tr_stream(lds, a, 16 * 72 + 16 * 32 + 32 * 2 * 128, 16 * 72 + 16 * 32 + 32 * 2 * 128 + 32 * 128, (blk - 128) * NWAVES + wave, 128 * NWAVES, wave, lane);
    }
    SEAM(7);
    if (IN(8)) {
        moe_prefix(tp, (const int*)ctl + CW_CNT, tid);
        pg8::MoeOrder<false> S; S.A = (const char*)(ws + WS_PROJ); S.Bt = (const char*)(ws + WS_WD); S.K = 256; S.npn = 4; S.G = GRID; S.c = blk; S.bstride = (size_t)D * 256 * 2;
        S.tp = tp; S.cnt = (const int*)ctl + CW_CNT; S.list = (const int*)(ws + WS_ROUTE);
        pg8::EpiDown E{(bf16*)(ws + WS_Y2), (const int*)ctl + CW_CNT, (const int*)(ws + WS_ROUTE), tp};
        pg8::gemm_phase<pg8::EpiDown, pg8::MoeOrder<false>, true>(lds, 256, S, E);
    }
    SEAM(8);
    if (IN(9)) p6_final(lds, a, blk, wave, lane, tid);
#undef IN
#undef SEAM
}

extern "C" void kernel_launch(void* const* d_in, const int* in_sizes, int n_in, void* d_out, int out_size, void* d_ws, size_t ws_size, hipStream_t stream) {
    static int grid = 0;
    if (grid == 0) {
        if (n_in != 21 || in_sizes[0] != M * D || out_size != M * D || ws_size < WS_END) { fprintf(stderr, "kernel_launch: unexpected shapes (n_in %d, in0 %d, out %d, ws %zu)\n", n_in, n_in > 0 ? in_sizes[0] : -1, out_size, ws_size); grid = -1; return; }
        int dev = 0, cus = 0, per_cu = 0;
        if (hipGetDevice(&dev) != hipSuccess || hipDeviceGetAttribute(&cus, hipDeviceAttributeMultiprocessorCount, dev) != hipSuccess) { fprintf(stderr, "kernel_launch: device query failed\n"); grid = -1; return; }
        if (hipFuncSetAttribute((const void*)mk_fwd, hipFuncAttributeMaxDynamicSharedMemorySize, LDS_BYTES) != hipSuccess) { fprintf(stderr, "kernel_launch: hipFuncSetAttribute failed\n"); grid = -1; return; }
        if (hipOccupancyMaxActiveBlocksPerMultiprocessor(&per_cu, (const void*)mk_fwd, NTHR, LDS_BYTES) != hipSuccess || per_cu < 1) { fprintf(stderr, "kernel_launch: occupancy query says %d workgroups per CU\n", per_cu); grid = -1; return; }
        if (cus * per_cu < GRID) { fprintf(stderr, "kernel_launch: needs %d co-resident workgroups, device holds %d x %d\n", GRID, cus, per_cu); grid = -1; return; }
        grid = GRID;
    }
    if (grid < 0) return;
    (void)hipMemsetAsync((char*)d_ws + WS_CTL, 0, CTL_ZERO_BYTES, stream);
    Args a{};
    for (int i = 0; i < 21; ++i) a.in[i] = d_in[i];
    a.out = (float*)d_out; a.ws = (unsigned char*)d_ws;
    for (int i = 0; i < 8; ++i) a.rt.inv_freq[i] = (float)pow(500000.0, -(double)(2 * i) / 16.0);
    a.ph_lo = 0; a.ph_hi = NPH;
    void* args[] = {&a};
    const hipError_t e = hipLaunchCooperativeKernel((const void*)mk_fwd, dim3(GRID), dim3(NTHR), args, LDS_BYTES, stream);
    if (e != hipSuccess) fprintf(stderr, "kernel_launch: cooperative launch failed: %s\n", hipGetErrorString(e));
}
```

```cpp
#include <hip/hip_runtime.h>
#include <cstdio>
#include <cstdint>
#include <cmath>

typedef unsigned short bf16;
typedef float f32x4 __attribute__((ext_vector_type(4)));
typedef float f32x2 __attribute__((ext_vector_type(2)));
typedef float f32x16 __attribute__((ext_vector_type(16)));
typedef unsigned u32x4 __attribute__((ext_vector_type(4)));
typedef unsigned u32x2 __attribute__((ext_vector_type(2)));
typedef short bf16x8 __attribute__((ext_vector_type(8)));
#define GAS __attribute__((address_space(1)))
#define LAS __attribute__((address_space(3)))

__device__ __forceinline__ float bf2f(bf16 v) { return __uint_as_float(((unsigned)v) << 16); }
__device__ __forceinline__ unsigned f2bf(float f) { unsigned u = __float_as_uint(f); return (u + 0x7fffu + ((u >> 16) & 1u)) >> 16; }
typedef float f32x2_t __attribute__((ext_vector_type(2))); typedef __bf16 bf16x2_t __attribute__((ext_vector_type(2)));
__device__ __forceinline__ unsigned pk2(float lo, float hi) { const f32x2_t v = {lo, hi}; const bf16x2_t b = __builtin_convertvector(v, bf16x2_t); return __builtin_bit_cast(unsigned, b); }
__device__ __forceinline__ float lo_bf16(unsigned w) { return __uint_as_float(w << 16); }
__device__ __forceinline__ float hi_bf16(unsigned w) { return __uint_as_float(w & 0xffff0000u); }
__device__ __forceinline__ float silu_f(float v) { return v * __builtin_amdgcn_rcpf(1.f + __expf(-v)); }
template <int CTRL> __device__ __forceinline__ float dpp_mov(float v) { return __int_as_float(__builtin_amdgcn_update_dpp(0, __float_as_int(v), CTRL, 0xF, 0xF, true)); }
__device__ __forceinline__ float wave_sum(float v) {
    v += dpp_mov<0xB1>(v); v += dpp_mov<0x4E>(v); v += dpp_mov<0x141>(v); v += dpp_mov<0x140>(v);
    const float r0 = __int_as_float(__builtin_amdgcn_readlane(__float_as_int(v), 0)), r1 = __int_as_float(__builtin_amdgcn_readlane(__float_as_int(v), 16));
    const float r2 = __int_as_float(__builtin_amdgcn_readlane(__float_as_int(v), 32)), r3 = __int_as_float(__builtin_amdgcn_readlane(__float_as_int(v), 48));
    return (r0 + r1) + (r2 + r3);
}

constexpr int NB = 8, SEQ = 2048, D = 1024, M = NB * SEQ;
constexpr int PW = 2560;
constexpr int C_GQ = 0, C_GK = 256, C_GV = 512, C_GG = 1024, C_SQ = 1536, C_SK = 2048, C_SV = 2176, C_Z = 2304;
constexpr int INW = 2320;
constexpr float EPS = 1e-6f;
constexpr int NEXP = 32, LCAP = 16384;
constexpr int NWAVES = 8, NTHR = 512, GRID = 256;

constexpr size_t MiB = 1u << 20;
constexpr size_t WS_CTL = 0, CTL_ZERO_BYTES = 256 * 1024;
constexpr int CW_CNT = 0, CNT_STRIDE = 64, CW_BAR = 4096;
constexpr size_t WS_MODP = 1 * MiB;
constexpr size_t WS_MOD = 2 * MiB + 512 * 1024;
constexpr size_t WS_ROPE = 3 * MiB;
constexpr size_t WS_WIN = 4 * MiB;
constexpr size_t WS_WOUT = 10 * MiB;
constexpr size_t WS_WGU = 12 * MiB;
constexpr size_t WS_WD = 44 * MiB;
constexpr size_t WS_ROUTE = 60 * MiB;
constexpr size_t WS_H = 64 * MiB;
constexpr size_t WS_SG = 208 * MiB;
constexpr size_t WS_O = 96 * MiB;
constexpr size_t WS_PROJ = 128 * MiB;
constexpr size_t WS_X1 = 160 * MiB;
constexpr size_t WS_Y2 = 64 * MiB;
constexpr size_t WS_DEC = 224 * MiB;
constexpr size_t WS_KVG = 225 * MiB;
constexpr size_t WS_DECG = 229 * MiB;
constexpr size_t WS_WRB = 230 * MiB;
constexpr size_t WS_END = 231 * MiB;

constexpr int LDS_BYTES = 163840;
constexpr int MISC_OFF = LDS_BYTES - 512;
namespace pg8 {
#define PG8_LAS __attribute__((address_space(3)))
constexpr int BM = 256, BK = 64, HALF = 128, HTB = HALF * BK * 2  , STAGE_BYTES = 8 * HTB, NXCD = 8, WGM = 8;

__host__ __device__ __forceinline__ int lds_byte(int r, int c) { const int st = (r >> 4) * 2 + (c >> 5), rr = r & 15, cc = c & 31, ob = rr * 64 + cc * 2; return st * 1024 + (ob ^ (((ob >> 9) & 1) << 5)); }
__host__ __device__ __forceinline__ void stage_rc(int b, int& R, int& C) { const int st = b / 1024, sb = b % 1024, swz = sb ^ (((sb >> 9) & 1) << 5); R = (st >> 1) * 16 + swz / 64; C = (st & 1) * 32 + (swz % 64) / 2; }
__host__ __device__ __forceinline__ int perm32(int rho) { const int n = rho >> 4, i = rho & 15; return 8 * (i >> 2) + 4 * n + (i & 3); }

struct Unit { const char* A; const char* B; int i0, i1, i2, qm; };

__device__ __forceinline__ int xcd_remap(int wgid, int nwg) { const int q = nwg / NXCD, r = nwg % NXCD, xcd = wgid % NXCD, off = wgid / NXCD; return (xcd < r ? xcd * (q + 1) : r * (q + 1) + (xcd - r) * q) + off; }

struct DenseOrder {
    const char* A; const char* Bt; int K, nM, nN, nwg, G, c;
    __device__ void init(const void* A_, const void* Bt_, int M, int N, int K_, int G_, int c_) { A = (const char*)A_; Bt = (const char*)Bt_; K = K_; nM = M / BM; nN = N / BM; nwg = nM * nN; G = G_; c = c_; }
    __device__ __forceinline__ bool next(int i, Unit& u) const {
        const int L = i * G + c; if (L >= nwg) return false;
        const int wgid = xcd_remap(L, nwg);
        const int nig = WGM * nN, gid = wgid / nig, fm = gid * WGM, gsz = (nM - fm) < WGM ? (nM - fm) : WGM;
        const int pm = fm + ((wgid % nig) % gsz), pn = (wgid % nig) / gsz;
        u.A = A + (size_t)pm * BM * K * 2; u.B = Bt + (size_t)pn * BM * K * 2; u.i0 = pm; u.i1 = pn; u.i2 = 0; u.qm = 15; return true;
    }
    __device__ __forceinline__ void a_voff(const Unit&, const int (&R)[2], const int (&C)[2], unsigned (&v)[2][2]) const {
#pragma unroll
        for (int h = 0; h < 2; ++h)
#pragma unroll
            for (int i = 0; i < 2; ++i) v[h][i] = (unsigned)((h * HALF + R[i]) * K + C[i]) * 2u;
    }
};

template <bool GATHER> struct MoeOrder {
    const char* A; const char* Bt; int K, npn, G, c; size_t bstride; const PG8_LAS int* tp; const int* cnt; const int* list;
    __device__ __forceinline__ bool next(int i, Unit& u) const {
        const int ntile = tp[32], nwg = ntile * npn, nfr = nwg / G, nfull = nfr * G, R = nwg - nfull, f = (4 * R <= G) ? 4 : (2 * R <= G) ? 2 : 1;
        int L, qm;
        if (i < nfr) { L = i * G + c; qm = 15; }
        else { if (i > nfr) return false;
            const int P = (f * R + 7) >> 3, x = c & 7, y = c >> 3, j = x * P + y;
            if (y >= P || j >= f * R) return false; L = nfull + j / f; qm = f == 4 ? (1 << (j & 3)) : f == 2 ? ((j & 1) ? 10 : 5) : 15; }
        u.qm = __builtin_amdgcn_readfirstlane(qm);
        const int wgid = xcd_remap(L, nwg); const int T = wgid / npn, pn = wgid % npn;
        const int e = tp[40 + T];
        u.i0 = e; u.i1 = T - tp[e]; u.i2 = pn;
        u.A = GATHER ? A : A + (size_t)T * BM * K * 2; u.B = Bt + (size_t)e * bstride + (size_t)pn * BM * K * 2; return true;
    }
    __device__ __forceinline__ void a_voff(const Unit& u, const int (&R)[2], const int (&C)[2], unsigned (&v)[2][2]) const {
        if (GATHER) {
            const int n = tp[208 + u.i0]; int tk[2][2];
#pragma unroll
            for (int h = 0; h < 2; ++h)
#pragma unroll
                for (int i = 0; i < 2; ++i) { const int r = u.i1 * BM + h * HALF + R[i]; tk[h][i] = (r < n) ? list[u.i0 * 16384 + r] : 0; }
            asm volatile("s_waitcnt vmcnt(0)" ::: "memory");
#pragma unroll
            for (int h = 0; h < 2; ++h)
#pragma unroll
                for (int i = 0; i < 2; ++i) v[h][i] = (unsigned)((tk[h][i] >> 1) * K + C[i]) * 2u;
            asm volatile("" : "+v"(v[0][0]), "+v"(v[0][1]), "+v"(v[1][0]), "+v"(v[1][1]));
        } else {
#pragma unroll
            for (int h = 0; h < 2; ++h)
#pragma unroll
                for (int i = 0; i < 2; ++i) v[h][i] = (unsigned)((h * HALF + R[i]) * K + C[i]) * 2u;
        }
    }
};

__device__ __forceinline__ unsigned cvt_pk_bf16(float lo, float hi) { unsigned r; asm volatile("v_cvt_pk_bf16_f32 %0, %1, %2" : "=v"(r) : "v"(lo), "v"(hi)); return r; }

struct EpiBf16 {
    static constexpr bool PERM = true;
    bf16* O; int ldc;
    __device__ __forceinline__ void operator()(const f32x4 (&acc)[2][2][4][2], const Unit& u, int wr, int wc, int fr, int fq) const {
        const int row0 = u.i0 * BM + wr * 64 + fr; const int col0 = u.i1 * BM + wc * 32 + 8 * fq;
#pragma unroll
        for (int ai = 0; ai < 2; ++ai)
#pragma unroll
            for (int m = 0; m < 4; ++m) { bf16* rowp = O + (size_t)(row0 + ai * HALF + m * 16) * ldc + col0;
#pragma unroll
                for (int bj = 0; bj < 2; ++bj) { const f32x4 v0 = acc[ai][bj][m][0], v1 = acc[ai][bj][m][1];
                    u32x4 w; w.x = cvt_pk_bf16(v0[0], v0[1]); w.y = cvt_pk_bf16(v0[2], v0[3]); w.z = cvt_pk_bf16(v1[0], v1[1]); w.w = cvt_pk_bf16(v1[2], v1[3]);
                    *(u32x4*)(rowp + bj * HALF) = w; } }
    }
};

struct EpiX1 {
    static constexpr bool PERM = true;
    const float* x; bf16* out; const float* mod;
    __device__ __forceinline__ void operator()(const f32x4 (&acc)[2][2][4][2], const Unit& u, int wr, int wc, int fr, int fq) const {
        const int row0 = u.i0 * BM + wr * 64 + fr; const int col0 = u.i1 * BM + wc * 32 + 8 * fq;
        const float* gt = mod + (u.i0 >> 3) * 6144 + 2048;
        f32x4 gv[2][2];
#pragma unroll
        for (int bj = 0; bj < 2; ++bj)
#pragma unroll
            for (int n = 0; n < 2; ++n) gv[bj][n] = *(const f32x4*)(gt + col0 + bj * HALF + 4 * n);
#pragma unroll
        for (int ai = 0; ai < 2; ++ai) {
            f32x4 xv[4][2][2];
#pragma unroll
            for (int m = 0; m < 4; ++m) { const size_t off = (size_t)(row0 + ai * HALF + m * 16) * 1024 + col0;
#pragma unroll
                for (int bj = 0; bj < 2; ++bj) { xv[m][bj][0] = *(const f32x4*)(x + off + bj * HALF); xv[m][bj][1] = *(const f32x4*)(x + off + bj * HALF + 4); } }
            asm volatile("" ::: "memory");
#pragma unroll
            for (int m = 0; m < 4; ++m) { const size_t off = (size_t)(row0 + ai * HALF + m * 16) * 1024 + col0;
#pragma unroll
                for (int bj = 0; bj < 2; ++bj) { const f32x4 v0 = xv[m][bj][0] + gv[bj][0] * acc[ai][bj][m][0], v1 = xv[m][bj][1] + gv[bj][1] * acc[ai][bj][m][1];
                    u32x4 w; w.x = cvt_pk_bf16(v0[0], v0[1]); w.y = cvt_pk_bf16(v0[2], v0[3]); w.z = cvt_pk_bf16(v1[0], v1[1]); w.w = cvt_pk_bf16(v1[2], v1[3]);
                    *(u32x4*)(out + off + bj * HALF) = w; } }
        }
    }
};

struct EpiAct {
    static constexpr bool PERM = false;
    bf16* act; const int* cnt; const float* lw; const PG8_LAS int* tp;
    __device__ __forceinline__ void operator()(const f32x4 (&acc)[2][2][4][2], const Unit& u, int wr, int wc, int fr, int fq) const {
        const int e = u.i0, n_e = tp[208 + e]; const int rl0 = u.i1 * BM + wr * 64 + fr; const size_t rbase = (size_t)(tp[e] + u.i1) * BM + wr * 64 + fr;
        const int f0 = u.i2 * 128 + wc * 16 + 4 * fq;
        float wrow[2][4];
#pragma unroll
        for (int ai = 0; ai < 2; ++ai)
#pragma unroll
            for (int m = 0; m < 4; ++m) { const int rl = rl0 + ai * HALF + m * 16; wrow[ai][m] = (rl < n_e) ? lw[e * 16384 + rl] : 0.f; }
        asm volatile("" ::: "memory");
#pragma unroll
        for (int ai = 0; ai < 2; ++ai)
#pragma unroll
            for (int m = 0; m < 4; ++m) { const int rl = rl0 + ai * HALF + m * 16;
                if (rl < n_e) { const float w = wrow[ai][m]; bf16* rowp = act + (rbase + ai * HALF + m * 16) * 256 + f0;
#pragma unroll
                    for (int bj = 0; bj < 2; ++bj) if ((u.qm >> (2 * ai + bj)) & 1) { const f32x4 g = acc[ai][bj][m][0], up = acc[ai][bj][m][1]; u32x2 o;
                        o.x = cvt_pk_bf16(silu_f(g[0]) * up[0] * w, silu_f(g[1]) * up[1] * w); o.y = cvt_pk_bf16(silu_f(g[2]) * up[2] * w, silu_f(g[3]) * up[3] * w);
                        *(u32x2*)(rowp + bj * 64) = o; } } }
    }
};

struct EpiDown {
    static constexpr bool PERM = true;
    bf16* y2; const int* cnt; const int* list; const PG8_LAS int* tp;
    __device__ __forceinline__ void operator()(const f32x4 (&acc)[2][2][4][2], const Unit& u, int wr, int wc, int fr, int fq) const {
        const int e = u.i0, n_e = tp[208 + e]; const int rl0 = u.i1 * BM + wr * 64 + fr; const int col0 = u.i2 * BM + wc * 32 + 8 * fq;
        int tkr[2][4];
#pragma unroll
        for (int ai = 0; ai < 2; ++ai)
#pragma unroll
            for (int m = 0; m < 4; ++m) { const int rl = rl0 + ai * HALF + m * 16; tkr[ai][m] = (rl < n_e) ? list[e * 16384 + rl] : -1; }
        asm volatile("" ::: "memory");
#pragma unroll
        for (int ai = 0; ai < 2; ++ai)
#pragma unroll
            for (int m = 0; m < 4; ++m) { const int tk = tkr[ai][m];
                if (tk >= 0) { bf16* rowp = y2 + (size_t)tk * 1024 + col0;
#pragma unroll
                    for (int bj = 0; bj < 2; ++bj) if ((u.qm >> (2 * ai + bj)) & 1) { const f32x4 v0 = acc[ai][bj][m][0], v1 = acc[ai][bj][m][1];
                        u32x4 w; w.x = cvt_pk_bf16(v0[0], v0[1]); w.y = cvt_pk_bf16(v0[2], v0[3]); w.z = cvt_pk_bf16(v1[0], v1[1]); w.w = cvt_pk_bf16(v1[2], v1[3]);
                        *(u32x4*)(rowp + bj * HALF) = w; } } }
    }
};

template <class Epi, class Sched, bool ALIGN_EPI>
__device__ __forceinline__ void gemm_phase(PG8_LAS unsigned char* lds, const int K, const Sched& S, const Epi& E) {
    const int tid = threadIdx.x, wid = __builtin_amdgcn_readfirstlane(tid >> 6), lane = tid & 63, wr = wid >> 2, wc = wid & 3, fr = lane & 15, fq = lane >> 4;
    const int nt = K / BK;
    int Rr[2], Cc[2]; unsigned voffB[2];
#pragma unroll
    for (int i = 0; i < 2; ++i) { int R, C; stage_rc(tid * 16 + i * 8192, R, C); Rr[i] = R; Cc[i] = C; const int Rb = Epi::PERM ? ((R & ~31) + perm32(R & 31)) : R; voffB[i] = (unsigned)(Rb * K + C) * 2u; }
    const size_t kstep = (size_t)(BK * 2);
    const size_t hstep = (size_t)HALF * K * 2;
    const unsigned ldsw = (unsigned)wid * 1024u;
    const int aoff = lds_byte(wr * 64 + fr, fq * 8), boff = lds_byte(wc * 32 + fr, fq * 8);
#define PG8_SA(b, h) (((b) * 2 + (h)) * HTB)
#define PG8_SB(b, h) ((4 + (b) * 2 + (h)) * HTB)
#define PG8_STG(bufoff, gbase, v0, v1) do { \
        __builtin_amdgcn_global_load_lds((const unsigned*)((const char*)(gbase) + (v0)), (PG8_LAS unsigned*)(lds + (bufoff) + ldsw), 16, 0, 0); \
        __builtin_amdgcn_global_load_lds((const unsigned*)((const char*)(gbase) + (v1)), (PG8_LAS unsigned*)(lds + (bufoff) + ldsw + 8192), 16, 0, 0); } while (0)
#define PG8_STGB(bufoff, gbase) PG8_STG(bufoff, gbase, voffB[0], voffB[1])
#define PG8_LDA(dst, b, h) do { _Pragma("unroll") for (int m = 0; m < 4; ++m) _Pragma("unroll") for (int k = 0; k < 2; ++k) dst[m][k] = *(const PG8_LAS bf16x8*)(lds + PG8_SA(b, h) + aoff + m * 2048 + k * 1024); } while (0)
#define PG8_LDB(dst, b, h) do { _Pragma("unroll") for (int n = 0; n < 2; ++n) _Pragma("unroll") for (int k = 0; k < 2; ++k) dst[n][k] = *(const PG8_LAS bf16x8*)(lds + PG8_SB(b, h) + boff + n * 2048 + k * 1024); } while (0)
#define PG8_MMA(ai, bj, At, Bt) do { __builtin_amdgcn_s_setprio(1); _Pragma("unroll") for (int m = 0; m < 4; ++m) _Pragma("unroll") for (int n = 0; n < 2; ++n) _Pragma("unroll") for (int k = 0; k < 2; ++k) \
        acc[ai][bj][m][n] = __builtin_amdgcn_mfma_f32_16x16x32_bf16(Bt[n][k], At[m][k], acc[ai][bj][m][n], 0, 0, 0); __builtin_amdgcn_s_setprio(0); } while (0)
#define PG8_WAIT_V(n) asm volatile("s_waitcnt vmcnt(" #n ")" ::: "memory")
#define PG8_WAIT_L(n) asm volatile("s_waitcnt lgkmcnt(" #n ")" ::: "memory")
#define PG8_BAR __builtin_amdgcn_s_barrier()
#define PG8_SCHED __builtin_amdgcn_sched_barrier(0)
    Unit cur, nxt; int ui = 0;
    if (!S.next(0, cur)) return;
    unsigned cv[2][2], nv[2][2];
    S.a_voff(cur, Rr, Cc, cv);
#define PG8_QFIX(qm, v) do { if (!((qm) & 3)) { v[0][0] = v[1][0]; v[0][1] = v[1][1]; } if (!((qm) & 12)) { v[1][0] = v[0][0]; v[1][1] = v[0][1]; } } while (0)
    PG8_QFIX(cur.qm, cv);
    size_t chb0 = (cur.qm & 5) ? 0 : hstep, chb1 = (cur.qm & 10) ? hstep : 0;
    f32x4 acc[2][2][4][2];
#pragma unroll
    for (int a = 0; a < 2; ++a)
#pragma unroll
        for (int b = 0; b < 2; ++b)
#pragma unroll
            for (int m = 0; m < 4; ++m)
#pragma unroll
                for (int n = 0; n < 2; ++n) acc[a][b][m][n] = (f32x4){0.f, 0.f, 0.f, 0.f};
    bf16x8 At[4][2], B0[2][2], B1[2][2];
    const char* cA = cur.A; const char* cB = cur.B;
    PG8_STGB(PG8_SB(0, 0), cB + chb0); PG8_STGB(PG8_SB(0, 1), cB + chb1); PG8_STG(PG8_SA(0, 0), cA, cv[0][0], cv[0][1]); PG8_STG(PG8_SA(0, 1), cA, cv[1][0], cv[1][1]);
    if (wr == 1) PG8_BAR;
    PG8_WAIT_V(2); PG8_BAR;
    PG8_STGB(PG8_SB(1, 0), cB + chb0 + kstep); PG8_STG(PG8_SA(1, 0), cA + kstep, cv[0][0], cv[0][1]); PG8_STGB(PG8_SB(1, 1), cB + chb1 + kstep);
    PG8_WAIT_V(6); PG8_BAR;
    for (;;) {
        const bool has_next = S.next(ui + 1, nxt);
        if (has_next) { S.a_voff(nxt, Rr, Cc, nv); PG8_QFIX(nxt.qm, nv); }
        else { nv[0][0] = cv[0][0]; nv[0][1] = cv[0][1]; nv[1][0] = cv[1][0]; nv[1][1] = cv[1][1]; }
        const char* nA = has_next ? nxt.A : cA; const char* nB = has_next ? nxt.B : cB;
        const size_t nhb0 = has_next ? ((nxt.qm & 5) ? 0 : hstep) : chb0, nhb1 = has_next ? ((nxt.qm & 10) ? hstep : 0) : chb1;
        const bool q00 = cur.qm & 1, q01 = cur.qm & 2, q10 = cur.qm & 4, q11 = cur.qm & 8;
#pragma unroll 1
        for (int t = 0; t < nt; t += 2) {
            const bool last = (t == nt - 2);
            const char* a1 = cA + (size_t)(t + 1) * kstep;
            const char* a2 = last ? nA : cA + (size_t)(t + 2) * kstep; const char* b2 = last ? nB : cB + (size_t)(t + 2) * kstep;
            const char* a3 = a2 + kstep; const char* b3 = b2 + kstep;
            const size_t h0 = last ? nhb0 : chb0, h1 = last ? nhb1 : chb1;
            const unsigned x00 = last ? nv[0][0] : cv[0][0], x01 = last ? nv[0][1] : cv[0][1], x10 = last ? nv[1][0] : cv[1][0], x11 = last ? nv[1][1] : cv[1][1];
            PG8_LDB(B0, 0, 0); PG8_LDB(B1, 0, 1); PG8_SCHED; PG8_LDA(At, 0, 0); PG8_STG(PG8_SA(1, 1), a1, cv[1][0], cv[1][1]);
            PG8_WAIT_V(8); PG8_WAIT_L(0); PG8_BAR; if (q00) PG8_MMA(0, 0, At, B0); if (q01) PG8_MMA(0, 1, At, B1); PG8_BAR; PG8_SCHED;
            PG8_LDA(At, 0, 1); PG8_STGB(PG8_SB(0, 0), b2 + h0); PG8_STGB(PG8_SB(0, 1), b2 + h1); PG8_STG(PG8_SA(0, 0), a2, x00, x01);
            PG8_WAIT_V(8); PG8_WAIT_L(0); PG8_BAR; if (q10) PG8_MMA(1, 0, At, B0); if (q11) PG8_MMA(1, 1, At, B1); PG8_BAR; PG8_SCHED;
            PG8_LDB(B0, 1, 0); PG8_LDB(B1, 1, 1); PG8_SCHED; PG8_LDA(At, 1, 0); PG8_STG(PG8_SA(0, 1), a2, x10, x11);
            PG8_WAIT_V(8); PG8_WAIT_L(0); PG8_BAR; if (q00) PG8_MMA(0, 0, At, B0); if (q01) PG8_MMA(0, 1, At, B1); PG8_BAR; PG8_SCHED;
            PG8_LDA(At, 1, 1); PG8_STGB(PG8_SB(1, 0), b3 + h0); PG8_STGB(PG8_SB(1, 1), b3 + h1); PG8_STG(PG8_SA(1, 0), a3, x00, x01);
            PG8_WAIT_V(8); PG8_WAIT_L(0); PG8_BAR; if (q10) PG8_MMA(1, 0, At, B0); if (q11) PG8_MMA(1, 1, At, B1); PG8_BAR; PG8_SCHED;
        }
        if constexpr (ALIGN_EPI) { if (wr == 0) PG8_BAR; }
        E(acc, cur, wr, wc, fr, fq);
        if (!has_next) break;
#pragma unroll
        for (int a = 0; a < 2; ++a)
#pragma unroll
            for (int b = 0; b < 2; ++b)
#pragma unroll
                for (int m = 0; m < 4; ++m)
#pragma unroll
                    for (int n = 0; n < 2; ++n) acc[a][b][m][n] = (f32x4){0.f, 0.f, 0.f, 0.f};
        cur = nxt; cA = nA; cB = nB; ++ui; chb0 = nhb0; chb1 = nhb1;
        cv[0][0] = nv[0][0]; cv[0][1] = nv[0][1]; cv[1][0] = nv[1][0]; cv[1][1] = nv[1][1];
        if constexpr (ALIGN_EPI) { if (wr == 1) PG8_BAR; }
    }
    PG8_WAIT_V(0);
    if constexpr (!ALIGN_EPI) { if (wr == 0) PG8_BAR; }
    PG8_BAR;
#undef PG8_SA
#undef PG8_QFIX
#undef PG8_SB
#undef PG8_STG
#undef PG8_STGB
#undef PG8_LDA
#undef PG8_LDB
#undef PG8_MMA
#undef PG8_WAIT_V
#undef PG8_WAIT_L
#undef PG8_BAR
#undef PG8_SCHED
}
}
#define XB_TMO      128
#define XB_XCNT(j)  (256  + 64 * (j))
#define XB_XSUB(j)  (1280 + 64 * (j))
#define XB_XGEN(j)  (2304 + 64 * (j))
#define XB_TOP      3328
#define XB_TOPGEN   3392
#define XCD_BAR_WORDS 3456
#define XB_SPIN_CAP (1u << 18)

__device__ __forceinline__ unsigned xb_ld(unsigned* p)              { return __hip_atomic_load(p, __ATOMIC_RELAXED, __HIP_MEMORY_SCOPE_AGENT); }
__device__ __forceinline__ unsigned xb_add(unsigned* p, unsigned v) { return __hip_atomic_fetch_add(p, v, __ATOMIC_RELAXED, __HIP_MEMORY_SCOPE_AGENT); }
__device__ __forceinline__ unsigned xb_xcc_id() { return (unsigned)__builtin_amdgcn_s_getreg((3 << 11) | 20) & 0xFu; }
#define XB_SPIN(cond, bar) do { unsigned _sp = 0; while (cond) { __builtin_amdgcn_s_sleep(1); \
    if ((++_sp & 255u) == 0u) { if (xb_ld(&(bar)[XB_TMO])) break; if (_sp > XB_SPIN_CAP) { atomicAdd(&(bar)[XB_TMO], 1u); break; } } } } while (0)

struct XcdBarrier {
    unsigned* bar; unsigned x;
    volatile LAS unsigned* st;
};

__device__ __forceinline__ XcdBarrier xcd_barrier_post(unsigned* bar, volatile LAS unsigned* st) {
    XcdBarrier b; b.bar = bar; b.x = xb_xcc_id(); b.st = st;
    if (threadIdx.x == 0) (void)xb_add(&bar[XB_XCNT(b.x)], 1u);
    return b;
}
__device__ __forceinline__ void xcd_barrier_complete(unsigned* bar, unsigned x, unsigned& nloc, unsigned& nx) {
    const unsigned G = gridDim.x * gridDim.y * gridDim.z;
    unsigned sum, cnt, mine, sp = 0u;
    for (;;) {
        sum = 0u; cnt = 0u; mine = 0u;
#pragma unroll
        for (unsigned j = 0; j < 16; ++j) { const unsigned c = xb_ld(&bar[XB_XCNT(j)]); sum += c; cnt += (c > 0u) ? 1u : 0u; mine = (j == x) ? c : mine; }
        if (sum == G) break;
        __builtin_amdgcn_s_sleep(1);
        if ((++sp & 255u) == 0u) { if (xb_ld(&bar[XB_TMO])) break; if (sp > XB_SPIN_CAP) { atomicAdd(&bar[XB_TMO], 1u); break; } }
    }
    nloc = mine > 0u ? mine : 1u; nx = cnt > 0u ? cnt : 1u;
}

__device__ __forceinline__ void xcd_barrier(const XcdBarrier& b) {
    asm volatile("s_waitcnt vmcnt(0)" ::: "memory");
    __syncthreads();
    if (threadIdx.x == 0) {
        unsigned* bar = b.bar;
        __builtin_amdgcn_s_waitcnt(0);
        unsigned nloc = b.st[0], nx = b.st[1];
        if (nloc == 0u) { xcd_barrier_complete(bar, b.x, nloc, nx); b.st[0] = nloc; b.st[1] = nx; }
        const unsigned old = xb_add(&bar[XB_XSUB(b.x)], 1u);
        const unsigned gen = old / nloc;
        if (old + 1u == (gen + 1u) * nloc) {
            __builtin_amdgcn_fence(__ATOMIC_RELEASE, "agent");
            asm volatile("s_waitcnt vmcnt(0)" ::: "memory");
            const unsigned og = xb_add(&bar[XB_TOP], 1u);
            const unsigned tg = og / nx;
            if (og + 1u == (tg + 1u) * nx) xb_add(&bar[XB_TOPGEN], 1u);
            else XB_SPIN(xb_ld(&bar[XB_TOPGEN]) == tg, bar);
            __builtin_amdgcn_fence(__ATOMIC_ACQUIRE, "agent");
            xb_add(&bar[XB_XGEN(b.x)], 1u);
            asm volatile("s_waitcnt vmcnt(0)" ::: "memory");
        } else {
            __builtin_amdgcn_fence(__ATOMIC_ACQUIRE, "agent");
            XB_SPIN(xb_ld(&bar[XB_XGEN(b.x)]) == gen, bar);
            asm volatile("s_waitcnt vmcnt(0)" ::: "memory");
        }
    }
    __syncthreads();
}
struct RopeTab { float inv_freq[8]; };
struct Args { const void* in[21]; float* out; unsigned char* ws; int ph_lo, ph_hi; RopeTab rt; };

__device__ __forceinline__ void p0_adaln(LAS unsigned char* lds, const float* c, const float* ada_w, const float* ada_b, float* modp, int blk, int tid) {
    LAS float* ca = (LAS float*)lds;
    LAS float* red = (LAS float*)(lds + 4096);
    const int kc = blk >> 5, cc = blk & 31;
    for (int i = tid; i < 1024; i += NTHR) { const int b = i >> 7, k = i & 127; ca[i] = silu_f(c[b * D + kc * 128 + k]); }
    __syncthreads();
    if (tid < 480) {
        const int cq = tid % 48, kr = tid / 48;
        f32x4 acc[8];
#pragma unroll
        for (int b = 0; b < 8; ++b) acc[b] = (f32x4){0.f, 0.f, 0.f, 0.f};
        const float* wp = ada_w + (size_t)(kc * 128) * 6144 + cc * 192 + cq * 4;
        f32x4 wv[13];
#pragma unroll
        for (int i = 0; i < 13; ++i) { const int k = kr + 10 * i; wv[i] = (k < 128) ? *(const f32x4*)(wp + (size_t)k * 6144) : (f32x4){0.f, 0.f, 0.f, 0.f}; }
#pragma unroll
        for (int i = 0; i < 13; ++i) { const int k = (kr + 10 * i) & 127;
#pragma unroll
            for (int b = 0; b < 8; ++b) acc[b] += wv[i] * ca[b * 128 + k]; }
#pragma unroll
        for (int b = 0; b < 8; ++b) *(LAS f32x4*)(red + (kr * 8 + b) * 192 + cq * 4) = acc[b];
    }
    __syncthreads();
    if (tid < 384) { const int b = tid / 48, cq = tid % 48; f32x4 s = (f32x4){0.f, 0.f, 0.f, 0.f};
#pragma unroll
        for (int kr = 0; kr < 10; ++kr) s += *(const LAS f32x4*)(red + (kr * 8 + b) * 192 + cq * 4);
        if (kc == 0) s += *(const f32x4*)(ada_b + cc * 192 + cq * 4);
        *(f32x4*)(modp + (size_t)(kc * 8 + b) * 6144 + cc * 192 + cq * 4) = s; }
    __syncthreads();
}

__device__ __forceinline__ void tr_store(LAS float* scr, bf16* dst, int Kd, int k0, int rowbase, bool gu, int lane) {
    asm volatile("s_waitcnt lgkmcnt(0)" ::: "memory");
    const int c = lane & 7;
#pragma unroll
    for (int j = 0; j < 4; ++j) { const int n = (lane >> 3) + 8 * j; const LAS float* s = scr + (8 * c) * 33 + n;
        u32x4 o; o.x = pk2(s[0 * 33], s[1 * 33]); o.y = pk2(s[2 * 33], s[3 * 33]); o.z = pk2(s[4 * 33], s[5 * 33]); o.w = pk2(s[6 * 33], s[7 * 33]);
        const int row = rowbase + n + ((gu && n >= 16) ? 16 : 0);
        *(u32x4*)(dst + (size_t)row * Kd + k0 + 8 * c) = o; }
    asm volatile("s_waitcnt lgkmcnt(0)" ::: "memory");
}
struct TrItem { const float* src; bf16* dst; int ldw, Kd, k0, rowbase; bool gu; };
__device__ __forceinline__ bool tr_decode(int it, const Args& a, TrItem& t) {
    constexpr int I0 = 16 * 72, I2 = 16 * 32, I3 = 32 * 2 * 128, I4 = 32 * 128, NIT = I0 + I2 + I3 + I4;
    if (it >= NIT) return false;
    unsigned char* ws = a.ws;
    const float* w_in = (const float*)a.in[6]; const float* w_out = (const float*)a.in[11];
    const float* w_gate = (const float*)a.in[17]; const float* w_up = (const float*)a.in[18]; const float* w_down = (const float*)a.in[19];
    bf16* win = (bf16*)(ws + WS_WIN); bf16* wout = (bf16*)(ws + WS_WOUT); bf16* wgu = (bf16*)(ws + WS_WGU); bf16* wd = (bf16*)(ws + WS_WD);
    int r = it;
    if (r < I0) { const int kb = r / 72, nb = r % 72, n0 = nb * 32, k0 = kb * 64; const int sc = n0 + (n0 >= 1536 ? 16 : 0);
        t.src = w_in + (size_t)k0 * INW + sc; t.ldw = INW; t.dst = win; t.Kd = D; t.k0 = k0; t.rowbase = n0; t.gu = false; return true; }
    r -= I0;
    if (r < I2) { const int kb = r / 32, nb = r % 32, n0 = nb * 32, k0 = kb * 64;
        t.src = w_out + (size_t)k0 * D + n0; t.ldw = D; t.dst = wout; t.Kd = D; t.k0 = k0; t.rowbase = n0; t.gu = false; return true; }
    r -= I2;
    if (r < I3) { const int e = r >> 8, ty = (r >> 7) & 1, q = r & 127, kb = q >> 3, nb = q & 7, n0 = nb * 32, k0 = kb * 64;
        t.src = (ty ? w_up : w_gate) + (size_t)e * D * 256 + (size_t)k0 * 256 + n0; t.ldw = 256; t.dst = wgu + (size_t)e * 512 * D; t.Kd = D; t.k0 = k0; t.rowbase = 2 * n0 + 16 * ty; t.gu = true; return true; }
    r -= I3;
    { const int e = r >> 7, q = r & 127, kb = q >> 5, nb = q & 31, n0 = nb * 32, k0 = kb * 64;
        t.src = w_down + (size_t)e * 256 * D + (size_t)k0 * D + n0; t.ldw = D; t.dst = wd + (size_t)e * D * 256; t.Kd = 256; t.k0 = k0; t.rowbase = n0; t.gu = false; return true; }
}
__device__ __forceinline__ void tr_load(const TrItem& t, f32x4 (&v)[8], int lane) {
#pragma unroll
    for (int i = 0; i < 8; ++i) v[i] = *(const f32x4*)(t.src + (size_t)(8 * i + (lane >> 3)) * t.ldw + 4 * (lane & 7));
}
__device__ __forceinline__ void tr_finish(const TrItem& t, const f32x4 (&v)[8], LAS float* scr, int lane) {
#pragma unroll
    for (int i = 0; i < 8; ++i) { LAS float* s = scr + (8 * i + (lane >> 3)) * 33 + 4 * (lane & 7); s[0] = v[i].x; s[1] = v[i].y; s[2] = v[i].z; s[3] = v[i].w; }
    tr_store(scr, t.dst, t.Kd, t.k0, t.rowbase, t.gu, lane);
}
__device__ __forceinline__ void tr_stream(LAS unsigned char* scrbase, const Args& a, int first, int last, int gw, int NGW, int wave, int lane) {
    LAS float* scr = (LAS float*)(scrbase + wave * 8704);
    TrItem cur, nxt; f32x4 va[8], vb[8];
    int it = first + gw;
    bool have = it < last && tr_decode(it, a, cur);
    if (have) tr_load(cur, va, lane);
    while (have) {
        const bool hn = (it + NGW) < last && tr_decode(it + NGW, a, nxt);
        if (hn) tr_load(nxt, vb, lane);
        tr_finish(cur, va, scr, lane);
        if (!hn) break;
        const bool hn2 = (it + 2 * NGW) < last && tr_decode(it + 2 * NGW, a, cur);
        if (hn2) tr_load(cur, va, lane);
        tr_finish(nxt, vb, scr, lane);
        it += 2 * NGW; have = hn2;
    }
}
__device__ __forceinline__ void p0_weights(LAS unsigned char* lds, const Args& a, int blk, int wave, int lane, int tid) {
    unsigned char* ws = a.ws;
    const float* w_in = (const float*)a.in[6]; const float* w_a2 = (const float*)a.in[7]; const float* b_a2 = (const float*)a.in[8];
    bf16* win = (bf16*)(ws + WS_WIN);
    if (tid < 64 && blk < 192) {
        const float* w_grp = (const float*)a.in[13]; const float* w_exp = (const float*)a.in[15]; bf16* wrb = (bf16*)(ws + WS_WRB);
        const int e = blk * 64 + tid, ln = e & 63, hl = (e >> 6) & 1; const bool ex = e < 8192;
        const int k0 = ex ? 128 * (e >> 10) + 16 * ((e >> 7) & 7) + 8 * (ln >> 5) : 128 * ((e - 8192) >> 9) + 32 * ((e >> 7) & 3) + 8 * (ln >> 4);
        const int col = ex ? (ln & 31) : (ln & 15);
        unsigned o[4];
#pragma unroll
        for (int j2 = 0; j2 < 4; ++j2) { unsigned pr[2];
#pragma unroll
            for (int u = 0; u < 2; ++u) { const int k = k0 + 2 * j2 + u; const float wv = ex ? w_exp[k * 32 + col] : (col < 4 ? w_grp[k * 4 + col] : 0.f);
                const unsigned hi = f2bf(wv); const float hf = __uint_as_float(hi << 16); pr[u] = hl ? f2bf(wv - hf) : hi; }
            o[j2] = pr[0] | (pr[1] << 16); }
        *(u32x4*)(wrb + (size_t)e * 8) = (u32x4){o[0], o[1], o[2], o[3]};
    }
    {
        float wa[16];
#pragma unroll
        for (int q = 0; q < 16; ++q) wa[q] = w_a2[q * 256 + blk];
        float s2[2];
#pragma unroll
        for (int u = 0; u < 2; ++u) { const float* wr = w_in + (size_t)(2 * tid + u) * INW + 1536; float s = 0.f;
#pragma unroll
            for (int q4 = 0; q4 < 4; ++q4) { const f32x4 w = *(const f32x4*)(wr + 4 * q4); s = fmaf(w.x, wa[4 * q4], s); s = fmaf(w.y, wa[4 * q4 + 1], s); s = fmaf(w.z, wa[4 * q4 + 2], s); s = fmaf(w.w, wa[4 * q4 + 3], s); }
            s2[u] = s; }
        *(unsigned*)(win + (size_t)(C_Z + blk) * D + 2 * tid) = pk2(s2[0], s2[1]);
    }
}

__device__ __forceinline__ void p1a_rows(LAS unsigned char* lds, const Args& a, int blk, int wave, int lane, int tid) {
    const float* x = (const float*)a.in[0]; const float* g = (const float*)a.in[5];
    const float* modp = (const float*)(a.ws + WS_MODP); float* mod = (float*)(a.ws + WS_MOD); bf16* h = (bf16*)(a.ws + WS_H);
    const int* pos = (const int*)a.in[2]; float* rtab = (float*)(a.ws + WS_ROPE);
    LAS float* ssh = (LAS float*)lds;
    const int b = blk >> 5;
    f32x4 n0[4], n1[4];
    const size_t mb = (size_t)blk * 64 + wave;
#pragma unroll
    for (int j = 0; j < 4; ++j) { n0[j] = *(const f32x4*)(x + mb * D + 4 * lane + 256 * j); n1[j] = *(const f32x4*)(x + (mb + NWAVES) * D + 4 * lane + 256 * j); }
    {
        float pv[4][8];
#pragma unroll
        for (int q = 0; q < 4; ++q)
#pragma unroll
            for (int kc = 0; kc < 8; ++kc) pv[q][kc] = modp[(size_t)(kc * 8 + b) * 6144 + tid + NTHR * q];
#pragma unroll
        for (int q = 0; q < 4; ++q) { const int i = tid + NTHR * q; float s = 0.f;
#pragma unroll
            for (int kc = 0; kc < 8; ++kc) s += pv[q][kc];
            ssh[i] = i < 1024 ? s : (1.f + s) * g[i - 1024]; }
    }
    if (tid < 192) { const int idx = blk * 192 + tid, bb = idx / 6144, col = idx % 6144; float s = 0.f;
#pragma unroll
        for (int kc = 0; kc < 8; ++kc) s += modp[(size_t)(kc * 8 + bb) * 6144 + col];
        mod[idx] = s; }
    { const int m = blk * 64 + (tid >> 3), j = tid & 7; float sn, cs; sincosf((float)pos[m] * a.rt.inv_freq[j], &sn, &cs); rtab[m * 16 + j] = cs; rtab[m * 16 + 8 + j] = sn; }
    __syncthreads();
    for (int r = wave; r < 64; r += NWAVES) {
        const size_t m = (size_t)blk * 64 + r;
        f32x4 v[4]; float ss = 0.f;
#pragma unroll
        for (int j = 0; j < 4; ++j) { v[j] = n0[j]; n0[j] = n1[j]; }
        if (r + 2 * NWAVES < 64) {
#pragma unroll
            for (int j = 0; j < 4; ++j) n1[j] = *(const f32x4*)(x + (m + 2 * NWAVES) * D + 4 * lane + 256 * j);
        }
#pragma unroll
        for (int j = 0; j < 4; ++j) ss += (v[j].x * v[j].x + v[j].y * v[j].y) + (v[j].z * v[j].z + v[j].w * v[j].w);
        const float rinv = rsqrtf(wave_sum(ss) * (1.f / D) + EPS);
#pragma unroll
        for (int j = 0; j < 4; ++j) { const int col = 4 * lane + 256 * j; const f32x4 sh = *(const LAS f32x4*)(ssh + col), gs = *(const LAS f32x4*)(ssh + 1024 + col);
            const f32x4 hv = v[j] * rinv * gs + sh; u32x2 o; o.x = pk2(hv.x, hv.y); o.y = pk2(hv.z, hv.w);
            *(u32x2*)(h + m * D + col) = o; }
    }
    __syncthreads();
}

__device__ __forceinline__ void p3b_route(LAS unsigned char* lds, const Args& a, int blk, int wave, int lane, int tid) {
    const bf16* x1 = (const bf16*)(a.ws + WS_X1); const float* g = (const float*)a.in[12];
    const float* b_grp = (const float*)a.in[14]; const float* b_exp = (const float*)a.in[16];
    const float* mod = (const float*)(a.ws + WS_MOD); bf16* h2 = (bf16*)(a.ws + WS_H); const bf16* wrb = (const bf16*)(a.ws + WS_WRB);
    int* cnt = (int*)(a.ws + WS_CTL) + CW_CNT; int* list = (int*)(a.ws + WS_ROUTE); float* lw = (float*)(a.ws + WS_ROUTE + 2 * MiB);
    LAS unsigned char* Ahi = lds; LAS unsigned char* Alo = lds + 65536;
    LAS float* red = (LAS float*)lds;
    LAS float* lgt = (LAS float*)(lds + 65536);
    LAS float* ssh = (LAS float*)(lds + 131072);
    LAS int* rsel = (LAS int*)(lds + 139264); LAS int* rslot = rsel + 128; LAS float* rwt = (LAS float*)(rslot + 128); LAS int* lcnt = (LAS int*)(rwt + 128); LAS int* lbase = lcnt + 32;
    LAS float* biasL = (LAS float*)(lbase + 32);
    const int b = blk >> 5, l31 = lane & 31, hh = lane >> 5;
    bf16x8 bh[8], bl[8], gh[4], gl[4];
#pragma unroll
    for (int s = 0; s < 8; ++s) { const size_t e = (size_t)(((wave * 8 + s) * 2) * 64 + lane) * 8; bh[s] = *(const bf16x8*)(wrb + e); bl[s] = *(const bf16x8*)(wrb + e + 512); }
#pragma unroll
    for (int s = 0; s < 4; ++s) { const size_t e = (size_t)(8192 + ((wave * 4 + s) * 2) * 64 + lane) * 8; gh[s] = *(const bf16x8*)(wrb + e); gl[s] = *(const bf16x8*)(wrb + e + 512); }
    u32x2 nx[4][4];
#pragma unroll
    for (int rr = 0; rr < 4; ++rr)
#pragma unroll
        for (int j = 0; j < 4; ++j) nx[rr][j] = *(const u32x2*)(x1 + ((size_t)blk * 64 + wave * 4 + rr) * D + 4 * lane + 256 * j);
    {
        float mv[4], gv[4];
#pragma unroll
        for (int q = 0; q < 4; ++q) { const int i = tid + NTHR * q; mv[q] = mod[b * 6144 + 3 * D + i]; gv[q] = i < 1024 ? 0.f : g[i - 1024]; }
#pragma unroll
        for (int q = 0; q < 4; ++q) { const int i = tid + NTHR * q; ssh[i] = i < 1024 ? mv[q] : (1.f + mv[q]) * gv[q]; }
    }
    if (tid < 32) lcnt[tid] = 0;
    if (tid >= 64 && tid < 100) biasL[tid - 64] = (tid < 96) ? b_exp[tid - 64] : b_grp[tid - 96];
    __syncthreads();
#pragma unroll 1
    for (int pass = 0; pass < 2; ++pass) {
#pragma unroll
        for (int rr = 0; rr < 4; ++rr) {
            const int rl = wave * 4 + rr; const int m = blk * 64 + pass * 32 + rl;
            f32x4 v[4]; float ss = 0.f;
#pragma unroll
            for (int j = 0; j < 4; ++j) { v[j].x = lo_bf16(nx[rr][j].x); v[j].y = hi_bf16(nx[rr][j].x); v[j].z = lo_bf16(nx[rr][j].y); v[j].w = hi_bf16(nx[rr][j].y); }
            if (pass == 0) {
#pragma unroll
              for (int j = 0; j < 4; ++j) nx[rr][j] = *(const u32x2*)(x1 + (size_t)(m + 32) * D + 4 * lane + 256 * j); }
#pragma unroll
            for (int j = 0; j < 4; ++j) ss += (v[j].x * v[j].x + v[j].y * v[j].y) + (v[j].z * v[j].z + v[j].w * v[j].w);
            const float rinv = rsqrtf(wave_sum(ss) * (1.f / D) + EPS);
#pragma unroll
            for (int j = 0; j < 4; ++j) { const int col = 4 * lane + 256 * j; const f32x4 sh = *(const LAS f32x4*)(ssh + col), sc = *(const LAS f32x4*)(ssh + 1024 + col);
                v[j] = v[j] * rinv * sc + sh;
                u32x2 hi; hi.x = pk2(v[j].x, v[j].y); hi.y = pk2(v[j].z, v[j].w);
                *(u32x2*)(h2 + (size_t)m * D + col) = hi;
                u32x2 lo; lo.x = pk2(v[j].x - lo_bf16(hi.x), v[j].y - hi_bf16(hi.x)); lo.y = pk2(v[j].z - lo_bf16(hi.y), v[j].w - hi_bf16(hi.y));
                const int c = (lane >> 1) + 32 * j; const int off = rl * 2048 + ((c ^ (rl & 15)) * 16) + 8 * (lane & 1);
                *(LAS u32x2*)(Ahi + off) = hi; *(LAS u32x2*)(Alo + off) = lo; }
        }
        __syncthreads();
        f32x16 acc0; f32x4 accg[2];
#pragma unroll
        for (int r = 0; r < 16; ++r) acc0[r] = 0.f;
        accg[0] = (f32x4){0.f, 0.f, 0.f, 0.f}; accg[1] = (f32x4){0.f, 0.f, 0.f, 0.f};
#pragma unroll
        for (int s = 0; s < 8; ++s) { const int c = 2 * (wave * 8 + s) + hh; const int off = l31 * 2048 + ((c ^ (l31 & 15)) * 16);
            const bf16x8 ah = *(const LAS bf16x8*)(Ahi + off), al = *(const LAS bf16x8*)(Alo + off);
            acc0 = __builtin_amdgcn_mfma_f32_32x32x16_bf16(ah, bh[s], acc0, 0, 0, 0); acc0 = __builtin_amdgcn_mfma_f32_32x32x16_bf16(ah, bl[s], acc0, 0, 0, 0); acc0 = __builtin_amdgcn_mfma_f32_32x32x16_bf16(al, bh[s], acc0, 0, 0, 0); }
#pragma unroll
        for (int s = 0; s < 4; ++s)
#pragma unroll
            for (int mt = 0; mt < 2; ++mt) { const int row = 16 * mt + (lane & 15), c = 16 * wave + 4 * s + (lane >> 4); const int off = row * 2048 + ((c ^ (row & 15)) * 16);
                const bf16x8 ah = *(const LAS bf16x8*)(Ahi + off), al = *(const LAS bf16x8*)(Alo + off);
                accg[mt] = __builtin_amdgcn_mfma_f32_16x16x32_bf16(ah, gh[s], accg[mt], 0, 0, 0); accg[mt] = __builtin_amdgcn_mfma_f32_16x16x32_bf16(ah, gl[s], accg[mt], 0, 0, 0); accg[mt] = __builtin_amdgcn_mfma_f32_16x16x32_bf16(al, gh[s], accg[mt], 0, 0, 0); }
        __syncthreads();
#pragma unroll
        for (int r = 0; r < 16; ++r) { const int row = (r & 3) + 8 * (r >> 2) + 4 * hh; red[(wave * 32 + row) * 36 + l31] = acc0[r]; }
        if ((lane & 15) < 4) {
#pragma unroll
            for (int mt = 0; mt < 2; ++mt)
#pragma unroll
                for (int r = 0; r < 4; ++r) red[(wave * 32 + 16 * mt + 4 * (lane >> 4) + r) * 36 + 32 + (lane & 15)] = accg[mt][r];
        }
        __syncthreads();
#pragma unroll
        for (int q = 0; q < 3; ++q) { const int p = tid + NTHR * q;
            if (p < 32 * 36) { float s = 0.f;
#pragma unroll
                for (int w = 0; w < 8; ++w) s += red[w * (32 * 36) + p];
                lgt[p] = s + biasL[p % 36]; } }
        __syncthreads();
        if (tid < 32) {
            const int row = tid;
            float lg[4];
#pragma unroll
            for (int o = 0; o < 4; ++o) lg[o] = lgt[row * 36 + 32 + o];
            int gi = 0; float gm = lg[0];
#pragma unroll
            for (int o = 1; o < 4; ++o) if (lg[o] > gm) { gm = lg[o]; gi = o; }
            float den = 0.f;
#pragma unroll
            for (int o = 0; o < 4; ++o) den += __expf(lg[o] - gm);
            const float gate = 1.f / den;
            float sl[8];
#pragma unroll
            for (int i = 0; i < 8; ++i) sl[i] = lgt[row * 36 + gi * 8 + i];
            int i1 = 0; float v1 = sl[0];
#pragma unroll
            for (int i = 1; i < 8; ++i) if (sl[i] > v1) { v1 = sl[i]; i1 = i; }
            int i2 = 0; float v2 = -INFINITY;
#pragma unroll
            for (int i = 0; i < 8; ++i) if (i != i1 && sl[i] > v2) { v2 = sl[i]; i2 = i; }
            const float e2 = __expf(v2 - v1), w1 = gate / (1.f + e2), w2 = gate * e2 / (1.f + e2);
            const int ea = gi * 8 + i1, eb = gi * 8 + i2, r2 = 2 * (pass * 32 + row);
            rsel[r2] = ea; rslot[r2] = atomicAdd((int*)(lcnt + ea), 1); rwt[r2] = w1;
            rsel[r2 + 1] = eb; rslot[r2 + 1] = atomicAdd((int*)(lcnt + eb), 1); rwt[r2 + 1] = w2;
        }
        __syncthreads();
    }
    if (tid < 32) { const int c = lcnt[tid]; lbase[tid] = c ? atomicAdd(&cnt[tid * CNT_STRIDE], c) : 0; }
    __syncthreads();
    if (tid < 128) { const int e = rsel[tid], slot = lbase[e] + rslot[tid]; list[e * LCAP + slot] = (blk * 64 + (tid >> 1)) * 2 + (tid & 1); lw[e * LCAP + slot] = rwt[tid]; }
    __syncthreads();
}

__device__ __forceinline__ void moe_prefix(LAS int* tp, const int* cnt, int tid) {
    if (tid < 64) {
        const int craw = __hip_atomic_load(cnt + (tid & 31) * CNT_STRIDE, __ATOMIC_RELAXED, __HIP_MEMORY_SCOPE_AGENT);
        if (tid < NEXP) tp[208 + tid] = craw;
        const int c = tid < NEXP ? ((craw + 255) >> 8) : 0;
        int s = c;
#pragma unroll
        for (int o = 1; o < 32; o <<= 1) { const int t = __shfl_up(s, o); if ((tid & 63) >= o) s += t; }
        if (tid < NEXP) { tp[tid] = s - c; for (int t = s - c; t < s; ++t) tp[40 + t] = tid; }
        if (tid == NEXP - 1) tp[NEXP] = s;
    }
    __syncthreads();
}

__device__ __forceinline__ void p6_final(LAS unsigned char* lds, const Args& a, int blk, int wave, int lane, int tid) {
    float* out = a.out; const bf16* x1 = (const bf16*)(a.ws + WS_X1); const float* fg = (const float*)a.in[20]; const float* mod = (const float*)(a.ws + WS_MOD); const bf16* y2 = (const bf16*)(a.ws + WS_Y2);
    LAS float* gt = (LAS float*)lds;
    const int b = blk >> 5;
    for (int i = tid; i < 1024; i += NTHR) gt[i] = mod[b * 6144 + 5 * D + i];
    __syncthreads();
    f32x4 gg[4];
#pragma unroll
    for (int j = 0; j < 4; ++j) gg[j] = *(const f32x4*)(fg + 4 * lane + 256 * j);
    u32x2 nx[4]; u32x2 nya[4], nyb[4];
    {
        const size_t m = (size_t)blk * 64 + wave;
#pragma unroll
        for (int j = 0; j < 4; ++j) { const int col = 4 * lane + 256 * j; nx[j] = *(const u32x2*)(x1 + m * D + col); nya[j] = *(const u32x2*)(y2 + (m * 2) * D + col); nyb[j] = *(const u32x2*)(y2 + (m * 2 + 1) * D + col); }
    }
    for (int r = wave; r < 64; r += NWAVES) {
        const size_t m = (size_t)blk * 64 + r;
        f32x4 v[4]; u32x2 ya4[4], yb4[4]; float ss = 0.f;
#pragma unroll
        for (int j = 0; j < 4; ++j) { v[j].x = lo_bf16(nx[j].x); v[j].y = hi_bf16(nx[j].x); v[j].z = lo_bf16(nx[j].y); v[j].w = hi_bf16(nx[j].y); ya4[j] = nya[j]; yb4[j] = nyb[j]; }
        if (r + NWAVES < 64) {
            const size_t mn = m + NWAVES;
#pragma unroll
            for (int j = 0; j < 4; ++j) { const int col = 4 * lane + 256 * j; nx[j] = *(const u32x2*)(x1 + mn * D + col); nya[j] = *(const u32x2*)(y2 + (mn * 2) * D + col); nyb[j] = *(const u32x2*)(y2 + (mn * 2 + 1) * D + col); }
        }
#pragma unroll
        for (int j = 0; j < 4; ++j) { const int col = 4 * lane + 256 * j; const u32x2 ya = ya4[j], yb = yb4[j];
            f32x4 y; y.x = __uint_as_float(ya.x << 16) + __uint_as_float(yb.x << 16); y.y = __uint_as_float(ya.x & 0xffff0000u) + __uint_as_float(yb.x & 0xffff0000u);
            y.z = __uint_as_float(ya.y << 16) + __uint_as_float(yb.y << 16); y.w = __uint_as_float(ya.y & 0xffff0000u) + __uint_as_float(yb.y & 0xffff0000u);
            v[j] += *(const LAS f32x4*)(gt + col) * y; ss += (v[j].x * v[j].x + v[j].y * v[j].y) + (v[j].z * v[j].z + v[j].w * v[j].w); }
        const float rinv = rsqrtf(wave_sum(ss) * (1.f / D) + EPS);
#pragma unroll
        for (int j = 0; j < 4; ++j) *(f32x4*)(out + m * D + 4 * lane + 256 * j) = v[j] * rinv * gg[j];
    }
    __syncthreads();
}
typedef short v4i16_t __attribute__((ext_vector_type(4)));
constexpr float LOG2E = 1.4426950408889634f;
__device__ __forceinline__ f32x16 mfma32(bf16x8 a, bf16x8 b, f32x16 c) { return __builtin_amdgcn_mfma_f32_32x32x16_bf16(a, b, c, 0, 0, 0); }
__device__ __forceinline__ v4i16_t tr_read(LAS unsigned char* p) { return __builtin_amdgcn_ds_read_tr16_b64_v4i16((LAS v4i16_t*)p); }
__device__ __forceinline__ bf16x8 cat8(v4i16_t a, v4i16_t b) { return (bf16x8){a[0], a[1], a[2], a[3], b[0], b[1], b[2], b[3]}; }
__device__ __forceinline__ unsigned cvtpk(float lo, float hi) { const f32x2_t v = {lo, hi}; const bf16x2_t b = __builtin_convertvector(v, bf16x2_t); return __builtin_bit_cast(unsigned, b); }
__device__ __forceinline__ bf16x8 pack8(const f32x16& v, int s) {
    u32x4 w; w.x = cvtpk(v[8 * s + 0], v[8 * s + 1]); w.y = cvtpk(v[8 * s + 2], v[8 * s + 3]); w.z = cvtpk(v[8 * s + 4], v[8 * s + 5]); w.w = cvtpk(v[8 * s + 6], v[8 * s + 7]);
    return __builtin_bit_cast(bf16x8, w);
}
__device__ __forceinline__ unsigned xor32_u(unsigned x) { const auto r = __builtin_amdgcn_permlane32_swap(x, x, false, false); return (threadIdx.x & 32) ? r[0] : r[1]; }
__device__ __forceinline__ float sum32(float x) { const auto r = __builtin_amdgcn_permlane32_swap(__float_as_uint(x), __float_as_uint(x), false, false); return __uint_as_float(r[0]) + __uint_as_float(r[1]); }
__device__ __forceinline__ float max32(float x) { const auto r = __builtin_amdgcn_permlane32_swap(__float_as_uint(x), __float_as_uint(x), false, false); return fmaxf(__uint_as_float(r[0]), __uint_as_float(r[1])); }
__device__ __forceinline__ float lo_bf(unsigned w) { return __uint_as_float(w << 16); }
__device__ __forceinline__ float hi_bf(unsigned w) { return __uint_as_float(w & 0xffff0000u); }
__device__ __forceinline__ int off256(int row, int ch) { return 256 * row + 16 * (ch ^ (((row & 3) << 2) | ((row >> 2) & 3))); }
__device__ __forceinline__ int off128(int row, int c) { return 128 * row + 16 * (c ^ ((row >> 1) & 7)); }

__device__ __forceinline__ void swa_unit(LAS unsigned char* lds, const bf16* proj, const float* rtab, const float* sinks, bf16* o, int unit, int tid, int lane, int wave) {
    const int b = unit >> 5, kh = (unit >> 4) & 1, qb = unit & 15;
    LAS unsigned char* Ks = lds; LAS unsigned char* Vs = lds + 32768;
    const int g = wave >> 1, qhf = wave & 1, qh = kh * 4 + g;
    const int l31 = lane & 31, h = lane >> 5, i16 = lane & 15, g16 = (lane >> 4) & 1, tq = i16 >> 2, tp = i16 & 3;
    bf16x8 qfa[2][4]; f32x4 qrt[2][4];
#pragma unroll
    for (int qs = 0; qs < 2; ++qs) { const size_t m = (size_t)b * SEQ + qb * 128 + 64 * qhf + 32 * qs + l31; const bf16* qp = proj + m * PW + C_SQ + qh * 64 + 8 * h;
#pragma unroll
        for (int s = 0; s < 4; ++s) qfa[qs][s] = *(const bf16x8*)(qp + 16 * s);
#pragma unroll
        for (int s = 0; s < 4; ++s) qrt[qs][s] = *(const f32x4*)(rtab + m * 16 + 4 * s); }
    {
        const int key = tid >> 1, half = tid & 1;
        const int jpos = (qb - 1) * 128 + key; const bool valid = jpos >= 0;
        const size_t m = (size_t)b * SEQ + (valid ? jpos : 0);
        const bf16* kp = proj + m * PW + C_SK + kh * 64 + half * 32; const bf16* vp = proj + m * PW + C_SV + kh * 64 + half * 32;
        u32x4 kc[4], vc[4];
#pragma unroll
        for (int c = 0; c < 4; ++c) { kc[c] = *(const u32x4*)(kp + 8 * c); vc[c] = *(const u32x4*)(vp + 8 * c); }
        if (half == 0) {
            const f32x4 c0 = *(const f32x4*)(rtab + m * 16), c1 = *(const f32x4*)(rtab + m * 16 + 4), s0 = *(const f32x4*)(rtab + m * 16 + 8), s1 = *(const f32x4*)(rtab + m * 16 + 12);
            const float cs[8] = {c0.x, c0.y, c0.z, c0.w, c1.x, c1.y, c1.z, c1.w}, sn[8] = {s0.x, s0.y, s0.z, s0.w, s1.x, s1.y, s1.z, s1.w};
#pragma unroll
            for (int w = 0; w < 4; ++w) {
                const float a0 = lo_bf(kc[0][w]), a1 = hi_bf(kc[0][w]), b0 = lo_bf(kc[1][w]), b1 = hi_bf(kc[1][w]);
                kc[0][w] = cvtpk(a0 * cs[2 * w] - b0 * sn[2 * w], a1 * cs[2 * w + 1] - b1 * sn[2 * w + 1]);
                kc[1][w] = cvtpk(b0 * cs[2 * w] + a0 * sn[2 * w], b1 * cs[2 * w + 1] + a1 * sn[2 * w + 1]);
            }
        }
        if (!valid) {
#pragma unroll
            for (int c = 0; c < 4; ++c) { kc[c] = (u32x4){0u, 0u, 0u, 0u}; vc[c] = (u32x4){0u, 0u, 0u, 0u}; }
        }
        const int vsw = (key >> 1) & 1;
#pragma unroll
        for (int c = 0; c < 4; ++c) { const int cc = 4 * half + c;
            *(LAS u32x4*)(Ks + off128(key, cc)) = kc[c];
            *(LAS u32x4*)(Vs + key * 128 + (((cc >> 2) ^ vsw) * 64) + (cc & 3) * 16) = vc[c]; }
    }
#pragma unroll
    for (int qs = 0; qs < 2; ++qs) {
        const f32x4 c0 = qrt[qs][0], c1 = qrt[qs][1], s0 = qrt[qs][2], s1 = qrt[qs][3];
        const float cs[8] = {c0.x, c0.y, c0.z, c0.w, c1.x, c1.y, c1.z, c1.w}, sn[8] = {s0.x, s0.y, s0.z, s0.w, s1.x, s1.y, s1.z, s1.w};
        u32x4 own = __builtin_bit_cast(u32x4, qfa[qs][0]), res;
#pragma unroll
        for (int w = 0; w < 4; ++w) { const unsigned pw = xor32_u(own[w]);
            const float o0 = lo_bf(own[w]), o1 = hi_bf(own[w]), p0 = lo_bf(pw), p1 = hi_bf(pw);
            const float sg = h ? 1.f : -1.f;
            res[w] = cvtpk(o0 * cs[2 * w] + sg * p0 * sn[2 * w], o1 * cs[2 * w + 1] + sg * p1 * sn[2 * w + 1]); }
        qfa[qs][0] = __builtin_bit_cast(bf16x8, res);
    }
    __syncthreads();
    const float sink2 = sinks[qh] * LOG2E, sc = 0.125f * LOG2E;
    const int vbase = (4 * h + tq) * 128 + 32 * g16 + 8 * tp;
#pragma unroll 1
    for (int qs = 0; qs < 2; ++qs) {
        const int q0 = 64 * qhf + 32 * qs;
        const size_t m = (size_t)b * SEQ + qb * 128 + q0 + l31;
        bf16x8 qf[4];
#pragma unroll
        for (int s = 0; s < 4; ++s) qf[s] = qs ? qfa[1][s] : qfa[0][s];
        const int kt0 = q0 >> 5;
        f32x16 st[5];
#pragma unroll
        for (int i = 0; i < 5; ++i) {
            f32x16 acc;
#pragma unroll
            for (int r = 0; r < 16; ++r) acc[r] = 0.f;
            const int row = 32 * (kt0 + i) + l31;
#pragma unroll
            for (int s = 0; s < 4; ++s) { const bf16x8 kf = *(const LAS bf16x8*)(Ks + off128(row, 2 * s + h)); acc = mfma32(kf, qf[s], acc); }
            st[i] = acc;
        }
        float mx = sink2;
#pragma unroll
        for (int i = 0; i < 5; ++i)
#pragma unroll
            for (int r = 0; r < 16; ++r) { const int krow = (r & 3) + 8 * (r >> 2) + 4 * h; const int dj = 32 * i + krow - l31;
                bool ok = (dj > 0) && (dj <= 128); if (qb == 0) ok = ok && (q0 + 32 * i + krow >= 128);
                const float x = ok ? st[i][r] * sc : -1e30f; st[i][r] = x; mx = fmaxf(mx, x); }
        mx = max32(mx);
        float l = 0.f;
#pragma unroll
        for (int i = 0; i < 5; ++i)
#pragma unroll
            for (int r = 0; r < 16; ++r) { const float p = __builtin_amdgcn_exp2f(st[i][r] - mx); st[i][r] = p; l += p; }
        l = sum32(l); l += __builtin_amdgcn_exp2f(sink2 - mx);
        f32x16 ot[2];
#pragma unroll
        for (int r = 0; r < 16; ++r) { ot[0][r] = 0.f; ot[1][r] = 0.f; }
#pragma unroll
        for (int i = 0; i < 5; ++i)
#pragma unroll
            for (int s2 = 0; s2 < 2; ++s2) { const bf16x8 pf = pack8(st[i], s2);
                LAS unsigned char* vb = Vs + (32 * (kt0 + i) + 16 * s2) * 128 + vbase;
#pragma unroll
                for (int dt = 0; dt < 2; ++dt) { const int xo = (dt ^ (tq >> 1)) * 64;
                    const bf16x8 vf = cat8(tr_read(vb + xo), tr_read(vb + 8 * 128 + xo));
                    ot[dt] = mfma32(vf, pf, ot[dt]); } }
        const float inv = __builtin_amdgcn_rcpf(l);
        bf16* op = o + m * D + 512 + qh * 64 + 4 * h;
#pragma unroll
        for (int dt = 0; dt < 2; ++dt)
#pragma unroll
            for (int gq = 0; gq < 4; ++gq) { u32x2 w; w.x = cvtpk(ot[dt][4 * gq] * inv, ot[dt][4 * gq + 1] * inv); w.y = cvtpk(ot[dt][4 * gq + 2] * inv, ot[dt][4 * gq + 3] * inv);
                *(u32x2*)(op + dt * 32 + 8 * gq) = w; }
    }
    __syncthreads();
}

constexpr int GLA_CH = 32768, GLA_QD = 16384, GLA_KD = 24576, GLA_K2T = 131072  , GLA_SEG = 147456  , GLA_DECL = 151552  , GLA_DECP = 152064, GLA_S = 131072, GLA_SSQ = 153088;
__device__ __forceinline__ float logsig16(float z) { return (fminf(z, 0.f) - __logf(1.f + __expf(-fabsf(z)))) * (1.f / 16.f); }
struct GlaRaw { bf16 la[2][8], qv[2][8], kv[2][8]; u32x4 v[2][2]; };
__device__ __forceinline__ void gla_kv_load(GlaRaw& r, const bf16* proj, int bh, int g, int jp, int tid) {
    const int b = bh >> 2, hd = bh & 3, d = tid & 63, seg = tid >> 6;
#pragma unroll
    for (int c2 = 0; c2 < 2; ++c2) { const size_t m0 = (size_t)b * SEQ + (4 * g + 2 * jp + c2) * 64;
#pragma unroll
        for (int i = 0; i < 8; ++i) { const size_t mr = (m0 + seg * 8 + i) * PW; r.la[c2][i] = proj[mr + C_Z + hd * 64 + d]; r.qv[c2][i] = proj[mr + C_GQ + hd * 64 + d]; r.kv[c2][i] = proj[mr + C_GK + hd * 64 + d]; }
#pragma unroll
        for (int i = 0; i < 2; ++i) { const int idx = tid + NTHR * i; r.v[c2][i] = *(const u32x4*)(proj + (m0 + (idx >> 4)) * PW + C_GV + hd * 128 + (idx & 15) * 8); } }
}
__device__ __forceinline__ void gla_kv_group(LAS unsigned char* lds, const bf16* proj, const float* b_a2, bf16* KV, bf16* KVG, float* DECG, int bh, int g, int tid, int lane, int wave, const GlaRaw& r0) {
    const int b = bh >> 2, hd = bh & 3;
    LAS float* decP = (LAS float*)(lds + GLA_DECP);
    const int et = wave >> 1, dt = wave & 1, l31 = lane & 31, hh = lane >> 5, i16 = lane & 15, g16 = (lane >> 4) & 1, tq = i16 >> 2, tp = i16 & 3;
    const int d = tid & 63, seg = tid >> 6;
    const float zb = b_a2[hd * 64 + d];
    f32x16 grp; float gdec = 1.f;
#pragma unroll
    for (int r = 0; r < 16; ++r) grp[r] = 0.f;
    GlaRaw r1; gla_kv_load(r1, proj, bh, g, 1, tid);
#pragma unroll
    for (int jp = 0; jp < 2; ++jp) {
        float la[2][8], qv[2][8], kv[2][8]; u32x4 vld[2][2];
#pragma unroll
        for (int c2 = 0; c2 < 2; ++c2) {
#pragma unroll
            for (int i = 0; i < 8; ++i) { la[c2][i] = bf2f(jp ? r1.la[c2][i] : r0.la[c2][i]); qv[c2][i] = bf2f(jp ? r1.qv[c2][i] : r0.qv[c2][i]) * 0.125f; kv[c2][i] = bf2f(jp ? r1.kv[c2][i] : r0.kv[c2][i]); }
#pragma unroll
            for (int i = 0; i < 2; ++i) vld[c2][i] = jp ? r1.v[c2][i] : r0.v[c2][i]; }
#pragma unroll
        for (int c2 = 0; c2 < 2; ++c2) { LAS float* segtot = (LAS float*)(lds + GLA_SEG + 2048 * c2);
#pragma unroll
            for (int i = 0; i < 8; ++i) la[c2][i] = logsig16(la[c2][i] + zb);
#pragma unroll
            for (int i = 1; i < 8; ++i) la[c2][i] += la[c2][i - 1];
            segtot[seg * 64 + d] = la[c2][7]; }
        __syncthreads();
#pragma unroll
        for (int c2 = 0; c2 < 2; ++c2) { const int jn = 2 * jp + c2;
            LAS unsigned char* vS = lds + GLA_CH * jn; LAS unsigned char* qdS = vS + GLA_QD; LAS unsigned char* kdS = vS + GLA_KD;
            LAS unsigned char* k2T = lds + GLA_K2T + 8192 * c2; LAS float* segtot = (LAS float*)(lds + GLA_SEG + 2048 * c2); LAS float* decL = (LAS float*)(lds + GLA_DECL + 256 * c2);
            float pre = 0.f, tot = 0.f;
#pragma unroll
            for (int s = 0; s < 8; ++s) { const float v = segtot[s * 64 + d]; tot += v; pre += (s < seg) ? v : 0.f; }
            u32x4 w; float e[8]; const float etot = __expf(tot);
#pragma unroll
            for (int i = 0; i < 8; ++i) { const int t = seg * 8 + i; const float bb = pre + la[c2][i]; const float en = __expf(-bb);
                e[i] = kv[c2][i] * en * etot;
                *(LAS bf16*)(qdS + off128(t, d >> 3) + (d & 7) * 2) = (bf16)f2bf(qv[c2][i] * __expf(bb));
                *(LAS bf16*)(kdS + off128(t, d >> 3) + (d & 7) * 2) = (bf16)f2bf(kv[c2][i] * en); }
            w.x = cvtpk(e[0], e[1]); w.y = cvtpk(e[2], e[3]); w.z = cvtpk(e[4], e[5]); w.w = cvtpk(e[6], e[7]);
            *(LAS u32x4*)(k2T + off128(d, seg)) = w;
            if (seg == 0) { decL[d] = etot; decP[jn * 64 + d] = etot; }
#pragma unroll
            for (int i = 0; i < 2; ++i) { const int idx = tid + NTHR * i; *(LAS u32x4*)(vS + off256(idx >> 4, idx & 15)) = vld[c2][i]; } }
        __syncthreads();
#pragma unroll
        for (int c2 = 0; c2 < 2; ++c2) { const int jn = 2 * jp + c2; const size_t unit = (size_t)(bh * 32 + 4 * g + jn);
            LAS unsigned char* vS = lds + GLA_CH * jn; LAS unsigned char* k2T = lds + GLA_K2T + 8192 * c2; LAS float* decL = (LAS float*)(lds + GLA_DECL + 256 * c2);
            f32x16 acc;
#pragma unroll
            for (int r = 0; r < 16; ++r) acc[r] = 0.f;
#pragma unroll
            for (int kk = 0; kk < 4; ++kk) {
                const int kb = 16 * kk + 8 * hh;
                const int ch = et * 4 + 2 * g16 + (tp >> 1);
                const bf16x8 af = cat8(tr_read(vS + off256(kb + tq, ch) + 8 * (tp & 1)), tr_read(vS + off256(kb + 4 + tq, ch) + 8 * (tp & 1)));
                const bf16x8 bfr = *(const LAS bf16x8*)(k2T + off128(dt * 32 + l31, 2 * kk + hh));
                acc = mfma32(af, bfr, acc);
            }
            const float dcl = decL[dt * 32 + l31];
            __builtin_amdgcn_sched_barrier(0);
            asm volatile("s_nop 15\n\ts_nop 15" ::: "memory");
            __builtin_amdgcn_sched_barrier(0);
            if (jn < 3 || g < 7) {
                bf16* sp = KV + unit * 8192 + (dt * 32 + l31) * 128 + et * 32 + 4 * hh;
#pragma unroll
                for (int gq = 0; gq < 4; ++gq) { u32x2 w; w.x = cvtpk(acc[4 * gq], acc[4 * gq + 1]); w.y = cvtpk(acc[4 * gq + 2], acc[4 * gq + 3]); *(u32x2*)(sp + 8 * gq) = w; }
            }
#pragma unroll
            for (int r = 0; r < 16; ++r) grp[r] = dcl * grp[r] + acc[r];
            gdec *= dcl; }
        __syncthreads();
    }
    {
        bf16* sp = KVG + (size_t)(bh * 8 + g) * 8192 + (dt * 32 + l31) * 128 + et * 32 + 4 * hh;
#pragma unroll
        for (int gq = 0; gq < 4; ++gq) { u32x2 w; w.x = cvtpk(grp[4 * gq], grp[4 * gq + 1]); w.y = cvtpk(grp[4 * gq + 2], grp[4 * gq + 3]); *(u32x2*)(sp + 8 * gq) = w; }
        if (et == 0 && hh == 0) DECG[(size_t)(bh * 8 + g) * 64 + dt * 32 + l31] = gdec;
    }
}

__device__ __forceinline__ void gla_out_block(LAS unsigned char* lds, const bf16* proj, const bf16* KV, const bf16* KVG, const float* DECG, const float* gn, bf16* o, int bh, int g, int tid, int lane, int wave) {
    const int b = bh >> 2, hd = bh & 3, n0 = 4 * g;
    LAS unsigned char* sS = lds + GLA_S; LAS float* ssq = (LAS float*)(lds + GLA_SSQ); LAS float* decP = (LAS float*)(lds + GLA_DECP);
    const int et = wave >> 1, tt = wave & 1, l31 = lane & 31, hh = lane >> 5, i16 = lane & 15, g16 = (lane >> 4) & 1, tq = i16 >> 2, tp = i16 & 3;
    const int srow = tid >> 4, sch = tid & 15;
    u32x4 kvn[2]; u32x2 gate[4];
#define GLA_LOAD(JN) do { const int n_ = n0 + (JN); const size_t m0_ = (size_t)b * SEQ + n_ * 64; const size_t unit_ = (size_t)(bh * 32 + n_); \
        _Pragma("unroll") for (int i = 0; i < 2; ++i) kvn[i] = ((JN) < 3) ? *(const u32x4*)(KV + unit_ * 8192 + (srow + 32 * i) * 128 + sch * 8) : (u32x4){0u, 0u, 0u, 0u}; \
        _Pragma("unroll") for (int gq = 0; gq < 4; ++gq) gate[gq] = *(const u32x2*)(proj + (m0_ + tt * 32 + l31) * PW + C_GG + hd * 128 + et * 32 + 8 * gq + 4 * hh); } while (0)
    GLA_LOAD(0);
    f32x4 gnv[4];
#pragma unroll
    for (int gq = 0; gq < 4; ++gq) gnv[gq] = *(const f32x4*)(gn + hd * 128 + et * 32 + 4 * hh + 8 * gq);
    float sst[2][8];
#pragma unroll
    for (int i = 0; i < 2; ++i)
#pragma unroll
        for (int j = 0; j < 8; ++j) sst[i][j] = 0.f;
    {
        u32x4 kvl[7][2]; float dcl[7][2];
#pragma unroll
        for (int m = 0; m < 7; ++m)
#pragma unroll
            for (int i = 0; i < 2; ++i) { const size_t u = (size_t)(bh * 8 + m);
                kvl[m][i] = (m < g) ? *(const u32x4*)(KVG + u * 8192 + (srow + 32 * i) * 128 + sch * 8) : (u32x4){0u, 0u, 0u, 0u};
                dcl[m][i] = (m < g) ? DECG[u * 64 + srow + 32 * i] : 1.f; }
#pragma unroll
        for (int m = 0; m < 7; ++m)
#pragma unroll
            for (int i = 0; i < 2; ++i)
#pragma unroll
                for (int w = 0; w < 4; ++w) { sst[i][2 * w] = dcl[m][i] * sst[i][2 * w] + lo_bf(kvl[m][i][w]); sst[i][2 * w + 1] = dcl[m][i] * sst[i][2 * w + 1] + hi_bf(kvl[m][i][w]); }
    }
#pragma unroll 1
    for (int jn = 0; jn < 4; ++jn) {
        const int n = n0 + jn;
        const size_t mt = (size_t)b * SEQ + n * 64 + tt * 32 + l31;
        LAS unsigned char* vS = lds + GLA_CH * jn; LAS unsigned char* qdS = vS + GLA_QD; LAS unsigned char* kdS = vS + GLA_KD;
#pragma unroll
        for (int i = 0; i < 2; ++i) { u32x4 sw; sw.x = cvtpk(sst[i][0], sst[i][1]); sw.y = cvtpk(sst[i][2], sst[i][3]); sw.z = cvtpk(sst[i][4], sst[i][5]); sw.w = cvtpk(sst[i][6], sst[i][7]);
            *(LAS u32x4*)(sS + off256(srow + 32 * i, sch)) = sw; }
        __syncthreads();
        if (jn < 3) {
#pragma unroll
            for (int i = 0; i < 2; ++i) { const float dc = decP[jn * 64 + srow + 32 * i];
#pragma unroll
                for (int w = 0; w < 4; ++w) { sst[i][2 * w] = dc * sst[i][2 * w] + lo_bf(kvn[i][w]); sst[i][2 * w + 1] = dc * sst[i][2 * w + 1] + hi_bf(kvn[i][w]); } }
        }
        u32x2 gcur[4];
#pragma unroll
        for (int gq = 0; gq < 4; ++gq) gcur[gq] = gate[gq];
        if (jn < 3) GLA_LOAD(jn + 1);
        bf16x8 qf[4];
#pragma unroll
        for (int kk = 0; kk < 4; ++kk) qf[kk] = *(const LAS bf16x8*)(qdS + off128(tt * 32 + l31, 2 * kk + hh));
        f32x16 ot;
#pragma unroll
        for (int r = 0; r < 16; ++r) ot[r] = 0.f;
        const int chv = et * 4 + 2 * g16 + (tp >> 1), sub = 8 * (tp & 1);
#pragma unroll
        for (int kk = 0; kk < 4; ++kk) { const int kb = 16 * kk + 8 * hh;
            const bf16x8 af = cat8(tr_read(sS + off256(kb + tq, chv) + sub), tr_read(sS + off256(kb + 4 + tq, chv) + sub));
            ot = mfma32(af, qf[kk], ot); }
#pragma unroll
        for (int st = 0; st < 2; ++st) {
            if (st <= tt) {
                f32x16 at;
#pragma unroll
                for (int r = 0; r < 16; ++r) at[r] = 0.f;
#pragma unroll
                for (int kk = 0; kk < 4; ++kk) { const bf16x8 kf = *(const LAS bf16x8*)(kdS + off128(st * 32 + l31, 2 * kk + hh)); at = mfma32(kf, qf[kk], at); }
                if (st == tt) {
#pragma unroll
                    for (int r = 0; r < 16; ++r) { const int sr = (r & 3) + 8 * (r >> 2) + 4 * hh; at[r] = (sr <= l31) ? at[r] : 0.f; }
                }
#pragma unroll
                for (int s2 = 0; s2 < 2; ++s2) { const bf16x8 pf = pack8(at, s2); const int kb = 32 * st + 16 * s2 + 4 * hh;
                    const bf16x8 vf = cat8(tr_read(vS + off256(kb + tq, chv) + sub), tr_read(vS + off256(kb + 8 + tq, chv) + sub));
                    ot = mfma32(vf, pf, ot); }
            }
        }
        float ss = 0.f;
#pragma unroll
        for (int r = 0; r < 16; ++r) ss += ot[r] * ot[r];
        ss = sum32(ss);
        if (hh == 0) ssq[et * 64 + tt * 32 + l31] = ss;
        __syncthreads();
        const int tl = tt * 32 + l31;
        const float rinv = rsqrtf(((ssq[tl] + ssq[64 + tl]) + (ssq[128 + tl] + ssq[192 + tl])) * (1.f / 128.f) + EPS);
        bf16* op = o + mt * D + hd * 128 + et * 32 + 4 * hh;
#pragma unroll
        for (int gq = 0; gq < 4; ++gq) { const f32x4 gg = gnv[gq];
            const float g0 = lo_bf(gcur[gq].x), g1 = hi_bf(gcur[gq].x), g2 = lo_bf(gcur[gq].y), g3 = hi_bf(gcur[gq].y);
            u32x2 w; w.x = cvtpk(ot[4 * gq] * rinv * gg.x * silu_f(g0), ot[4 * gq + 1] * rinv * gg.y * silu_f(g1)); w.y = cvtpk(ot[4 * gq + 2] * rinv * gg.z * silu_f(g2), ot[4 * gq + 3] * rinv * gg.w * silu_f(g3));
            *(u32x2*)(op + 8 * gq) = w; }
        __syncthreads();
    }
#undef GLA_LOAD
}
constexpr int NPH = 10;
__global__ void __launch_bounds__(NTHR, 2) mk_fwd(Args a) {
    extern __shared__ __attribute__((aligned(16))) unsigned char lds_raw[];
    LAS unsigned char* lds = (LAS unsigned char*)lds_raw;
    volatile LAS unsigned* MISC = (volatile LAS unsigned*)(lds + MISC_OFF);
    const int tid = threadIdx.x, lane = tid & 63, wave = __builtin_amdgcn_readfirstlane(tid >> 6), blk = blockIdx.x;
    if (tid < 128) MISC[tid] = 0u;
    __syncthreads();
    unsigned char* ws = a.ws;
    unsigned* ctl = (unsigned*)(ws + WS_CTL);
    const int lo = a.ph_lo, hi = a.ph_hi;
    XcdBarrier bar = xcd_barrier_post(ctl + CW_BAR + lo * XCD_BAR_WORDS, MISC);
#define IN(k) (lo <= (k) && (k) < hi)
#define SEAM(k) do { if (IN(k) && IN((k) + 1)) xcd_barrier(bar); } while (0)
    LAS int* tp = (LAS int*)(lds + 132096);

    if (IN(0)) {
        TrItem t0; f32x4 tv[8]; const int it0 = blk * NWAVES + wave; const bool h0 = it0 < 16 * 72 + 16 * 32 && tr_decode(it0, a, t0);
        if (h0) tr_load(t0, tv, lane);
        p0_adaln(lds, (const float*)a.in[1], (const float*)a.in[3], (const float*)a.in[4], (float*)(ws + WS_MODP), blk, tid);
        p0_weights(lds, a, blk, wave, lane, tid);
        if (h0) tr_finish(t0, tv, (LAS float*)(lds + 65536 + wave * 8704), lane);
    }
    SEAM(0);
    if (IN(1)) p1a_rows(lds, a, blk, wave, lane, tid);
    SEAM(1);
    if (IN(2)) {
        pg8::DenseOrder S; S.init(ws + WS_H, ws + WS_WIN, M, PW, D, GRID, blk);
        pg8::EpiBf16 E{(bf16*)(ws + WS_PROJ), PW};
        constexpr int TG0 = 16 * 72 + 16 * 32, TG1 = TG0 + 32 * 2 * 128, TGM = TG0 + 32 * 128;
        if (blk >= 128) { tr_stream(lds, a, TG0, TGM, (blk - 128) * NWAVES + wave, 128 * NWAVES, wave, lane); __syncthreads(); }
        pg8::gemm_phase<pg8::EpiBf16, pg8::DenseOrder, true>(lds, D, S, E);
        if (blk >= 128) tr_stream(lds, a, TGM, TG1, (blk - 128) * NWAVES + wave, 128 * NWAVES, wave, lane);
    }
    SEAM(2);
    if (IN(3)) {
        const bf16* proj = (const bf16*)(ws + WS_PROJ); bf16* o = (bf16*)(ws + WS_O);
        GlaRaw r0; gla_kv_load(r0, proj, blk >> 3, blk & 7, 0, tid);
        swa_unit(lds, proj, (const float*)(ws + WS_ROPE), (const float*)a.in[10], o, blk, tid, lane, wave);
        gla_kv_group(lds, proj, (const float*)a.in[8], (bf16*)(ws + WS_SG), (bf16*)(ws + WS_KVG), (float*)(ws + WS_DECG), blk >> 3, blk & 7, tid, lane, wave, r0);
    }
    SEAM(3);
    if (IN(4)) {
        const bf16* proj = (const bf16*)(ws + WS_PROJ); bf16* o = (bf16*)(ws + WS_O);
        gla_out_block(lds, proj, (const bf16*)(ws + WS_SG), (const bf16*)(ws + WS_KVG), (const float*)(ws + WS_DECG), (const float*)a.in[9], o, blk >> 3, blk & 7, tid, lane, wave);
    }
    SEAM(4);
    if (IN(5)) {
        pg8::DenseOrder S; S.init(ws + WS_O, ws + WS_WOUT, M, D, D, GRID, blk);
        pg8::EpiX1 E{(const float*)a.in[0], (bf16*)(ws + WS_X1), (const float*)(ws + WS_MOD)};
        pg8::gemm_phase<pg8::EpiX1, pg8::DenseOrder, false>(lds, D, S, E);
    }
    SEAM(5);
    if (IN(6)) p3b_route(lds, a, blk, wave, lane, tid);
    SEAM(6);
    if (IN(7)) {
        moe_prefix(tp, (const int*)ctl + CW_CNT, tid);
        pg8::MoeOrder<true> S; S.A = (const char*)(ws + WS_H); S.Bt = (const char*)(ws + WS_WGU); S.K = D; S.npn = 2; S.G = GRID; S.c = blk; S.bstride = (size_t)512 * D * 2;
        S.tp = tp; S.cnt = (const int*)ctl + CW_CNT; S.list = (const int*)(ws + WS_ROUTE);
        pg8::EpiAct E{(bf16*)(ws + WS_PROJ), (const int*)ctl + CW_CNT, (const float*)(ws + WS_ROUTE + 2 * MiB), tp};
        pg8::gemm_phase<pg8::EpiAct, pg8::MoeOrder<true>, true>(lds, D, S, E);
        if (blk >= 128) tr_stream(lds, a, 16 * 72 + 16 * 32 + 32 * 2 * 128, 16 * 72 + 16 * 32 + 32 * 2 * 128 + 32 * 128, (blk - 128) * NWAVES + wave, 128 * NWAVES, wave, lane);
    }
    SEAM(7);
    if (IN(8)) {
        moe_prefix(tp, (const int*)ctl + CW_CNT, tid);
        pg8::MoeOrder<false> S; S.A = (const char*)(ws + WS_PROJ); S.Bt = (const char*)(ws + WS_WD); S.K = 256; S.npn = 4; S.G = GRID; S.c = blk; S.bstride = (size_t)D * 256 * 2;
        S.tp = tp; S.cnt = (const int*)ctl + CW_CNT; S.list = (const int*)(ws + WS_ROUTE);
        pg8::EpiDown E{(bf16*)(ws + WS_Y2), (const int*)ctl + CW_CNT, (const int*)(ws + WS_ROUTE), tp};
        pg8::gemm_phase<pg8::EpiDown, pg8::MoeOrder<false>, true>(lds, 256, S, E);
    }
    SEAM(8);
    if (IN(9)) p6_final(lds, a, blk, wave, lane, tid);
#undef IN
#undef SEAM
}

extern "C" void kernel_launch(void* const* d_in, const int* in_sizes, int n_in, void* d_out, int out_size, void* d_ws, size_t ws_size, hipStream_t stream) {
    static int grid = 0;
    if (grid == 0) {
        if (n_in != 21 || in_sizes[0] != M * D || out_size != M * D || ws_size < WS_END) { fprintf(stderr, "kernel_launch: unexpected shapes (n_in %d, in0 %d, out %d, ws %zu)\n", n_in, n_in > 0 ? in_sizes[0] : -1, out_size, ws_size); grid = -1; return; }
        int dev = 0, cus = 0, per_cu = 0;
        if (hipGetDevice(&dev) != hipSuccess || hipDeviceGetAttribute(&cus, hipDeviceAttributeMultiprocessorCount, dev) != hipSuccess) { fprintf(stderr, "kernel_launch: device query failed\n"); grid = -1; return; }
        if (hipFuncSetAttribute((const void*)mk_fwd, hipFuncAttributeMaxDynamicSharedMemorySize, LDS_BYTES) != hipSuccess) { fprintf(stderr, "kernel_launch: hipFuncSetAttribute failed\n"); grid = -1; return; }
        if (hipOccupancyMaxActiveBlocksPerMultiprocessor(&per_cu, (const void*)mk_fwd, NTHR, LDS_BYTES) != hipSuccess || per_cu < 1) { fprintf(stderr, "kernel_launch: occupancy query says %d workgroups per CU\n", per_cu); grid = -1; return; }
        if (cus * per_cu < GRID) { fprintf(stderr, "kernel_launch: needs %d co-resident workgroups, device holds %d x %d\n", GRID, cus, per_cu); grid = -1; return; }
        grid = GRID;
    }
    if (grid < 0) return;
    (void)hipMemsetAsync((char*)d_ws + WS_CTL, 0, CTL_ZERO_BYTES, stream);
    Args a{};
    for (int i = 0; i < 21; ++i) a.in[i] = d_in[i];
    a.out = (float*)d_out; a.ws = (unsigned char*)d_ws;
    for (int i = 0; i < 8; ++i) a.rt.inv_freq[i] = (float)pow(500000.0, -(double)(2 * i) / 16.0);
    a.ph_lo = 0; a.ph_hi = NPH;
    void* args[] = {&a};
    const hipError_t e = hipLaunchCooperativeKernel((const void*)mk_fwd, dim3(GRID), dim3(NTHR), args, LDS_BYTES, stream);
    if (e != hipSuccess) fprintf(stderr, "kernel_launch: cooperative launch failed: %s\n", hipGetErrorString(e));
}
```

```cpp
#include <hip/hip_runtime.h>
#include <cstdio>
#include <cstdint>
#include <cmath>

typedef unsigned short bf16;
typedef float f32x4 __attribute__((ext_vector_type(4)));
typedef float f32x2 __attribute__((ext_vector_type(2)));
typedef float f32x16 __attribute__((ext_vector_type(16)));
typedef unsigned u32x4 __attribute__((ext_vector_type(4)));
typedef unsigned u32x2 __attribute__((ext_vector_type(2)));
typedef short bf16x8 __attribute__((ext_vector_type(8)));
#define GAS __attribute__((address_space(1)))
#define LAS __attribute__((address_space(3)))

__device__ __forceinline__ float bf2f(bf16 v) { return __uint_as_float(((unsigned)v) << 16); }
__device__ __forceinline__ unsigned f2bf(float f) { unsigned u = __float_as_uint(f); return (u + 0x7fffu + ((u >> 16) & 1u)) >> 16; }
typedef float f32x2_t __attribute__((ext_vector_type(2))); typedef __bf16 bf16x2_t __attribute__((ext_vector_type(2)));
__device__ __forceinline__ unsigned pk2(float lo, float hi) { const f32x2_t v = {lo, hi}; const bf16x2_t b = __builtin_convertvector(v, bf16x2_t); return __builtin_bit_cast(unsigned, b); }
__device__ __forceinline__ float lo_bf16(unsigned w) { return __uint_as_float(w << 16); }
__device__ __forceinline__ float hi_bf16(unsigned w) { return __uint_as_float(w & 0xffff0000u); }
__device__ __forceinline__ float silu_f(float v) { return v * __builtin_amdgcn_rcpf(1.f + __expf(-v)); }
template <int CTRL> __device__ __forceinline__ float dpp_mov(float v) { return __int_as_float(__builtin_amdgcn_update_dpp(0, __float_as_int(v), CTRL, 0xF, 0xF, true)); }
__device__ __forceinline__ float wave_sum(float v) {
    v += dpp_mov<0xB1>(v); v += dpp_mov<0x4E>(v); v += dpp_mov<0x141>(v); v += dpp_mov<0x140>(v);
    const float r0 = __int_as_float(__builtin_amdgcn_readlane(__float_as_int(v), 0)), r1 = __int_as_float(__builtin_amdgcn_readlane(__float_as_int(v), 16));
    const float r2 = __int_as_float(__builtin_amdgcn_readlane(__float_as_int(v), 32)), r3 = __int_as_float(__builtin_amdgcn_readlane(__float_as_int(v), 48));
    return (r0 + r1) + (r2 + r3);
}

constexpr int NB = 8, SEQ = 2048, D = 1024, M = NB * SEQ;
constexpr int PW = 2560;
constexpr int C_GQ = 0, C_GK = 256, C_GV = 512, C_GG = 1024, C_SQ = 1536, C_SK = 2048, C_SV = 2176, C_Z = 2304;
constexpr int INW = 2320;
constexpr float EPS = 1e-6f;
constexpr int NEXP = 32, LCAP = 16384;
constexpr int NWAVES = 8, NTHR = 512, GRID = 256;

constexpr size_t MiB = 1u << 20;
constexpr size_t WS_CTL = 0, CTL_ZERO_BYTES = 256 * 1024;
constexpr int CW_CNT = 0, CNT_STRIDE = 64, CW_BAR = 4096;
constexpr size_t WS_MODP = 1 * MiB;
constexpr size_t WS_MOD = 2 * MiB + 512 * 1024;
constexpr size_t WS_ROPE = 3 * MiB;
constexpr size_t WS_WIN = 4 * MiB;
constexpr size_t WS_WOUT = 10 * MiB;
constexpr size_t WS_WGU = 12 * MiB;
constexpr size_t WS_WD = 44 * MiB;
constexpr size_t WS_ROUTE = 60 * MiB;
constexpr size_t WS_H = 64 * MiB;
constexpr size_t WS_SG = 208 * MiB;
constexpr size_t WS_O = 96 * MiB;
constexpr size_t WS_PROJ = 128 * MiB;
constexpr size_t WS_X1 = 160 * MiB;
constexpr size_t WS_Y2 = 64 * MiB;
constexpr size_t WS_DEC = 224 * MiB;
constexpr size_t WS_KVG = 225 * MiB;
constexpr size_t WS_DECG = 229 * MiB;
constexpr size_t WS_WRB = 230 * MiB;
constexpr size_t WS_END = 231 * MiB;

constexpr int LDS_BYTES = 163840;
constexpr int MISC_OFF = LDS_BYTES - 512;
namespace pg8 {
#define PG8_LAS __attribute__((address_space(3)))
constexpr int BM = 256, BK = 64, HALF = 128, HTB = HALF * BK * 2  , STAGE_BYTES = 8 * HTB, NXCD = 8, WGM = 8;

__host__ __device__ __forceinline__ int lds_byte(int r, int c) { const int st = (r >> 4) * 2 + (c >> 5), rr = r & 15, cc = c & 31, ob = rr * 64 + cc * 2; return st * 1024 + (ob ^ (((ob >> 9) & 1) << 5)); }
__host__ __device__ __forceinline__ void stage_rc(int b, int& R, int& C) { const int st = b / 1024, sb = b % 1024, swz = sb ^ (((sb >> 9) & 1) << 5); R = (st >> 1) * 16 + swz / 64; C = (st & 1) * 32 + (swz % 64) / 2; }
__host__ __device__ __forceinline__ int perm32(int rho) { const int n = rho >> 4, i = rho & 15; return 8 * (i >> 2) + 4 * n + (i & 3); }

struct Unit { const char* A; const char* B; int i0, i1, i2, qm; };

__device__ __forceinline__ int xcd_remap(int wgid, int nwg) { const int q = nwg / NXCD, r = nwg % NXCD, xcd = wgid % NXCD, off = wgid / NXCD; return (xcd < r ? xcd * (q + 1) : r * (q + 1) + (xcd - r) * q) + off; }

struct DenseOrder {
    const char* A; const char* Bt; int K, nM, nN, nwg, G, c;
    __device__ void init(const void* A_, const void* Bt_, int M, int N, int K_, int G_, int c_) { A = (const char*)A_; Bt = (const char*)Bt_; K = K_; nM = M / BM; nN = N / BM; nwg = nM * nN; G = G_; c = c_; }
    __device__ __forceinline__ bool next(int i, Unit& u) const {
        const int L = i * G + c; if (L >= nwg) return false;
        const int wgid = xcd_remap(L, nwg);
        const int nig = WGM * nN, gid = wgid / nig, fm = gid * WGM, gsz = (nM - fm) < WGM ? (nM - fm) : WGM;
        const int pm = fm + ((wgid % nig) % gsz), pn = (wgid % nig) / gsz;
        u.A = A + (size_t)pm * BM * K * 2; u.B = Bt + (size_t)pn * BM * K * 2; u.i0 = pm; u.i1 = pn; u.i2 = 0; u.qm = 15; return true;
    }
    __device__ __forceinline__ void a_voff(const Unit&, const int (&R)[2], const int (&C)[2], unsigned (&v)[2][2]) const {
#pragma unroll
        for (int h = 0; h < 2; ++h)
#pragma unroll
            for (int i = 0; i < 2; ++i) v[h][i] = (unsigned)((h * HALF + R[i]) * K + C[i]) * 2u;
    }
};

template <bool GATHER> struct MoeOrder {
    const char* A; const char* Bt; int K, npn, G, c; size_t bstride; const PG8_LAS int* tp; const int* cnt; const int* list;
    __device__ __forceinline__ bool next(int i, Unit& u) const {
        const int ntile = tp[32], nwg = ntile * npn, nfr = nwg / G, nfull = nfr * G, R = nwg - nfull, f = (4 * R <= G) ? 4 : (2 * R <= G) ? 2 : 1;
        int L, qm;
        if (i < nfr) { L = i * G + c; qm = 15; }
        else { if (i > nfr) return false;
            const int P = (f * R + 7) >> 3, x = c & 7, y = c >> 3, j = x * P + y;
            if (y >= P || j >= f * R) return false; L = nfull + j / f; qm = f == 4 ? (1 << (j & 3)) : f == 2 ? ((j & 1) ? 10 : 5) : 15; }
        u.qm = __builtin_amdgcn_readfirstlane(qm);
        const int wgid = xcd_remap(L, nwg); const int T = wgid / npn, pn = wgid % npn;
        const int e = tp[40 + T];
        u.i0 = e; u.i1 = T - tp[e]; u.i2 = pn;
        u.A = GATHER ? A : A + (size_t)T * BM * K * 2; u.B = Bt + (size_t)e * bstride + (size_t)pn * BM * K * 2; return true;
    }
    __device__ __forceinline__ void a_voff(const Unit& u, const int (&R)[2], const int (&C)[2], unsigned (&v)[2][2]) const {
        if (GATHER) {
            const int n = tp[208 + u.i0]; int tk[2][2];
#pragma unroll
            for (int h = 0; h < 2; ++h)
#pragma unroll
                for (int i = 0; i < 2; ++i) { const int r = u.i1 * BM + h * HALF + R[i]; tk[h][i] = (r < n) ? list[u.i0 * 16384 + r] : 0; }
            asm volatile("s_waitcnt vmcnt(0)" ::: "memory");
#pragma unroll
            for (int h = 0; h < 2; ++h)
#pragma unroll
                for (int i = 0; i < 2; ++i) v[h][i] = (unsigned)((tk[h][i] >> 1) * K + C[i]) * 2u;
            asm volatile("" : "+v"(v[0][0]), "+v"(v[0][1]), "+v"(v[1][0]), "+v"(v[1][1]));
        } else {
#pragma unroll
            for (int h = 0; h < 2; ++h)
#pragma unroll
                for (int i = 0; i < 2; ++i) v[h][i] = (unsigned)((h * HALF + R[i]) * K + C[i]) * 2u;
        }
    }
};

__device__ __forceinline__ unsigned cvt_pk_bf16(float lo, float hi) { unsigned r; asm volatile("v_cvt_pk_bf16_f32 %0, %1, %2" : "=v"(r) : "v"(lo), "v"(hi)); return r; }

struct EpiBf16 {
    static constexpr bool PERM = true;
    bf16* O; int ldc;
    __device__ __forceinline__ void operator()(const f32x4 (&acc)[2][2][4][2], const Unit& u, int wr, int wc, int fr, int fq) const {
        const int row0 = u.i0 * BM + wr * 64 + fr; const int col0 = u.i1 * BM + wc * 32 + 8 * fq;
#pragma unroll
        for (int ai = 0; ai < 2; ++ai)
#pragma unroll
            for (int m = 0; m < 4; ++m) { bf16* rowp = O + (size_t)(row0 + ai * HALF + m * 16) * ldc + col0;
#pragma unroll
                for (int bj = 0; bj < 2; ++bj) { const f32x4 v0 = acc[ai][bj][m][0], v1 = acc[ai][bj][m][1];
                    u32x4 w; w.x = cvt_pk_bf16(v0[0], v0[1]); w.y = cvt_pk_bf16(v0[2], v0[3]); w.z = cvt_pk_bf16(v1[0], v1[1]); w.w = cvt_pk_bf16(v1[2], v1[3]);
                    *(u32x4*)(rowp + bj * HALF) = w; } }
    }
};

struct EpiX1 {
    static constexpr bool PERM = true;
    const float* x; bf16* out; const float* mod;
    __device__ __forceinline__ void operator()(const f32x4 (&acc)[2][2][4][2], const Unit& u, int wr, int wc, int fr, int fq) const {
        const int row0 = u.i0 * BM + wr * 64 + fr; const int col0 = u.i1 * BM + wc * 32 + 8 * fq;
        const float* gt = mod + (u.i0 >> 3) * 6144 + 2048;
        f32x4 gv[2][2];
#pragma unroll
        for (int bj = 0; bj < 2; ++bj)
#pragma unroll
            for (int n = 0; n < 2; ++n) gv[bj][n] = *(const f32x4*)(gt + col0 + bj * HALF + 4 * n);
#pragma unroll
        for (int ai = 0; ai < 2; ++ai) {
            f32x4 xv[4][2][2];
#pragma unroll
            for (int m = 0; m < 4; ++m) { const size_t off = (size_t)(row0 + ai * HALF + m * 16) * 1024 + col0;
#pragma unroll
                for (int bj = 0; bj < 2; ++bj) { xv[m][bj][0] = *(const f32x4*)(x + off + bj * HALF); xv[m][bj][1] = *(const f32x4*)(x + off + bj * HALF + 4); } }
            asm volatile("" ::: "memory");
#pragma unroll
            for (int m = 0; m < 4; ++m) { const size_t off = (size_t)(row0 + ai * HALF + m * 16) * 1024 + col0;
#pragma unroll
                for (int bj = 0; bj < 2; ++bj) { const f32x4 v0 = xv[m][bj][0] + gv[bj][0] * acc[ai][bj][m][0], v1 = xv[m][bj][1] + gv[bj][1] * acc[ai][bj][m][1];
                    u32x4 w; w.x = cvt_pk_bf16(v0[0], v0[1]); w.y = cvt_pk_bf16(v0[2], v0[3]); w.z = cvt_pk_bf16(v1[0], v1[1]); w.w = cvt_pk_bf16(v1[2], v1[3]);
                    *(u32x4*)(out + off + bj * HALF) = w; } }
        }
    }
};

struct EpiAct {
    static constexpr bool PERM = false;
    bf16* act; const int* cnt; const float* lw; const PG8_LAS int* tp;
    __device__ __forceinline__ void operator()(const f32x4 (&acc)[2][2][4][2], const Unit& u, int wr, int wc, int fr, int fq) const {
        const int e = u.i0, n_e = tp[208 + e]; const int rl0 = u.i1 * BM + wr * 64 + fr; const size_t rbase = (size_t)(tp[e] + u.i1) * BM + wr * 64 + fr;
        const int f0 = u.i2 * 128 + wc * 16 + 4 * fq;
        float wrow[2][4];
#pragma unroll
        for (int ai = 0; ai < 2; ++ai)
#pragma unroll
            for (int m = 0; m < 4; ++m) { const int rl = rl0 + ai * HALF + m * 16; wrow[ai][m] = (rl < n_e) ? lw[e * 16384 + rl] : 0.f; }
        asm volatile("" ::: "memory");
#pragma unroll
        for (int ai = 0; ai < 2; ++ai)
#pragma unroll
            for (int m = 0; m < 4; ++m) { const int rl = rl0 + ai * HALF + m * 16;
                if (rl < n_e) { const float w = wrow[ai][m]; bf16* rowp = act + (rbase + ai * HALF + m * 16) * 256 + f0;
#pragma unroll
                    for (int bj = 0; bj < 2; ++bj) if ((u.qm >> (2 * ai + bj)) & 1) { const f32x4 g = acc[ai][bj][m][0], up = acc[ai][bj][m][1]; u32x2 o;
                        o.x = cvt_pk_bf16(silu_f(g[0]) * up[0] * w, silu_f(g[1]) * up[1] * w); o.y = cvt_pk_bf16(silu_f(g[2]) * up[2] * w, silu_f(g[3]) * up[3] * w);
                        *(u32x2*)(rowp + bj * 64) = o; } } }
    }
};

struct EpiDown {
    static constexpr bool PERM = true;
    bf16* y2; const int* cnt; const int* list; const PG8_LAS int* tp;
    __device__ __forceinline__ void operator()(const f32x4 (&acc)[2][2][4][2], const Unit& u, int wr, int wc, int fr, int fq) const {
        const int e = u.i0, n_e = tp[208 + e]; const int rl0 = u.i1 * BM + wr * 64 + fr; const int col0 = u.i2 * BM + wc * 32 + 8 * fq;
        int tkr[2][4];
#pragma unroll
        for (int ai = 0; ai < 2; ++ai)
#pragma unroll
            for (int m = 0; m < 4; ++m) { const int rl = rl0 + ai * HALF + m * 16; tkr[ai][m] = (rl < n_e) ? list[e * 16384 + rl] : -1; }
        asm volatile("" ::: "memory");
#pragma unroll
        for (int ai = 0; ai < 2; ++ai)
#pragma unroll
            for (int m = 0; m < 4; ++m) { const int tk = tkr[ai][m];
                if (tk >= 0) { bf16* rowp = y2 + (size_t)tk * 1024 + col0;
#pragma unroll
                    for (int bj = 0; bj < 2; ++bj) if ((u.qm >> (2 * ai + bj)) & 1) { const f32x4 v0 = acc[ai][bj][m][0], v1 = acc[ai][bj][m][1];
                        u32x4 w; w.x = cvt_pk_bf16(v0[0], v0[1]); w.y = cvt_pk_bf16(v0[2], v0[3]); w.z = cvt_pk_bf16(v1[0], v1[1]); w.w = cvt_pk_bf16(v1[2], v1[3]);
                        *(u32x4*)(rowp + bj * HALF) = w; } } }
    }
};

template <class Epi, class Sched, bool ALIGN_EPI>
__device__ __forceinline__ void gemm_phase(PG8_LAS unsigned char* lds, const int K, const Sched& S, const Epi& E) {
    const int tid = threadIdx.x, wid = __builtin_amdgcn_readfirstlane(tid >> 6), lane = tid & 63, wr = wid >> 2, wc = wid & 3, fr = lane & 15, fq = lane >> 4;
    const int nt = K / BK;
    int Rr[2], Cc[2]; unsigned voffB[2];
#pragma unroll
    for (int i = 0; i < 2; ++i) { int R, C; stage_rc(tid * 16 + i * 8192, R, C); Rr[i] = R; Cc[i] = C; const int Rb = Epi::PERM ? ((R & ~31) + perm32(R & 31)) : R; voffB[i] = (unsigned)(Rb * K + C) * 2u; }
    const size_t kstep = (size_t)(BK * 2);
    const size_t hstep = (size_t)HALF * K * 2;
    const unsigned ldsw = (unsigned)wid * 1024u;
    const int aoff = lds_byte(wr * 64 + fr, fq * 8), boff = lds_byte(wc * 32 + fr, fq * 8);
#define PG8_SA(b, h) (((b) * 2 + (h)) * HTB)
#define PG8_SB(b, h) ((4 + (b) * 2 + (h)) * HTB)
#define PG8_STG(bufoff, gbase, v0, v1) do { \
        __builtin_amdgcn_global_load_lds((const unsigned*)((const char*)(gbase) + (v0)), (PG8_LAS unsigned*)(lds + (bufoff) + ldsw), 16, 0, 0); \
        __builtin_amdgcn_global_load_lds((const unsigned*)((const char*)(gbase) + (v1)), (PG8_LAS unsigned*)(lds + (bufoff) + ldsw + 8192), 16, 0, 0); } while (0)
#define PG8_STGB(bufoff, gbase) PG8_STG(bufoff, gbase, voffB[0], voffB[1])
#define PG8_LDA(dst, b, h) do { _Pragma("unroll") for (int m = 0; m < 4; ++m) _Pragma("unroll") for (int k = 0; k < 2; ++k) dst[m][k] = *(const PG8_LAS bf16x8*)(lds + PG8_SA(b, h) + aoff + m * 2048 + k * 1024); } while (0)
#define PG8_LDB(dst, b, h) do { _Pragma("unroll") for (int n = 0; n < 2; ++n) _Pragma("unroll") for (int k = 0; k < 2; ++k) dst[n][k] = *(const PG8_LAS bf16x8*)(lds + PG8_SB(b, h) + boff + n * 2048 + k * 1024); } while (0)
#define PG8_MMA(ai, bj, At, Bt) do { __builtin_amdgcn_s_setprio(1); _Pragma("unroll") for (int m = 0; m < 4; ++m) _Pragma("unroll") for (int n = 0; n < 2; ++n) _Pragma("unroll") for (int k = 0; k < 2; ++k) \
        acc[ai][bj][m][n] = __builtin_amdgcn_mfma_f32_16x16x32_bf16(Bt[n][k], At[m][k], acc[ai][bj][m][n], 0, 0, 0); __builtin_amdgcn_s_setprio(0); } while (0)
#define PG8_WAIT_V(n) asm volatile("s_waitcnt vmcnt(" #n ")" ::: "memory")
#define PG8_WAIT_L(n) asm volatile("s_waitcnt lgkmcnt(" #n ")" ::: "memory")
#define PG8_BAR __builtin_amdgcn_s_barrier()
#define PG8_SCHED __builtin_amdgcn_sched_barrier(0)
    Unit cur, nxt; int ui = 0;
    if (!S.next(0, cur)) return;
    unsigned cv[2][2], nv[2][2];
    S.a_voff(cur, Rr, Cc, cv);
#define PG8_QFIX(qm, v) do { if (!((qm) & 3)) { v[0][0] = v[1][0]; v[0][1] = v[1][1]; } if (!((qm) & 12)) { v[1][0] = v[0][0]; v[1][1] = v[0][1]; } } while (0)
    PG8_QFIX(cur.qm, cv);
    size_t chb0 = (cur.qm & 5) ? 0 : hstep, chb1 = (cur.qm & 10) ? hstep : 0;
    f32x4 acc[2][2][4][2];
#pragma unroll
    for (int a = 0; a < 2; ++a)
#pragma unroll
        for (int b = 0; b < 2; ++b)
#pragma unroll
            for (int m = 0; m < 4; ++m)
#pragma unroll
                for (int n = 0; n < 2; ++n) acc[a][b][m][n] = (f32x4){0.f, 0.f, 0.f, 0.f};
    bf16x8 At[4][2], B0[2][2], B1[2][2];
    const char* cA = cur.A; const char* cB = cur.B;
    PG8_STGB(PG8_SB(0, 0), cB + chb0); PG8_STGB(PG8_SB(0, 1), cB + chb1); PG8_STG(PG8_SA(0, 0), cA, cv[0][0], cv[0][1]); PG8_STG(PG8_SA(0, 1), cA, cv[1][0], cv[1][1]);
    if (wr == 1) PG8_BAR;
    PG8_WAIT_V(2); PG8_BAR;
    PG8_STGB(PG8_SB(1, 0), cB + chb0 + kstep); PG8_STG(PG8_SA(1, 0), cA + kstep, cv[0][0], cv[0][1]); PG8_STGB(PG8_SB(1, 1), cB + chb1 + kstep);
    PG8_WAIT_V(6); PG8_BAR;
    for (;;) {
        const bool has_next = S.next(ui + 1, nxt);
        if (has_next) { S.a_voff(nxt, Rr, Cc, nv); PG8_QFIX(nxt.qm, nv); }
        else { nv[0][0] = cv[0][0]; nv[0][1] = cv[0][1]; nv[1][0] = cv[1][0]; nv[1][1] = cv[1][1]; }
        const char* nA = has_next ? nxt.A : cA; const char* nB = has_next ? nxt.B : cB;
        const size_t nhb0 = has_next ? ((nxt.qm & 5) ? 0 : hstep) : chb0, nhb1 = has_next ? ((nxt.qm & 10) ? hstep : 0) : chb1;
        const bool q00 = cur.qm & 1, q01 = cur.qm & 2, q10 = cur.qm & 4, q11 = cur.qm & 8;
#pragma unroll 1
        for (int t = 0; t < nt; t += 2) {
            const bool last = (t == nt - 2);
            const char* a1 = cA + (size_t)(t + 1) * kstep;
            const char* a2 = last ? nA : cA + (size_t)(t + 2) * kstep; const char* b2 = last ? nB : cB + (size_t)(t + 2) * kstep;
            const char* a3 = a2 + kstep; const char* b3 = b2 + kstep;
            const size_t h0 = last ? nhb0 : chb0, h1 = last ? nhb1 : chb1;
            const unsigned x00 = last ? nv[0][0] : cv[0][0], x01 = last ? nv[0][1] : cv[0][1], x10 = last ? nv[1][0] : cv[1][0], x11 = last ? nv[1][1] : cv[1][1];
            PG8_LDB(B0, 0, 0); PG8_LDB(B1, 0, 1); PG8_SCHED; PG8_LDA(At, 0, 0); PG8_STG(PG8_SA(1, 1), a1, cv[1][0], cv[1][1]);
            PG8_WAIT_V(8); PG8_WAIT_L(0); PG8_BAR; if (q00) PG8_MMA(0, 0, At, B0); if (q01) PG8_MMA(0, 1, At, B1); PG8_BAR; PG8_SCHED;
            PG8_LDA(At, 0, 1); PG8_STGB(PG8_SB(0, 0), b2 + h0); PG8_STGB(PG8_SB(0, 1), b2 + h1); PG8_STG(PG8_SA(0, 0), a2, x00, x01);
            PG8_WAIT_V(8); PG8_WAIT_L(0); PG8_BAR; if (q10) PG8_MMA(1, 0, At, B0); if (q11) PG8_MMA(1, 1, At, B1); PG8_BAR; PG8_SCHED;
            PG8_LDB(B0, 1, 0); PG8_LDB(B1, 1, 1); PG8_SCHED; PG8_LDA(At, 1, 0); PG8_STG(PG8_SA(0, 1), a2, x10, x11);
            PG8_WAIT_V(8); PG8_WAIT_L(0); PG8_BAR; if (q00) PG8_MMA(0, 0, At, B0); if (q01) PG8_MMA(0, 1, At, B1); PG8_BAR; PG8_SCHED;
            PG8_LDA(At, 1, 1); PG8_STGB(PG8_SB(1, 0), b3 + h0); PG8_STGB(PG8_SB(1, 1), b3 + h1); PG8_STG(PG8_SA(1, 0), a3, x00, x01);
            PG8_WAIT_V(8); PG8_WAIT_L(0); PG8_BAR; if (q10) PG8_MMA(1, 0, At, B0); if (q11) PG8_MMA(1, 1, At, B1); PG8_BAR; PG8_SCHED;
        }
        if constexpr (ALIGN_EPI) { if (wr == 0) PG8_BAR; }
        E(acc, cur, wr, wc, fr, fq);
        if (!has_next) break;
#pragma unroll
        for (int a = 0; a < 2; ++a)
#pragma unroll
            for (int b = 0; b < 2; ++b)
#pragma unroll
                for (int m = 0; m < 4; ++m)
#pragma unroll
                    for (int n = 0; n < 2; ++n) acc[a][b][m][n] = (f32x4){0.f, 0.f, 0.f, 0.f};
        cur = nxt; cA = nA; cB = nB; ++ui; chb0 = nhb0; chb1 = nhb1;
        cv[0][0] = nv[0][0]; cv[0][1] = nv[0][1]; cv[1][0] = nv[1][0]; cv[1][1] = nv[1][1];
        if constexpr (ALIGN_EPI) { if (wr == 1) PG8_BAR; }
    }
    PG8_WAIT_V(0);
    if constexpr (!ALIGN_EPI) { if (wr == 0) PG8_BAR; }
    PG8_BAR;
#undef PG8_SA
#undef PG8_QFIX
#undef PG8_SB
#undef PG8_STG
#undef PG8_STGB
#undef PG8_LDA
#undef PG8_LDB
#undef PG8_MMA
#undef PG8_WAIT_V
#undef PG8_WAIT_L
#undef PG8_BAR
#undef PG8_SCHED
}
}
#define XB_TMO      128
#define XB_XCNT(j)  (256  + 64 * (j))
#define XB_XSUB(j)  (1280 + 64 * (j))
#define XB_XGEN(j)  (2304 + 64 * (j))
#define XB_TOP      3328
#define XB_TOPGEN   3392
#define XCD_BAR_WORDS 3456
#define XB_SPIN_CAP (1u << 18)

__device__ __forceinline__ unsigned xb_ld(unsigned* p)              { return __hip_atomic_load(p, __ATOMIC_RELAXED, __HIP_MEMORY_SCOPE_AGENT); }
__device__ __forceinline__ unsigned xb_add(unsigned* p, unsigned v) { return __hip_atomic_fetch_add(p, v, __ATOMIC_RELAXED, __HIP_MEMORY_SCOPE_AGENT); }
__device__ __forceinline__ unsigned xb_xcc_id() { return (unsigned)__builtin_amdgcn_s_getreg((3 << 11) | 20) & 0xFu; }
#define XB_SPIN(cond, bar) do { unsigned _sp = 0; while (cond) { __builtin_amdgcn_s_sleep(1); \
    if ((++_sp & 255u) == 0u) { if (xb_ld(&(bar)[XB_TMO])) break; if (_sp > XB_SPIN_CAP) { atomicAdd(&(bar)[XB_TMO], 1u); break; } } } } while (0)

struct XcdBarrier {
    unsigned* bar; unsigned x;
    volatile LAS unsigned* st;
};

__device__ __forceinline__ XcdBarrier xcd_barrier_post(unsigned* bar, volatile LAS unsigned* st) {
    XcdBarrier b; b.bar = bar; b.x = xb_xcc_id(); b.st = st;
    if (threadIdx.x == 0) (void)xb_add(&bar[XB_XCNT(b.x)], 1u);
    return b;
}
__device__ __forceinline__ void xcd_barrier_complete(unsigned* bar, unsigned x, unsigned& nloc, unsigned& nx) {
    const unsigned G = gridDim.x * gridDim.y * gridDim.z;
    unsigned sum, cnt, mine, sp = 0u;
    for (;;) {
        sum = 0u; cnt = 0u; mine = 0u;
#pragma unroll
        for (unsigned j = 0; j < 16; ++j) { const unsigned c = xb_ld(&bar[XB_XCNT(j)]); sum += c; cnt += (c > 0u) ? 1u : 0u; mine = (j == x) ? c : mine; }
        if (sum == G) break;
        __builtin_amdgcn_s_sleep(1);
        if ((++sp & 255u) == 0u) { if (xb_ld(&bar[XB_TMO])) break; if (sp > XB_SPIN_CAP) { atomicAdd(&bar[XB_TMO], 1u); break; } }
    }
    nloc = mine > 0u ? mine : 1u; nx = cnt > 0u ? cnt : 1u;
}

__device__ __forceinline__ void xcd_barrier(const XcdBarrier& b) {
    asm volatile("s_waitcnt vmcnt(0)" ::: "memory");
    __syncthreads();
    if (threadIdx.x == 0) {
        unsigned* bar = b.bar;
        __builtin_amdgcn_s_waitcnt(0);
        unsigned nloc = b.st[0], nx = b.st[1];
        if (nloc == 0u) { xcd_barrier_complete(bar, b.x, nloc, nx); b.st[0] = nloc; b.st[1] = nx; }
        const unsigned old = xb_add(&bar[XB_XSUB(b.x)], 1u);
        const unsigned gen = old / nloc;
        if (old + 1u == (gen + 1u) * nloc) {
            __builtin_amdgcn_fence(__ATOMIC_RELEASE, "agent");
            asm volatile("s_waitcnt vmcnt(0)" ::: "memory");
            const unsigned og = xb_add(&bar[XB_TOP], 1u);
            const unsigned tg = og / nx;
            if (og + 1u == (tg + 1u) * nx) xb_add(&bar[XB_TOPGEN], 1u);
            else XB_SPIN(xb_ld(&bar[XB_TOPGEN]) == tg, bar);
            __builtin_amdgcn_fence(__ATOMIC_ACQUIRE, "agent");
            xb_add(&bar[XB_XGEN(b.x)], 1u);
            asm volatile("s_waitcnt vmcnt(0)" ::: "memory");
        } else {
            __builtin_amdgcn_fence(__ATOMIC_ACQUIRE, "agent");
            XB_SPIN(xb_ld(&bar[XB_XGEN(b.x)]) == gen, bar);
            asm volatile("s_waitcnt vmcnt(0)" ::: "memory");
        }
    }
    __syncthreads();
}
struct RopeTab { float inv_freq[8]; };
struct Args { const void* in[21]; float* out; unsigned char* ws; int ph_lo, ph_hi; RopeTab rt; };

__device__ __forceinline__ void p0_adaln(LAS unsigned char* lds, const float* c, const float* ada_w, const float* ada_b, float* modp, int blk, int tid) {
    LAS float* ca = (LAS float*)lds;
    LAS float* red = (LAS float*)(lds + 4096);
    const int kc = blk >> 5, cc = blk & 31;
    for (int i = tid; i < 1024; i += NTHR) { const int b = i >> 7, k = i & 127; ca[i] = silu_f(c[b * D + kc * 128 + k]); }
    __syncthreads();
    if (tid < 480) {
        const int cq = tid % 48, kr = tid / 48;
        f32x4 acc[8];
#pragma unroll
        for (int b = 0; b < 8; ++b) acc[b] = (f32x4){0.f, 0.f, 0.f, 0.f};
        const float* wp = ada_w + (size_t)(kc * 128) * 6144 + cc * 192 + cq * 4;
        f32x4 wv[13];
#pragma unroll
        for (int i = 0; i < 13; ++i) { const int k = kr + 10 * i; wv[i] = (k < 128) ? *(const f32x4*)(wp + (size_t)k * 6144) : (f32x4){0.f, 0.f, 0.f, 0.f}; }
#pragma unroll
        for (int i = 0; i < 13; ++i) { const int k = (kr + 10 * i) & 127;
#pragma unroll
            for (int b = 0; b < 8; ++b) acc[b] += wv[i] * ca[b * 128 + k]; }
#pragma unroll
        for (int b = 0; b < 8; ++b) *(LAS f32x4*)(red + (kr * 8 + b) * 192 + cq * 4) = acc[b];
    }
    __syncthreads();
    if (tid < 384) { const int b = tid / 48, cq = tid % 48; f32x4 s = (f32x4){0.f, 0.f, 0.f, 0.f};
#pragma unroll
        for (int kr = 0; kr < 10; ++kr) s += *(const LAS f32x4*)(red + (kr * 8 + b) * 192 + cq * 4);
        if (kc == 0) s += *(const f32x4*)(ada_b + cc * 192 + cq * 4);
        *(f32x4*)(modp + (size_t)(kc * 8 + b) * 6144 + cc * 192 + cq * 4) = s; }
    __syncthreads();
}

__device__ __forceinline__ void tr_store(LAS float* scr, bf16* dst, int Kd, int k0, int rowbase, bool gu, int lane) {
    asm volatile("s_waitcnt lgkmcnt(0)" ::: "memory");
    const int c = lane & 7;
#pragma unroll
    for (int j = 0; j < 4; ++j) { const int n = (lane >> 3) + 8 * j; const LAS float* s = scr + (8 * c) * 33 + n;
        u32x4 o; o.x = pk2(s[0 * 33], s[1 * 33]); o.y = pk2(s[2 * 33], s[3 * 33]); o.z = pk2(s[4 * 33], s[5 * 33]); o.w = pk2(s[6 * 33], s[7 * 33]);
        const int row = rowbase + n + ((gu && n >= 16) ? 16 : 0);
        *(u32x4*)(dst + (size_t)row * Kd + k0 + 8 * c) = o; }
    asm volatile("s_waitcnt lgkmcnt(0)" ::: "memory");
}
struct TrItem { const float* src; bf16* dst; int ldw, Kd, k0, rowbase; bool gu; };
__device__ __forceinline__ bool tr_decode(int it, const Args& a, TrItem& t) {
    constexpr int I0 = 16 * 72, I2 = 16 * 32, I3 = 32 * 2 * 128, I4 = 32 * 128, NIT = I0 + I2 + I3 + I4;
    if (it >= NIT) return false;
    unsigned char* ws = a.ws;
    const float* w_in = (const float*)a.in[6]; const float* w_out = (const float*)a.in[11];
    const float* w_gate = (const float*)a.in[17]; const float* w_up = (const float*)a.in[18]; const float* w_down = (const float*)a.in[19];
    bf16* win = (bf16*)(ws + WS_WIN); bf16* wout = (bf16*)(ws + WS_WOUT); bf16* wgu = (bf16*)(ws + WS_WGU); bf16* wd = (bf16*)(ws + WS_WD);
    int r = it;
    if (r < I0) { const int kb = r / 72, nb = r % 72, n0 = nb * 32, k0 = kb * 64; const int sc = n0 + (n0 >= 1536 ? 16 : 0);
        t.src = w_in + (size_t)k0 * INW + sc; t.ldw = INW; t.dst = win; t.Kd = D; t.k0 = k0; t.rowbase = n0; t.gu = false; return true; }
    r -= I0;
    if (r < I2) { const int kb = r / 32, nb = r % 32, n0 = nb * 32, k0 = kb * 64;
        t.src = w_out + (size_t)k0 * D + n0; t.ldw = D; t.dst = wout; t.Kd = D; t.k0 = k0; t.rowbase = n0; t.gu = false; return true; }
    r -= I2;
    if (r < I3) { const int e = r >> 8, ty = (r >> 7) & 1, q = r & 127, kb = q >> 3, nb = q & 7, n0 = nb * 32, k0 = kb * 64;
        t.src = (ty ? w_up : w_gate) + (size_t)e * D * 256 + (size_t)k0 * 256 + n0; t.ldw = 256; t.dst = wgu + (size_t)e * 512 * D; t.Kd = D; t.k0 = k0; t.rowbase = 2 * n0 + 16 * ty; t.gu = true; return true; }
    r -= I3;
    { const int e = r >> 7, q = r & 127, kb = q >> 5, nb = q & 31, n0 = nb * 32, k0 = kb * 64;
        t.src = w_down + (size_t)e * 256 * D + (size_t)k0 * D + n0; t.ldw = D; t.dst = wd + (size_t)e * D * 256; t.Kd = 256; t.k0 = k0; t.rowbase = n0; t.gu = false; return true; }
}
__device__ __forceinline__ void tr_load(const TrItem& t, f32x4 (&v)[8], int lane) {
#pragma unroll
    for (int i = 0; i < 8; ++i) v[i] = *(const f32x4*)(t.src + (size_t)(8 * i + (lane >> 3)) * t.ldw + 4 * (lane & 7));
}
__device__ __forceinline__ void tr_finish(const TrItem& t, const f32x4 (&v)[8], LAS float* scr, int lane) {
#pragma unroll
    for (int i = 0; i < 8; ++i) { LAS float* s = scr + (8 * i + (lane >> 3)) * 33 + 4 * (lane & 7); s[0] = v[i].x; s[1] = v[i].y; s[2] = v[i].z; s[3] = v[i].w; }
    tr_store(scr, t.dst, t.Kd, t.k0, t.rowbase, t.gu, lane);
}
__device__ __forceinline__ void tr_stream(LAS unsigned char* scrbase, const Args& a, int first, int last, int gw, int NGW, int wave, int lane) {
    LAS float* scr = (LAS float*)(scrbase + wave * 8704);
    TrItem cur, nxt; f32x4 va[8], vb[8];
    int it = first + gw;
    bool have = it < last && tr_decode(it, a, cur);
    if (have) tr_load(cur, va, lane);
    while (have) {
        const bool hn = (it + NGW) < last && tr_decode(it + NGW, a, nxt);
        if (hn) tr_load(nxt, vb, lane);
        tr_finish(cur, va, scr, lane);
        if (!hn) break;
        const bool hn2 = (it + 2 * NGW) < last && tr_decode(it + 2 * NGW, a, cur);
        if (hn2) tr_load(cur, va, lane);
        tr_finish(nxt, vb, scr, lane);
        it += 2 * NGW; have = hn2;
    }
}
__device__ __forceinline__ void p0_weights(LAS unsigned char* lds, const Args& a, int blk, int wave, int lane, int tid) {
    unsigned char* ws = a.ws;
    const float* w_in = (const float*)a.in[6]; const float* w_a2 = (const float*)a.in[7]; const float* b_a2 = (const float*)a.in[8];
    bf16* win = (bf16*)(ws + WS_WIN);
    if (tid < 64 && blk < 192) {
        const float* w_grp = (const float*)a.in[13]; const float* w_exp = (const float*)a.in[15]; bf16* wrb = (bf16*)(ws + WS_WRB);
        const int e = blk * 64 + tid, ln = e & 63, hl = (e >> 6) & 1; const bool ex = e < 8192;
        const int k0 = ex ? 128 * (e >> 10) + 16 * ((e >> 7) & 7) + 8 * (ln >> 5) : 128 * ((e - 8192) >> 9) + 32 * ((e >> 7) & 3) + 8 * (ln >> 4);
        const int col = ex ? (ln & 31) : (ln & 15);
        unsigned o[4];
#pragma unroll
        for (int j2 = 0; j2 < 4; ++j2) { unsigned pr[2];
#pragma unroll
            for (int u = 0; u < 2; ++u) { const int k = k0 + 2 * j2 + u; const float wv = ex ? w_exp[k * 32 + col] : (col < 4 ? w_grp[k * 4 + col] : 0.f);
                const unsigned hi = f2bf(wv); const float hf = __uint_as_float(hi << 16); pr[u] = hl ? f2bf(wv - hf) : hi; }
            o[j2] = pr[0] | (pr[1] << 16); }
        *(u32x4*)(wrb + (size_t)e * 8) = (u32x4){o[0], o[1], o[2], o[3]};
    }
    {
        float wa[16];
#pragma unroll
        for (int q = 0; q < 16; ++q) wa[q] = w_a2[q * 256 + blk];
        float s2[2];
#pragma unroll
        for (int u = 0; u < 2; ++u) { const float* wr = w_in + (size_t)(2 * tid + u) * INW + 1536; float s = 0.f;
#pragma unroll
            for (int q4 = 0; q4 < 4; ++q4) { const f32x4 w = *(const f32x4*)(wr + 4 * q4); s = fmaf(w.x, wa[4 * q4], s); s = fmaf(w.y, wa[4 * q4 + 1], s); s = fmaf(w.z, wa[4 * q4 + 2], s); s = fmaf(w.w, wa[4 * q4 + 3], s); }
            s2[u] = s; }
        *(unsigned*)(win + (size_t)(C_Z + blk) * D + 2 * tid) = pk2(s2[0], s2[1]);
    }
}

__device__ __forceinline__ void p1a_rows(LAS unsigned char* lds, const Args& a, int blk, int wave, int lane, int tid, f32x4 (&n0)[4], f32x4 (&n1)[4]) {
    const float* x = (const float*)a.in[0]; const float* g = (const float*)a.in[5];
    const float* modp = (const float*)(a.ws + WS_MODP); float* mod = (float*)(a.ws + WS_MOD); bf16* h = (bf16*)(a.ws + WS_H);
    const int* pos = (const int*)a.in[2]; float* rtab = (float*)(a.ws + WS_ROPE);
    LAS float* ssh = (LAS float*)lds;
    const int b = blk >> 5;
    {
        float pv[4][8];
#pragma unroll
        for (int q = 0; q < 4; ++q)
#pragma unroll
            for (int kc = 0; kc < 8; ++kc) pv[q][kc] = modp[(size_t)(kc * 8 + b) * 6144 + tid + NTHR * q];
#pragma unroll
        for (int q = 0; q < 4; ++q) { const int i = tid + NTHR * q; float s = 0.f;
#pragma unroll
            for (int kc = 0; kc < 8; ++kc) s += pv[q][kc];
            ssh[i] = i < 1024 ? s : (1.f + s) * g[i - 1024]; }
    }
    if (tid < 192) { const int idx = blk * 192 + tid, bb = idx / 6144, col = idx % 6144; float s = 0.f;
#pragma unroll
        for (int kc = 0; kc < 8; ++kc) s += modp[(size_t)(kc * 8 + bb) * 6144 + col];
        mod[idx] = s; }
    { const int m = blk * 64 + (tid >> 3), j = tid & 7; float sn, cs; sincosf((float)pos[m] * a.rt.inv_freq[j], &sn, &cs); rtab[m * 16 + j] = cs; rtab[m * 16 + 8 + j] = sn; }
    __syncthreads();
    for (int r = wave; r < 64; r += NWAVES) {
        const size_t m = (size_t)blk * 64 + r;
        f32x4 v[4]; float ss = 0.f;
#pragma unroll
        for (int j = 0; j < 4; ++j) { v[j] = n0[j]; n0[j] = n1[j]; }
        if (r + 2 * NWAVES < 64) {
#pragma unroll
            for (int j = 0; j < 4; ++j) n1[j] = *(const f32x4*)(x + (m + 2 * NWAVES) * D + 4 * lane + 256 * j);
        }
#pragma unroll
        for (int j = 0; j < 4; ++j) ss += (v[j].x * v[j].x + v[j].y * v[j].y) + (v[j].z * v[j].z + v[j].w * v[j].w);
        const float rinv = rsqrtf(wave_sum(ss) * (1.f / D) + EPS);
#pragma unroll
        for (int j = 0; j < 4; ++j) { const int col = 4 * lane + 256 * j; const f32x4 sh = *(const LAS f32x4*)(ssh + col), gs = *(const LAS f32x4*)(ssh + 1024 + col);
            const f32x4 hv = v[j] * rinv * gs + sh; u32x2 o; o.x = pk2(hv.x, hv.y); o.y = pk2(hv.z, hv.w);
            *(u32x2*)(h + m * D + col) = o; }
    }
    __syncthreads();
}

struct RouteFrags { bf16x8 bh[8], bl[8], gh[4], gl[4]; };
__device__ __forceinline__ void p3b_pre(LAS unsigned char* lds, const Args& a, int blk, int wave, int lane, int tid, RouteFrags& f) {
    const float* g = (const float*)a.in[12]; const float* mod = (const float*)(a.ws + WS_MOD); const bf16* wrb = (const bf16*)(a.ws + WS_WRB);
    const float* b_grp = (const float*)a.in[14]; const float* b_exp = (const float*)a.in[16];
    LAS float* ssh = (LAS float*)(lds + 131072);
    LAS float* biasL = (LAS float*)(lds + 139264) + 448;
    const int b = blk >> 5;
#pragma unroll
    for (int s = 0; s < 8; ++s) { const size_t e = (size_t)(((wave * 8 + s) * 2) * 64 + lane) * 8; f.bh[s] = *(const bf16x8*)(wrb + e); f.bl[s] = *(const bf16x8*)(wrb + e + 512); }
#pragma unroll
    for (int s = 0; s < 4; ++s) { const size_t e = (size_t)(8192 + ((wave * 4 + s) * 2) * 64 + lane) * 8; f.gh[s] = *(const bf16x8*)(wrb + e); f.gl[s] = *(const bf16x8*)(wrb + e + 512); }
    float mv[4], gv[4];
#pragma unroll
    for (int q = 0; q < 4; ++q) { const int i = tid + NTHR * q; mv[q] = mod[b * 6144 + 3 * D + i]; gv[q] = i < 1024 ? 0.f : g[i - 1024]; }
#pragma unroll
    for (int q = 0; q < 4; ++q) { const int i = tid + NTHR * q; ssh[i] = i < 1024 ? mv[q] : (1.f + mv[q]) * gv[q]; }
    if (tid >= 64 && tid < 100) biasL[tid - 64] = (tid < 96) ? b_exp[tid - 64] : b_grp[tid - 96];
}
__device__ __forceinline__ void p3b_route(LAS unsigned char* lds, const Args& a, int blk, int wave, int lane, int tid, const RouteFrags& f) {
    const bf16* x1 = (const bf16*)(a.ws + WS_X1); const float* g = (const float*)a.in[12];
    const float* b_grp = (const float*)a.in[14]; const float* b_exp = (const float*)a.in[16];
    const float* mod = (const float*)(a.ws + WS_MOD); bf16* h2 = (bf16*)(a.ws + WS_H); const bf16* wrb = (const bf16*)(a.ws + WS_WRB);
    int* cnt = (int*)(a.ws + WS_CTL) + CW_CNT; int* list = (int*)(a.ws + WS_ROUTE); float* lw = (float*)(a.ws + WS_ROUTE + 2 * MiB);
    LAS unsigned char* Ahi = lds; LAS unsigned char* Alo = lds + 65536;
    LAS float* red = (LAS float*)lds;
    LAS float* lgt = (LAS float*)(lds + 65536);
    LAS float* ssh = (LAS float*)(lds + 131072);
    LAS int* rsel = (LAS int*)(lds + 139264); LAS int* rslot = rsel + 128; LAS float* rwt = (LAS float*)(rslot + 128); LAS int* lcnt = (LAS int*)(rwt + 128); LAS int* lbase = lcnt + 32;
    LAS float* biasL = (LAS float*)(lbase + 32);
    const int b = blk >> 5, l31 = lane & 31, hh = lane >> 5;
    u32x2 nx[4][4];
#pragma unroll
    for (int rr = 0; rr < 4; ++rr)
#pragma unroll
        for (int j = 0; j < 4; ++j) nx[rr][j] = *(const u32x2*)(x1 + ((size_t)blk * 64 + wave * 4 + rr) * D + 4 * lane + 256 * j);
    if (tid < 32) lcnt[tid] = 0;
    __syncthreads();
#pragma unroll 1
    for (int pass = 0; pass < 2; ++pass) {
#pragma unroll
        for (int rr = 0; rr < 4; ++rr) {
            const int rl = wave * 4 + rr; const int m = blk * 64 + pass * 32 + rl;
            f32x4 v[4]; float ss = 0.f;
#pragma unroll
            for (int j = 0; j < 4; ++j) { v[j].x = lo_bf16(nx[rr][j].x); v[j].y = hi_bf16(nx[rr][j].x); v[j].z = lo_bf16(nx[rr][j].y); v[j].w = hi_bf16(nx[rr][j].y); }
            if (pass == 0) {
#pragma unroll
              for (int j = 0; j < 4; ++j) nx[rr][j] = *(const u32x2*)(x1 + (size_t)(m + 32) * D + 4 * lane + 256 * j); }
#pragma unroll
            for (int j = 0; j < 4; ++j) ss += (v[j].x * v[j].x + v[j].y * v[j].y) + (v[j].z * v[j].z + v[j].w * v[j].w);
            const float rinv = rsqrtf(wave_sum(ss) * (1.f / D) + EPS);
#pragma unroll
            for (int j = 0; j < 4; ++j) { const int col = 4 * lane + 256 * j; const f32x4 sh = *(const LAS f32x4*)(ssh + col), sc = *(const LAS f32x4*)(ssh + 1024 + col);
                v[j] = v[j] * rinv * sc + sh;
                u32x2 hi; hi.x = pk2(v[j].x, v[j].y); hi.y = pk2(v[j].z, v[j].w);
                *(u32x2*)(h2 + (size_t)m * D + col) = hi;
                u32x2 lo; lo.x = pk2(v[j].x - lo_bf16(hi.x), v[j].y - hi_bf16(hi.x)); lo.y = pk2(v[j].z - lo_bf16(hi.y), v[j].w - hi_bf16(hi.y));
                const int c = (lane >> 1) + 32 * j; const int off = rl * 2048 + ((c ^ (rl & 15)) * 16) + 8 * (lane & 1);
                *(LAS u32x2*)(Ahi + off) = hi; *(LAS u32x2*)(Alo + off) = lo; }
        }
        __syncthreads();
        f32x16 acc0; f32x4 accg[2];
#pragma unroll
        for (int r = 0; r < 16; ++r) acc0[r] = 0.f;
        accg[0] = (f32x4){0.f, 0.f, 0.f, 0.f}; accg[1] = (f32x4){0.f, 0.f, 0.f, 0.f};
#pragma unroll
        for (int s = 0; s < 8; ++s) { const int c = 2 * (wave * 8 + s) + hh; const int off = l31 * 2048 + ((c ^ (l31 & 15)) * 16);
            const bf16x8 ah = *(const LAS bf16x8*)(Ahi + off), al = *(const LAS bf16x8*)(Alo + off);
            acc0 = __builtin_amdgcn_mfma_f32_32x32x16_bf16(ah, f.bh[s], acc0, 0, 0, 0); acc0 = __builtin_amdgcn_mfma_f32_32x32x16_bf16(ah, f.bl[s], acc0, 0, 0, 0); acc0 = __builtin_amdgcn_mfma_f32_32x32x16_bf16(al, f.bh[s], acc0, 0, 0, 0); }
#pragma unroll
        for (int s = 0; s < 4; ++s)
#pragma unroll
            for (int mt = 0; mt < 2; ++mt) { const int row = 16 * mt + (lane & 15), c = 16 * wave + 4 * s + (lane >> 4); const int off = row * 2048 + ((c ^ (row & 15)) * 16);
                const bf16x8 ah = *(const LAS bf16x8*)(Ahi + off), al = *(const LAS bf16x8*)(Alo + off);
                accg[mt] = __builtin_amdgcn_mfma_f32_16x16x32_bf16(ah, f.gh[s], accg[mt], 0, 0, 0); accg[mt] = __builtin_amdgcn_mfma_f32_16x16x32_bf16(ah, f.gl[s], accg[mt], 0, 0, 0); accg[mt] = __builtin_amdgcn_mfma_f32_16x16x32_bf16(al, f.gh[s], accg[mt], 0, 0, 0); }
        __syncthreads();
#pragma unroll
        for (int r = 0; r < 16; ++r) { const int row = (r & 3) + 8 * (r >> 2) + 4 * hh; red[(wave * 32 + row) * 36 + l31] = acc0[r]; }
        if ((lane & 15) < 4) {
#pragma unroll
            for (int mt = 0; mt < 2; ++mt)
#pragma unroll
                for (int r = 0; r < 4; ++r) red[(wave * 32 + 16 * mt + 4 * (lane >> 4) + r) * 36 + 32 + (lane & 15)] = accg[mt][r];
        }
        __syncthreads();
#pragma unroll
        for (int q = 0; q < 3; ++q) { const int p = tid + NTHR * q;
            if (p < 32 * 36) { float s = 0.f;
#pragma unroll
                for (int w = 0; w < 8; ++w) s += red[w * (32 * 36) + p];
                lgt[p] = s + biasL[p % 36]; } }
        __syncthreads();
        if (tid < 32) {
            const int row = tid;
            float lg[4];
#pragma unroll
            for (int o = 0; o < 4; ++o) lg[o] = lgt[row * 36 + 32 + o];
            int gi = 0; float gm = lg[0];
#pragma unroll
            for (int o = 1; o < 4; ++o) if (lg[o] > gm) { gm = lg[o]; gi = o; }
            float den = 0.f;
#pragma unroll
            for (int o = 0; o < 4; ++o) den += __expf(lg[o] - gm);
            const float gate = 1.f / den;
            float sl[8];
#pragma unroll
            for (int i = 0; i < 8; ++i) sl[i] = lgt[row * 36 + gi * 8 + i];
            int i1 = 0; float v1 = sl[0];
#pragma unroll
            for (int i = 1; i < 8; ++i) if (sl[i] > v1) { v1 = sl[i]; i1 = i; }
            int i2 = 0; float v2 = -INFINITY;
#pragma unroll
            for (int i = 0; i < 8; ++i) if (i != i1 && sl[i] > v2) { v2 = sl[i]; i2 = i; }
            const float e2 = __expf(v2 - v1), w1 = gate / (1.f + e2), w2 = gate * e2 / (1.f + e2);
            const int ea = gi * 8 + i1, eb = gi * 8 + i2, r2 = 2 * (pass * 32 + row);
            rsel[r2] = ea; rslot[r2] = atomicAdd((int*)(lcnt + ea), 1); rwt[r2] = w1;
            rsel[r2 + 1] = eb; rslot[r2 + 1] = atomicAdd((int*)(lcnt + eb), 1); rwt[r2 + 1] = w2;
        }
        __syncthreads();
    }
    if (tid < 32) { const int c = lcnt[tid]; lbase[tid] = c ? atomicAdd(&cnt[tid * CNT_STRIDE], c) : 0; }
    __syncthreads();
    if (tid < 128) { const int e = rsel[tid], slot = lbase[e] + rslot[tid]; list[e * LCAP + slot] = (blk * 64 + (tid >> 1)) * 2 + (tid & 1); lw[e * LCAP + slot] = rwt[tid]; }
    __syncthreads();
}

__device__ __forceinline__ void moe_prefix(LAS int* tp, const int* cnt, int tid) {
    if (tid < 64) {
        const int craw = __hip_atomic_load(cnt + (tid & 31) * CNT_STRIDE, __ATOMIC_RELAXED, __HIP_MEMORY_SCOPE_AGENT);
        if (tid < NEXP) tp[208 + tid] = craw;
        const int c = tid < NEXP ? ((craw + 255) >> 8) : 0;
        int s = c;
#pragma unroll
        for (int o = 1; o < 32; o <<= 1) { const int t = __shfl_up(s, o); if ((tid & 63) >= o) s += t; }
        if (tid < NEXP) { tp[tid] = s - c; for (int t = s - c; t < s; ++t) tp[40 + t] = tid; }
        if (tid == NEXP - 1) tp[NEXP] = s;
    }
    __syncthreads();
}

__device__ __forceinline__ void p6_final(LAS unsigned char* lds, const Args& a, int blk, int wave, int lane, int tid) {
    float* out = a.out; const bf16* x1 = (const bf16*)(a.ws + WS_X1); const float* fg = (const float*)a.in[20]; const float* mod = (const float*)(a.ws + WS_MOD); const bf16* y2 = (const bf16*)(a.ws + WS_Y2);
    LAS float* gt = (LAS float*)lds;
    const int b = blk >> 5;
    for (int i = tid; i < 1024; i += NTHR) gt[i] = mod[b * 6144 + 5 * D + i];
    __syncthreads();
    f32x4 gg[4];
#pragma unroll
    for (int j = 0; j < 4; ++j) gg[j] = *(const f32x4*)(fg + 4 * lane + 256 * j);
    u32x2 nx[4]; u32x2 nya[4], nyb[4];
    {
        const size_t m = (size_t)blk * 64 + wave;
#pragma unroll
        for (int j = 0; j < 4; ++j) { const int col = 4 * lane + 256 * j; nx[j] = *(const u32x2*)(x1 + m * D + col); nya[j] = *(const u32x2*)(y2 + (m * 2) * D + col); nyb[j] = *(const u32x2*)(y2 + (m * 2 + 1) * D + col); }
    }
    for (int r = wave; r < 64; r += NWAVES) {
        const size_t m = (size_t)blk * 64 + r;
        f32x4 v[4]; u32x2 ya4[4], yb4[4]; float ss = 0.f;
#pragma unroll
        for (int j = 0; j < 4; ++j) { v[j].x = lo_bf16(nx[j].x); v[j].y = hi_bf16(nx[j].x); v[j].z = lo_bf16(nx[j].y); v[j].w = hi_bf16(nx[j].y); ya4[j] = nya[j]; yb4[j] = nyb[j]; }
        if (r + NWAVES < 64) {
            const size_t mn = m + NWAVES;
#pragma unroll
            for (int j = 0; j < 4; ++j) { const int col = 4 * lane + 256 * j; nx[j] = *(const u32x2*)(x1 + mn * D + col); nya[j] = *(const u32x2*)(y2 + (mn * 2) * D + col); nyb[j] = *(const u32x2*)(y2 + (mn * 2 + 1) * D + col); }
        }
#pragma unroll
        for (int j = 0; j < 4; ++j) { const int col = 4 * lane + 256 * j; const u32x2 ya = ya4[j], yb = yb4[j];
            f32x4 y; y.x = __uint_as_float(ya.x << 16) + __uint_as_float(yb.x << 16); y.y = __uint_as_float(ya.x & 0xffff0000u) + __uint_as_float(yb.x & 0xffff0000u);
            y.z = __uint_as_float(ya.y << 16) + __uint_as_float(yb.y << 16); y.w = __uint_as_float(ya.y & 0xffff0000u) + __uint_as_float(yb.y & 0xffff0000u);
            v[j] += *(const LAS f32x4*)(gt + col) * y; ss += (v[j].x * v[j].x + v[j].y * v[j].y) + (v[j].z * v[j].z + v[j].w * v[j].w); }
        const float rinv = rsqrtf(wave_sum(ss) * (1.f / D) + EPS);
#pragma unroll
        for (int j = 0; j < 4; ++j) *(f32x4*)(out + m * D + 4 * lane + 256 * j) = v[j] * rinv * gg[j];
    }
    __syncthreads();
}
typedef short v4i16_t __attribute__((ext_vector_type(4)));
constexpr float LOG2E = 1.4426950408889634f;
__device__ __forceinline__ f32x16 mfma32(bf16x8 a, bf16x8 b, f32x16 c) { return __builtin_amdgcn_mfma_f32_32x32x16_bf16(a, b, c, 0, 0, 0); }
__device__ __forceinline__ v4i16_t tr_read(LAS unsigned char* p) { return __builtin_amdgcn_ds_read_tr16_b64_v4i16((LAS v4i16_t*)p); }
__device__ __forceinline__ bf16x8 cat8(v4i16_t a, v4i16_t b) { return (bf16x8){a[0], a[1], a[2], a[3], b[0], b[1], b[2], b[3]}; }
__device__ __forceinline__ unsigned cvtpk(float lo, float hi) { const f32x2_t v = {lo, hi}; const bf16x2_t b = __builtin_convertvector(v, bf16x2_t); return __builtin_bit_cast(unsigned, b); }
__device__ __forceinline__ bf16x8 pack8(const f32x16& v, int s) {
    u32x4 w; w.x = cvtpk(v[8 * s + 0], v[8 * s + 1]); w.y = cvtpk(v[8 * s + 2], v[8 * s + 3]); w.z = cvtpk(v[8 * s + 4], v[8 * s + 5]); w.w = cvtpk(v[8 * s + 6], v[8 * s + 7]);
    return __builtin_bit_cast(bf16x8, w);
}
__device__ __forceinline__ unsigned xor32_u(unsigned x) { const auto r = __builtin_amdgcn_permlane32_swap(x, x, false, false); return (threadIdx.x & 32) ? r[0] : r[1]; }
__device__ __forceinline__ float sum32(float x) { const auto r = __builtin_amdgcn_permlane32_swap(__float_as_uint(x), __float_as_uint(x), false, false); return __uint_as_float(r[0]) + __uint_as_float(r[1]); }
__device__ __forceinline__ float max32(float x) { const auto r = __builtin_amdgcn_permlane32_swap(__float_as_uint(x), __float_as_uint(x), false, false); return fmaxf(__uint_as_float(r[0]), __uint_as_float(r[1])); }
__device__ __forceinline__ float lo_bf(unsigned w) { return __uint_as_float(w << 16); }
__device__ __forceinline__ float hi_bf(unsigned w) { return __uint_as_float(w & 0xffff0000u); }
__device__ __forceinline__ int off256(int row, int ch) { return 256 * row + 16 * (ch ^ (((row & 3) << 2) | ((row >> 2) & 3))); }
__device__ __forceinline__ int off128(int row, int c) { return 128 * row + 16 * (c ^ ((row >> 1) & 7)); }

__device__ __forceinline__ void swa_unit(LAS unsigned char* lds, const bf16* proj, const float* rtab, const float* sinks, bf16* o, int unit, int tid, int lane, int wave) {
    const int b = unit >> 5, kh = (unit >> 4) & 1, qb = unit & 15;
    LAS unsigned char* Ks = lds; LAS unsigned char* Vs = lds + 32768;
    const int g = wave >> 1, qhf = wave & 1, qh = kh * 4 + g;
    const int l31 = lane & 31, h = lane >> 5, i16 = lane & 15, g16 = (lane >> 4) & 1, tq = i16 >> 2, tp = i16 & 3;
    bf16x8 qfa[2][4]; f32x4 qrt[2][4];
#pragma unroll
    for (int qs = 0; qs < 2; ++qs) { const size_t m = (size_t)b * SEQ + qb * 128 + 64 * qhf + 32 * qs + l31; const bf16* qp = proj + m * PW + C_SQ + qh * 64 + 8 * h;
#pragma unroll
        for (int s = 0; s < 4; ++s) qfa[qs][s] = *(const bf16x8*)(qp + 16 * s);
#pragma unroll
        for (int s = 0; s < 4; ++s) qrt[qs][s] = *(const f32x4*)(rtab + m * 16 + 4 * s); }
    {
        const int key = tid >> 1, half = tid & 1;
        const int jpos = (qb - 1) * 128 + key; const bool valid = jpos >= 0;
        const size_t m = (size_t)b * SEQ + (valid ? jpos : 0);
        const bf16* kp = proj + m * PW + C_SK + kh * 64 + half * 32; const bf16* vp = proj + m * PW + C_SV + kh * 64 + half * 32;
        u32x4 kc[4], vc[4];
#pragma unroll
        for (int c = 0; c < 4; ++c) { kc[c] = *(const u32x4*)(kp + 8 * c); vc[c] = *(const u32x4*)(vp + 8 * c); }
        if (half == 0) {
            const f32x4 c0 = *(const f32x4*)(rtab + m * 16), c1 = *(const f32x4*)(rtab + m * 16 + 4), s0 = *(const f32x4*)(rtab + m * 16 + 8), s1 = *(const f32x4*)(rtab + m * 16 + 12);
            const float cs[8] = {c0.x, c0.y, c0.z, c0.w, c1.x, c1.y, c1.z, c1.w}, sn[8] = {s0.x, s0.y, s0.z, s0.w, s1.x, s1.y, s1.z, s1.w};
#pragma unroll
            for (int w = 0; w < 4; ++w) {
                const float a0 = lo_bf(kc[0][w]), a1 = hi_bf(kc[0][w]), b0 = lo_bf(kc[1][w]), b1 = hi_bf(kc[1][w]);
                kc[0][w] = cvtpk(a0 * cs[2 * w] - b0 * sn[2 * w], a1 * cs[2 * w + 1] - b1 * sn[2 * w + 1]);
                kc[1][w] = cvtpk(b0 * cs[2 * w] + a0 * sn[2 * w], b1 * cs[2 * w + 1] + a1 * sn[2 * w + 1]);
            }
        }
        if (!valid) {
#pragma unroll
            for (int c = 0; c < 4; ++c) { kc[c] = (u32x4){0u, 0u, 0u, 0u}; vc[c] = (u32x4){0u, 0u, 0u, 0u}; }
        }
        const int vsw = (key >> 1) & 1;
#pragma unroll
        for (int c = 0; c < 4; ++c) { const int cc = 4 * half + c;
            *(LAS u32x4*)(Ks + off128(key, cc)) = kc[c];
            *(LAS u32x4*)(Vs + key * 128 + (((cc >> 2) ^ vsw) * 64) + (cc & 3) * 16) = vc[c]; }
    }
#pragma unroll
    for (int qs = 0; qs < 2; ++qs) {
        const f32x4 c0 = qrt[qs][0], c1 = qrt[qs][1], s0 = qrt[qs][2], s1 = qrt[qs][3];
        const float cs[8] = {c0.x, c0.y, c0.z, c0.w, c1.x, c1.y, c1.z, c1.w}, sn[8] = {s0.x, s0.y, s0.z, s0.w, s1.x, s1.y, s1.z, s1.w};
        u32x4 own = __builtin_bit_cast(u32x4, qfa[qs][0]), res;
#pragma unroll
        for (int w = 0; w < 4; ++w) { const unsigned pw = xor32_u(own[w]);
            const float o0 = lo_bf(own[w]), o1 = hi_bf(own[w]), p0 = lo_bf(pw), p1 = hi_bf(pw);
            const float sg = h ? 1.f : -1.f;
            res[w] = cvtpk(o0 * cs[2 * w] + sg * p0 * sn[2 * w], o1 * cs[2 * w + 1] + sg * p1 * sn[2 * w + 1]); }
        qfa[qs][0] = __builtin_bit_cast(bf16x8, res);
    }
    __syncthreads();
    const float sink2 = sinks[qh] * LOG2E, sc = 0.125f * LOG2E;
    const int vbase = (4 * h + tq) * 128 + 32 * g16 + 8 * tp;
#pragma unroll 1
    for (int qs = 0; qs < 2; ++qs) {
        const int q0 = 64 * qhf + 32 * qs;
        const size_t m = (size_t)b * SEQ + qb * 128 + q0 + l31;
        bf16x8 qf[4];
#pragma unroll
        for (int s = 0; s < 4; ++s) qf[s] = qs ? qfa[1][s] : qfa[0][s];
        const int kt0 = q0 >> 5;
        f32x16 st[5];
#pragma unroll
        for (int i = 0; i < 5; ++i) {
            f32x16 acc;
#pragma unroll
            for (int r = 0; r < 16; ++r) acc[r] = 0.f;
            const int row = 32 * (kt0 + i) + l31;
#pragma unroll
            for (int s = 0; s < 4; ++s) { const bf16x8 kf = *(const LAS bf16x8*)(Ks + off128(row, 2 * s + h)); acc = mfma32(kf, qf[s], acc); }
            st[i] = acc;
        }
        float mx = sink2;
#pragma unroll
        for (int i = 0; i < 5; ++i)
#pragma unroll
            for (int r = 0; r < 16; ++r) { const int krow = (r & 3) + 8 * (r >> 2) + 4 * h; const int dj = 32 * i + krow - l31;
                bool ok = (dj > 0) && (dj <= 128); if (qb == 0) ok = ok && (q0 + 32 * i + krow >= 128);
                const float x = ok ? st[i][r] * sc : -1e30f; st[i][r] = x; mx = fmaxf(mx, x); }
        mx = max32(mx);
        float l = 0.f;
#pragma unroll
        for (int i = 0; i < 5; ++i)
#pragma unroll
            for (int r = 0; r < 16; ++r) { const float p = __builtin_amdgcn_exp2f(st[i][r] - mx); st[i][r] = p; l += p; }
        l = sum32(l); l += __builtin_amdgcn_exp2f(sink2 - mx);
        f32x16 ot[2];
#pragma unroll
        for (int r = 0; r < 16; ++r) { ot[0][r] = 0.f; ot[1][r] = 0.f; }
#pragma unroll
        for (int i = 0; i < 5; ++i)
#pragma unroll
            for (int s2 = 0; s2 < 2; ++s2) { const bf16x8 pf = pack8(st[i], s2);
                LAS unsigned char* vb = Vs + (32 * (kt0 + i) + 16 * s2) * 128 + vbase;
#pragma unroll
                for (int dt = 0; dt < 2; ++dt) { const int xo = (dt ^ (tq >> 1)) * 64;
                    const bf16x8 vf = cat8(tr_read(vb + xo), tr_read(vb + 8 * 128 + xo));
                    ot[dt] = mfma32(vf, pf, ot[dt]); } }
        const float inv = __builtin_amdgcn_rcpf(l);
        bf16* op = o + m * D + 512 + qh * 64 + 4 * h;
#pragma unroll
        for (int dt = 0; dt < 2; ++dt)
#pragma unroll
            for (int gq = 0; gq < 4; ++gq) { u32x2 w; w.x = cvtpk(ot[dt][4 * gq] * inv, ot[dt][4 * gq + 1] * inv); w.y = cvtpk(ot[dt][4 * gq + 2] * inv, ot[dt][4 * gq + 3] * inv);
                *(u32x2*)(op + dt * 32 + 8 * gq) = w; }
    }
    __syncthreads();
}

constexpr int GLA_CH = 32768, GLA_QD = 16384, GLA_KD = 24576, GLA_K2T = 131072  , GLA_SEG = 147456  , GLA_DECL = 151552  , GLA_DECP = 152064, GLA_S = 131072, GLA_SSQ = 153088;
__device__ __forceinline__ float logsig16(float z) { return (fminf(z, 0.f) - __logf(1.f + __expf(-fabsf(z)))) * (1.f / 16.f); }
struct GlaRaw { bf16 la[2][8], qv[2][8], kv[2][8]; u32x4 v[2][2]; };
__device__ __forceinline__ void gla_kv_load(GlaRaw& r, const bf16* proj, int bh, int g, int jp, int tid) {
    const int b = bh >> 2, hd = bh & 3, d = tid & 63, seg = tid >> 6;
#pragma unroll
    for (int c2 = 0; c2 < 2; ++c2) { const size_t m0 = (size_t)b * SEQ + (4 * g + 2 * jp + c2) * 64;
#pragma unroll
        for (int i = 0; i < 8; ++i) { const size_t mr = (m0 + seg * 8 + i) * PW; r.la[c2][i] = proj[mr + C_Z + hd * 64 + d]; r.qv[c2][i] = proj[mr + C_GQ + hd * 64 + d]; r.kv[c2][i] = proj[mr + C_GK + hd * 64 + d]; }
#pragma unroll
        for (int i = 0; i < 2; ++i) { const int idx = tid + NTHR * i; r.v[c2][i] = *(const u32x4*)(proj + (m0 + (idx >> 4)) * PW + C_GV + hd * 128 + (idx & 15) * 8); } }
}
__device__ __forceinline__ void gla_kv_group(LAS unsigned char* lds, const bf16* proj, const float* b_a2, bf16* KV, bf16* KVG, float* DECG, int bh, int g, int tid, int lane, int wave, const GlaRaw& r0) {
    const int b = bh >> 2, hd = bh & 3;
    LAS float* decP = (LAS float*)(lds + GLA_DECP);
    const int et = wave >> 1, dt = wave & 1, l31 = lane & 31, hh = lane >> 5, i16 = lane & 15, g16 = (lane >> 4) & 1, tq = i16 >> 2, tp = i16 & 3;
    const int d = tid & 63, seg = tid >> 6;
    const float zb = b_a2[hd * 64 + d];
    f32x16 grp; float gdec = 1.f;
#pragma unroll
    for (int r = 0; r < 16; ++r) grp[r] = 0.f;
    GlaRaw r1; gla_kv_load(r1, proj, bh, g, 1, tid);
#pragma unroll
    for (int jp = 0; jp < 2; ++jp) {
        float la[2][8], qv[2][8], kv[2][8]; u32x4 vld[2][2];
#pragma unroll
        for (int c2 = 0; c2 < 2; ++c2) {
#pragma unroll
            for (int i = 0; i < 8; ++i) { la[c2][i] = bf2f(jp ? r1.la[c2][i] : r0.la[c2][i]); qv[c2][i] = bf2f(jp ? r1.qv[c2][i] : r0.qv[c2][i]) * 0.125f; kv[c2][i] = bf2f(jp ? r1.kv[c2][i] : r0.kv[c2][i]); }
#pragma unroll
            for (int i = 0; i < 2; ++i) vld[c2][i] = jp ? r1.v[c2][i] : r0.v[c2][i]; }
#pragma unroll
        for (int c2 = 0; c2 < 2; ++c2) { LAS float* segtot = (LAS float*)(lds + GLA_SEG + 2048 * c2);
#pragma unroll
            for (int i = 0; i < 8; ++i) la[c2][i] = logsig16(la[c2][i] + zb);
#pragma unroll
            for (int i = 1; i < 8; ++i) la[c2][i] += la[c2][i - 1];
            segtot[seg * 64 + d] = la[c2][7]; }
        __syncthreads();
#pragma unroll
        for (int c2 = 0; c2 < 2; ++c2) { const int jn = 2 * jp + c2;
            LAS unsigned char* vS = lds + GLA_CH * jn; LAS unsigned char* qdS = vS + GLA_QD; LAS unsigned char* kdS = vS + GLA_KD;
            LAS unsigned char* k2T = lds + GLA_K2T + 8192 * c2; LAS float* segtot = (LAS float*)(lds + GLA_SEG + 2048 * c2); LAS float* decL = (LAS float*)(lds + GLA_DECL + 256 * c2);
            float pre = 0.f, tot = 0.f;
#pragma unroll
            for (int s = 0; s < 8; ++s) { const float v = segtot[s * 64 + d]; tot += v; pre += (s < seg) ? v : 0.f; }
            u32x4 w; float e[8]; const float etot = __expf(tot);
#pragma unroll
            for (int i = 0; i < 8; ++i) { const int t = seg * 8 + i; const float bb = pre + la[c2][i]; const float en = __expf(-bb);
                e[i] = kv[c2][i] * en * etot;
                *(LAS bf16*)(qdS + off128(t, d >> 3) + (d & 7) * 2) = (bf16)f2bf(qv[c2][i] * __expf(bb));
                *(LAS bf16*)(kdS + off128(t, d >> 3) + (d & 7) * 2) = (bf16)f2bf(kv[c2][i] * en); }
            w.x = cvtpk(e[0], e[1]); w.y = cvtpk(e[2], e[3]); w.z = cvtpk(e[4], e[5]); w.w = cvtpk(e[6], e[7]);
            *(LAS u32x4*)(k2T + off128(d, seg)) = w;
            if (seg == 0) { decL[d] = etot; decP[jn * 64 + d] = etot; }
#pragma unroll
            for (int i = 0; i < 2; ++i) { const int idx = tid + NTHR * i; *(LAS u32x4*)(vS + off256(idx >> 4, idx & 15)) = vld[c2][i]; } }
        __syncthreads();
#pragma unroll
        for (int c2 = 0; c2 < 2; ++c2) { const int jn = 2 * jp + c2; const size_t unit = (size_t)(bh * 32 + 4 * g + jn);
            LAS unsigned char* vS = lds + GLA_CH * jn; LAS unsigned char* k2T = lds + GLA_K2T + 8192 * c2; LAS float* decL = (LAS float*)(lds + GLA_DECL + 256 * c2);
            f32x16 acc;
#pragma unroll
            for (int r = 0; r < 16; ++r) acc[r] = 0.f;
#pragma unroll
            for (int kk = 0; kk < 4; ++kk) {
                const int kb = 16 * kk + 8 * hh;
                const int ch = et * 4 + 2 * g16 + (tp >> 1);
                const bf16x8 af = cat8(tr_read(vS + off256(kb + tq, ch) + 8 * (tp & 1)), tr_read(vS + off256(kb + 4 + tq, ch) + 8 * (tp & 1)));
                const bf16x8 bfr = *(const LAS bf16x8*)(k2T + off128(dt * 32 + l31, 2 * kk + hh));
                acc = mfma32(af, bfr, acc);
            }
            const float dcl = decL[dt * 32 + l31];
            __builtin_amdgcn_sched_barrier(0);
            asm volatile("s_nop 15\n\ts_nop 15" ::: "memory");
            __builtin_amdgcn_sched_barrier(0);
            if (jn < 3 || g < 7) {
                bf16* sp = KV + unit * 8192 + (dt * 32 + l31) * 128 + et * 32 + 4 * hh;
#pragma unroll
                for (int gq = 0; gq < 4; ++gq) { u32x2 w; w.x = cvtpk(acc[4 * gq], acc[4 * gq + 1]); w.y = cvtpk(acc[4 * gq + 2], acc[4 * gq + 3]); *(u32x2*)(sp + 8 * gq) = w; }
            }
#pragma unroll
            for (int r = 0; r < 16; ++r) grp[r] = dcl * grp[r] + acc[r];
            gdec *= dcl; }
        __syncthreads();
    }
    {
        bf16* sp = KVG + (size_t)(bh * 8 + g) * 8192 + (dt * 32 + l31) * 128 + et * 32 + 4 * hh;
#pragma unroll
        for (int gq = 0; gq < 4; ++gq) { u32x2 w; w.x = cvtpk(grp[4 * gq], grp[4 * gq + 1]); w.y = cvtpk(grp[4 * gq + 2], grp[4 * gq + 3]); *(u32x2*)(sp + 8 * gq) = w; }
        if (et == 0 && hh == 0) DECG[(size_t)(bh * 8 + g) * 64 + dt * 32 + l31] = gdec;
    }
}

__device__ __forceinline__ void gla_out_block(LAS unsigned char* lds, const bf16* proj, const bf16* KV, const bf16* KVG, const float* DECG, const float* gn, bf16* o, int bh, int g, int tid, int lane, int wave) {
    const int b = bh >> 2, hd = bh & 3, n0 = 4 * g;
    LAS unsigned char* sS = lds + GLA_S; LAS float* ssq = (LAS float*)(lds + GLA_SSQ); LAS float* decP = (LAS float*)(lds + GLA_DECP);
    const int et = wave >> 1, tt = wave & 1, l31 = lane & 31, hh = lane >> 5, i16 = lane & 15, g16 = (lane >> 4) & 1, tq = i16 >> 2, tp = i16 & 3;
    const int srow = tid >> 4, sch = tid & 15;
    u32x4 kvn[2]; u32x2 gate[4];
#define GLA_LOAD(JN) do { const int n_ = n0 + (JN); const size_t m0_ = (size_t)b * SEQ + n_ * 64; const size_t unit_ = (size_t)(bh * 32 + n_); \
        _Pragma("unroll") for (int i = 0; i < 2; ++i) kvn[i] = ((JN) < 3) ? *(const u32x4*)(KV + unit_ * 8192 + (srow + 32 * i) * 128 + sch * 8) : (u32x4){0u, 0u, 0u, 0u}; \
        _Pragma("unroll") for (int gq = 0; gq < 4; ++gq) gate[gq] = *(const u32x2*)(proj + (m0_ + tt * 32 + l31) * PW + C_GG + hd * 128 + et * 32 + 8 * gq + 4 * hh); } while (0)
    GLA_LOAD(0);
    f32x4 gnv[4];
#pragma unroll
    for (int gq = 0; gq < 4; ++gq) gnv[gq] = *(const f32x4*)(gn + hd * 128 + et * 32 + 4 * hh + 8 * gq);
    float sst[2][8];
#pragma unroll
    for (int i = 0; i < 2; ++i)
#pragma unroll
        for (int j = 0; j < 8; ++j) sst[i][j] = 0.f;
    {
        u32x4 kvl[7][2]; float dcl[7][2];
#pragma unroll
        for (int m = 0; m < 7; ++m)
#pragma unroll
            for (int i = 0; i < 2; ++i) { const size_t u = (size_t)(bh * 8 + m);
                kvl[m][i] = (m < g) ? *(const u32x4*)(KVG + u * 8192 + (srow + 32 * i) * 128 + sch * 8) : (u32x4){0u, 0u, 0u, 0u};
                dcl[m][i] = (m < g) ? DECG[u * 64 + srow + 32 * i] : 1.f; }
#pragma unroll
        for (int m = 0; m < 7; ++m)
#pragma unroll
            for (int i = 0; i < 2; ++i)
#pragma unroll
                for (int w = 0; w < 4; ++w) { sst[i][2 * w] = dcl[m][i] * sst[i][2 * w] + lo_bf(kvl[m][i][w]); sst[i][2 * w + 1] = dcl[m][i] * sst[i][2 * w + 1] + hi_bf(kvl[m][i][w]); }
    }
#pragma unroll 1
    for (int jn = 0; jn < 4; ++jn) {
        const int n = n0 + jn;
        const size_t mt = (size_t)b * SEQ + n * 64 + tt * 32 + l31;
        LAS unsigned char* vS = lds + GLA_CH * jn; LAS unsigned char* qdS = vS + GLA_QD; LAS unsigned char* kdS = vS + GLA_KD;
#pragma unroll
        for (int i = 0; i < 2; ++i) { u32x4 sw; sw.x = cvtpk(sst[i][0], sst[i][1]); sw.y = cvtpk(sst[i][2], sst[i][3]); sw.z = cvtpk(sst[i][4], sst[i][5]); sw.w = cvtpk(sst[i][6], sst[i][7]);
            *(LAS u32x4*)(sS + off256(srow + 32 * i, sch)) = sw; }
        __syncthreads();
        if (jn < 3) {
#pragma unroll
            for (int i = 0; i < 2; ++i) { const float dc = decP[jn * 64 + srow + 32 * i];
#pragma unroll
                for (int w = 0; w < 4; ++w) { sst[i][2 * w] = dc * sst[i][2 * w] + lo_bf(kvn[i][w]); sst[i][2 * w + 1] = dc * sst[i][2 * w + 1] + hi_bf(kvn[i][w]); } }
        }
        u32x2 gcur[4];
#pragma unroll
        for (int gq = 0; gq < 4; ++gq) gcur[gq] = gate[gq];
        if (jn < 3) GLA_LOAD(jn + 1);
        bf16x8 qf[4];
#pragma unroll
        for (int kk = 0; kk < 4; ++kk) qf[kk] = *(const LAS bf16x8*)(qdS + off128(tt * 32 + l31, 2 * kk + hh));
        f32x16 ot;
#pragma unroll
        for (int r = 0; r < 16; ++r) ot[r] = 0.f;
        const int chv = et * 4 + 2 * g16 + (tp >> 1), sub = 8 * (tp & 1);
#pragma unroll
        for (int kk = 0; kk < 4; ++kk) { const int kb = 16 * kk + 8 * hh;
            const bf16x8 af = cat8(tr_read(sS + off256(kb + tq, chv) + sub), tr_read(sS + off256(kb + 4 + tq, chv) + sub));
            ot = mfma32(af, qf[kk], ot); }
#pragma unroll
        for (int st = 0; st < 2; ++st) {
            if (st <= tt) {
                f32x16 at;
#pragma unroll
                for (int r = 0; r < 16; ++r) at[r] = 0.f;
#pragma unroll
                for (int kk = 0; kk < 4; ++kk) { const bf16x8 kf = *(const LAS bf16x8*)(kdS + off128(st * 32 + l31, 2 * kk + hh)); at = mfma32(kf, qf[kk], at); }
                if (st == tt) {
#pragma unroll
                    for (int r = 0; r < 16; ++r) { const int sr = (r & 3) + 8 * (r >> 2) + 4 * hh; at[r] = (sr <= l31) ? at[r] : 0.f; }
                }
#pragma unroll
                for (int s2 = 0; s2 < 2; ++s2) { const bf16x8 pf = pack8(at, s2); const int kb = 32 * st + 16 * s2 + 4 * hh;
                    const bf16x8 vf = cat8(tr_read(vS + off256(kb + tq, chv) + sub), tr_read(vS + off256(kb + 8 + tq, chv) + sub));
                    ot = mfma32(vf, pf, ot); }
            }
        }
        float ss = 0.f;
#pragma unroll
        for (int r = 0; r < 16; ++r) ss += ot[r] * ot[r];
        ss = sum32(ss);
        if (hh == 0) ssq[et * 64 + tt * 32 + l31] = ss;
        __syncthreads();
        const int tl = tt * 32 + l31;
        const float rinv = rsqrtf(((ssq[tl] + ssq[64 + tl]) + (ssq[128 + tl] + ssq[192 + tl])) * (1.f / 128.f) + EPS);
        bf16* op = o + mt * D + hd * 128 + et * 32 + 4 * hh;
#pragma unroll
        for (int gq = 0; gq < 4; ++gq) { const f32x4 gg = gnv[gq];
            const float g0 = lo_bf(gcur[gq].x), g1 = hi_bf(gcur[gq].x), g2 = lo_bf(gcur[gq].y), g3 = hi_bf(gcur[gq].y);
            u32x2 w; w.x = cvtpk(ot[4 * gq] * rinv * gg.x * silu_f(g0), ot[4 * gq + 1] * rinv * gg.y * silu_f(g1)); w.y = cvtpk(ot[4 * gq + 2] * rinv * gg.z * silu_f(g2), ot[4 * gq + 3] * rinv * gg.w * silu_f(g3));
            *(u32x2*)(op + 8 * gq) = w; }
        __syncthreads();
    }
#undef GLA_LOAD
}
constexpr int NPH = 10;
__global__ void __launch_bounds__(NTHR, 2) mk_fwd(Args a) {
    extern __shared__ __attribute__((aligned(16))) unsigned char lds_raw[];
    LAS unsigned char* lds = (LAS unsigned char*)lds_raw;
    volatile LAS unsigned* MISC = (volatile LAS unsigned*)(lds + MISC_OFF);
    const int tid = threadIdx.x, lane = tid & 63, wave = __builtin_amdgcn_readfirstlane(tid >> 6), blk = blockIdx.x;
    if (tid < 128) MISC[tid] = 0u;
    __syncthreads();
    unsigned char* ws = a.ws;
    unsigned* ctl = (unsigned*)(ws + WS_CTL);
    const int lo = a.ph_lo, hi = a.ph_hi;
    XcdBarrier bar = xcd_barrier_post(ctl + CW_BAR + lo * XCD_BAR_WORDS, MISC);
#define IN(k) (lo <= (k) && (k) < hi)
#define SEAM(k) do { if (IN(k) && IN((k) + 1)) xcd_barrier(bar); } while (0)
    LAS int* tp = (LAS int*)(lds + 132096);

    if (IN(0)) {
        TrItem t0; f32x4 tv[8]; const int it0 = blk * NWAVES + wave; const bool h0 = it0 < 16 * 72 + 16 * 32 && tr_decode(it0, a, t0);
        if (h0) tr_load(t0, tv, lane);
        p0_adaln(lds, (const float*)a.in[1], (const float*)a.in[3], (const float*)a.in[4], (float*)(ws + WS_MODP), blk, tid);
        p0_weights(lds, a, blk, wave, lane, tid);
        if (h0) tr_finish(t0, tv, (LAS float*)(lds + 65536 + wave * 8704), lane);
    }
    f32x4 xa[4], xb[4];
    if (IN(1)) {
        const float* x = (const float*)a.in[0]; const size_t mb = (size_t)blk * 64 + wave;
#pragma unroll
        for (int j = 0; j < 4; ++j) { xa[j] = *(const f32x4*)(x + mb * D + 4 * lane + 256 * j); xb[j] = *(const f32x4*)(x + (mb + NWAVES) * D + 4 * lane + 256 * j); }
    }
    SEAM(0);
    if (IN(1)) p1a_rows(lds, a, blk, wave, lane, tid, xa, xb);
    SEAM(1);
    if (IN(2)) {
        pg8::DenseOrder S; S.init(ws + WS_H, ws + WS_WIN, M, PW, D, GRID, blk);
        pg8::EpiBf16 E{(bf16*)(ws + WS_PROJ), PW};
        constexpr int TG0 = 16 * 72 + 16 * 32, TG1 = TG0 + 32 * 2 * 128, TGM = TG0 + 32 * 128;
        if (blk >= 128) { tr_stream(lds, a, TG0, TGM, (blk - 128) * NWAVES + wave, 128 * NWAVES, wave, lane); __syncthreads(); }
        pg8::gemm_phase<pg8::EpiBf16, pg8::DenseOrder, true>(lds, D, S, E);
        if (blk >= 128) tr_stream(lds, a, TGM, TG1, (blk - 128) * NWAVES + wave, 128 * NWAVES, wave, lane);
    }
    SEAM(2);
    if (IN(3)) {
        const bf16* proj = (const bf16*)(ws + WS_PROJ); bf16* o = (bf16*)(ws + WS_O);
        GlaRaw r0; gla_kv_load(r0, proj, blk >> 3, blk & 7, 0, tid);
        swa_unit(lds, proj, (const float*)(ws + WS_ROPE), (const float*)a.in[10], o, blk, tid, lane, wave);
        gla_kv_group(lds, proj, (const float*)a.in[8], (bf16*)(ws + WS_SG), (bf16*)(ws + WS_KVG), (float*)(ws + WS_DECG), blk >> 3, blk & 7, tid, lane, wave, r0);
    }
    SEAM(3);
    if (IN(4)) {
        const bf16* proj = (const bf16*)(ws + WS_PROJ); bf16* o = (bf16*)(ws + WS_O);
        gla_out_block(lds, proj, (const bf16*)(ws + WS_SG), (const bf16*)(ws + WS_KVG), (const float*)(ws + WS_DECG), (const float*)a.in[9], o, blk >> 3, blk & 7, tid, lane, wave);
    }
    SEAM(4);
    if (IN(5)) {
        pg8::DenseOrder S; S.init(ws + WS_O, ws + WS_WOUT, M, D, D, GRID, blk);
        pg8::EpiX1 E{(const float*)a.in[0], (bf16*)(ws + WS_X1), (const float*)(ws + WS_MOD)};
        pg8::gemm_phase<pg8::EpiX1, pg8::DenseOrder, false>(lds, D, S, E);
    }
    RouteFrags rf;
    if (IN(6)) p3b_pre(lds, a, blk, wave, lane, tid, rf);
    SEAM(5);
    if (IN(6)) p3b_route(lds, a, blk, wave, lane, tid, rf);
    SEAM(6);
    if (IN(7)) {
        moe_prefix(tp, (const int*)ctl + CW_CNT, tid);
        pg8::MoeOrder<true> S; S.A = (const char*)(ws + WS_H); S.Bt = (const char*)(ws + WS_WGU); S.K = D; S.npn = 2; S.G = GRID; S.c = blk; S.bstride = (size_t)512 * D * 2;
        S.tp = tp; S.cnt = (const int*)ctl + CW_CNT; S.list = (const int*)(ws + WS_ROUTE);
        pg8::EpiAct E{(bf16*)(ws + WS_PROJ), (const int*)ctl + CW_CNT, (const float*)(ws + WS_ROUTE + 2 * MiB), tp};
        pg8::gemm_phase<pg8::EpiAct, pg8::MoeOrder<true>, true>(lds, D, S, E);
        if (blk >= 128) tr_stream(lds, a, 16 * 72 + 16 * 32 + 32 * 2 * 128, 16 * 72 + 16 * 32 + 32 * 2 * 128 + 32 * 128, (blk - 128) * NWAVES + wave, 128 * NWAVES, wave, lane);
    }
    SEAM(7);
    if (IN(8)) {
        moe_prefix(tp, (const int*)ctl + CW_CNT, tid);
        pg8::MoeOrder<false> S; S.A = (const char*)(ws + WS_PROJ); S.Bt = (const char*)(ws + WS_WD); S.K = 256; S.npn = 4; S.G = GRID; S.c = blk; S.bstride = (size_t)D * 256 * 2;
        S.tp = tp; S.cnt = (const int*)ctl + CW_CNT; S.list = (const int*)(ws + WS_ROUTE);
        pg8::EpiDown E{(bf16*)(ws + WS_Y2), (const int*)ctl + CW_CNT, (const int*)(ws + WS_ROUTE), tp};
        pg8::gemm_phase<pg8::EpiDown, pg8::MoeOrder<false>, true>(lds, 256, S, E);
    }
    SEAM(8);
    if (IN(9)) p6_final(lds, a, blk, wave, lane, tid);
#undef IN
#undef SEAM
}

extern "C" void kernel_launch(void* const* d_in, const int* in_sizes, int n_in, void* d_out, int out_size, void* d_ws, size_t ws_size, hipStream_t stream) {
    static int grid = 0;
    if (grid == 0) {
        if (n_in != 21 || in_sizes[0] != M * D || out_size != M * D || ws_size < WS_END) { fprintf(stderr, "kernel_launch: unexpected shapes (n_in %d, in0 %d, out %d, ws %zu)\n", n_in, n_in > 0 ? in_sizes[0] : -1, out_size, ws_size); grid = -1; return; }
        int dev = 0, cus = 0, per_cu = 0;
        if (hipGetDevice(&dev) != hipSuccess || hipDeviceGetAttribute(&cus, hipDeviceAttributeMultiprocessorCount, dev) != hipSuccess) { fprintf(stderr, "kernel_launch: device query failed\n"); grid = -1; return; }
        if (hipFuncSetAttribute((const void*)mk_fwd, hipFuncAttributeMaxDynamicSharedMemorySize, LDS_BYTES) != hipSuccess) { fprintf(stderr, "kernel_launch: hipFuncSetAttribute failed\n"); grid = -1; return; }
        if (hipOccupancyMaxActiveBlocksPerMultiprocessor(&per_cu, (const void*)mk_fwd, NTHR, LDS_BYTES) != hipSuccess || per_cu < 1) { fprintf(stderr, "kernel_launch: occupancy query says %d workgroups per CU\n", per_cu); grid = -1; return; }
        if (cus * per_cu < GRID) { fprintf(stderr, "kernel_launch: needs %d co-resident workgroups, device holds %d x %d\n", GRID, cus, per_cu); grid = -1; return; }
        grid = GRID;
    }
    if (grid < 0) return;
    (void)hipMemsetAsync((char*)d_ws + WS_CTL, 0, CTL_ZERO_BYTES, stream);
    Args a{};
    for (int i = 0; i < 21; ++i) a.in[i] = d_in[i];
    a.out = (float*)d_out; a.ws = (unsigned char*)d_ws;
    for (int i = 0; i < 8; ++i) a.rt.inv_freq[i] = (float)pow(500000.0, -(double)(2 * i) / 16.0);
    a.ph_lo = 0; a.ph_hi = NPH;
    void* args[] = {&a};
    const hipError_t e = hipLaunchCooperativeKernel((const void*)mk_fwd, dim3(GRID), dim3(NTHR), args, LDS_BYTES, stream);
    if (e != hipSuccess) fprintf(stderr, "kernel_launch: cooperative launch failed: %s\n", hipGetErrorString(e));
}
```

```cpp
#include <hip/hip_runtime.h>
#include <cstdio>
#include <cstdint>
#include <cmath>

typedef unsigned short bf16;
typedef float f32x4 __attribute__((ext_vector_type(4)));
typedef float f32x2 __attribute__((ext_vector_type(2)));
typedef float f32x16 __attribute__((ext_vector_type(16)));
typedef unsigned u32x4 __attribute__((ext_vector_type(4)));
typedef unsigned u32x2 __attribute__((ext_vector_type(2)));
typedef short bf16x8 __attribute__((ext_vector_type(8)));
#define GAS __attribute__((address_space(1)))
#define LAS __attribute__((address_space(3)))

__device__ __forceinline__ float bf2f(bf16 v) { return __uint_as_float(((unsigned)v) << 16); }
__device__ __forceinline__ unsigned f2bf(float f) { unsigned u = __float_as_uint(f); return (u + 0x7fffu + ((u >> 16) & 1u)) >> 16; }
typedef float f32x2_t __attribute__((ext_vector_type(2))); typedef __bf16 bf16x2_t __attribute__((ext_vector_type(2)));
__device__ __forceinline__ unsigned pk2(float lo, float hi) { const f32x2_t v = {lo, hi}; const bf16x2_t b = __builtin_convertvector(v, bf16x2_t); return __builtin_bit_cast(unsigned, b); }
__device__ __forceinline__ float lo_bf16(unsigned w) { return __uint_as_float(w << 16); }
__device__ __forceinline__ float hi_bf16(unsigned w) { return __uint_as_float(w & 0xffff0000u); }
__device__ __forceinline__ float silu_f(float v) { return v * __builtin_amdgcn_rcpf(1.f + __expf(-v)); }
template <int CTRL> __device__ __forceinline__ float dpp_mov(float v) { return __int_as_float(__builtin_amdgcn_update_dpp(0, __float_as_int(v), CTRL, 0xF, 0xF, true)); }
__device__ __forceinline__ float wave_sum(float v) {
    v += dpp_mov<0xB1>(v); v += dpp_mov<0x4E>(v); v += dpp_mov<0x141>(v); v += dpp_mov<0x140>(v);
    const float r0 = __int_as_float(__builtin_amdgcn_readlane(__float_as_int(v), 0)), r1 = __int_as_float(__builtin_amdgcn_readlane(__float_as_int(v), 16));
    const float r2 = __int_as_float(__builtin_amdgcn_readlane(__float_as_int(v), 32)), r3 = __int_as_float(__builtin_amdgcn_readlane(__float_as_int(v), 48));
    return (r0 + r1) + (r2 + r3);
}

constexpr int NB = 8, SEQ = 2048, D = 1024, M = NB * SEQ;
constexpr int PW = 2560;
constexpr int C_GQ = 0, C_GK = 256, C_GV = 512, C_GG = 1024, C_SQ = 1536, C_SK = 2048, C_SV = 2176, C_Z = 2304;
constexpr int INW = 2320;
constexpr float EPS = 1e-6f;
constexpr int NEXP = 32, LCAP = 16384;
constexpr int NWAVES = 8, NTHR = 512, GRID = 256;

constexpr size_t MiB = 1u << 20;
constexpr size_t WS_CTL = 0, CTL_ZERO_BYTES = 256 * 1024;
constexpr int CW_CNT = 0, CNT_STRIDE = 64, CW_BAR = 4096;
constexpr size_t WS_MODP = 1 * MiB;
constexpr size_t WS_MOD = 2 * MiB + 512 * 1024;
constexpr size_t WS_ROPE = 3 * MiB;
constexpr size_t WS_WIN = 4 * MiB;
constexpr size_t WS_WOUT = 10 * MiB;
constexpr size_t WS_WGU = 12 * MiB;
constexpr size_t WS_WD = 44 * MiB;
constexpr size_t WS_ROUTE = 60 * MiB;
constexpr size_t WS_H = 64 * MiB;
constexpr size_t WS_SG = 208 * MiB;
constexpr size_t WS_O = 96 * MiB;
constexpr size_t WS_PROJ = 128 * MiB;
constexpr size_t WS_X1 = 160 * MiB;
constexpr size_t WS_Y2 = 64 * MiB;
constexpr size_t WS_DEC = 224 * MiB;
constexpr size_t WS_KVG = 225 * MiB;
constexpr size_t WS_DECG = 229 * MiB;
constexpr size_t WS_WRB = 230 * MiB;
constexpr size_t WS_END = 231 * MiB;

constexpr int LDS_BYTES = 163840;
constexpr int MISC_OFF = LDS_BYTES - 512;
namespace pg8 {
#define PG8_LAS __attribute__((address_space(3)))
constexpr int BM = 256, BK = 64, HALF = 128, HTB = HALF * BK * 2  , STAGE_BYTES = 8 * HTB, NXCD = 8, WGM = 8;

__host__ __device__ __forceinline__ int lds_byte(int r, int c) { const int st = (r >> 4) * 2 + (c >> 5), rr = r & 15, cc = c & 31, ob = rr * 64 + cc * 2; return st * 1024 + (ob ^ (((ob >> 9) & 1) << 5)); }
__host__ __device__ __forceinline__ void stage_rc(int b, int& R, int& C) { const int st = b / 1024, sb = b % 1024, swz = sb ^ (((sb >> 9) & 1) << 5); R = (st >> 1) * 16 + swz / 64; C = (st & 1) * 32 + (swz % 64) / 2; }
__host__ __device__ __forceinline__ int perm32(int rho) { const int n = rho >> 4, i = rho & 15; return 8 * (i >> 2) + 4 * n + (i & 3); }

struct Unit { const char* A; const char* B; int i0, i1, i2, qm; };

__device__ __forceinline__ int xcd_remap(int wgid, int nwg) { const int q = nwg / NXCD, r = nwg % NXCD, xcd = wgid % NXCD, off = wgid / NXCD; return (xcd < r ? xcd * (q + 1) : r * (q + 1) + (xcd - r) * q) + off; }

struct DenseOrder {
    const char* A; const char* Bt; int K, nM, nN, nwg, G, c;
    __device__ void init(const void* A_, const void* Bt_, int M, int N, int K_, int G_, int c_) { A = (const char*)A_; Bt = (const char*)Bt_; K = K_; nM = M / BM; nN = N / BM; nwg = nM * nN; G = G_; c = c_; }
    __device__ __forceinline__ bool next(int i, Unit& u) const {
        const int L = i * G + c; if (L >= nwg) return false;
        const int wgid = xcd_remap(L, nwg);
        const int nig = WGM * nN, gid = wgid / nig, fm = gid * WGM, gsz = (nM - fm) < WGM ? (nM - fm) : WGM;
        const int pm = fm + ((wgid % nig) % gsz), pn = (wgid % nig) / gsz;
        u.A = A + (size_t)pm * BM * K * 2; u.B = Bt + (size_t)pn * BM * K * 2; u.i0 = pm; u.i1 = pn; u.i2 = 0; u.qm = 15; return true;
    }
    __device__ __forceinline__ void a_voff(const Unit&, const int (&R)[2], const int (&C)[2], unsigned (&v)[2][2]) const {
#pragma unroll
        for (int h = 0; h < 2; ++h)
#pragma unroll
            for (int i = 0; i < 2; ++i) v[h][i] = (unsigned)((h * HALF + R[i]) * K + C[i]) * 2u;
    }
};

template <bool GATHER> struct MoeOrder {
    const char* A; const char* Bt; int K, npn, G, c; size_t bstride; const PG8_LAS int* tp; const int* cnt; const int* list;
    __device__ __forceinline__ bool next(int i, Unit& u) const {
        const int ntile = tp[32], nwg = ntile * npn, nfr = nwg / G, nfull = nfr * G, R = nwg - nfull, f = (4 * R <= G) ? 4 : (2 * R <= G) ? 2 : 1;
        int L, qm;
        if (i < nfr) { L = i * G + c; qm = 15; }
        else { if (i > nfr) return false;
            const int P = (f * R + 7) >> 3, x = c & 7, y = c >> 3, j = x * P + y;
            if (y >= P || j >= f * R) return false; L = nfull + j / f; qm = f == 4 ? (1 << (j & 3)) : f == 2 ? ((j & 1) ? 10 : 5) : 15; }
        u.qm = __builtin_amdgcn_readfirstlane(qm);
        const int wgid = xcd_remap(L, nwg); const int T = wgid / npn, pn = wgid % npn;
        const int e = tp[40 + T];
        u.i0 = e; u.i1 = T - tp[e]; u.i2 = pn;
        u.A = GATHER ? A : A + (size_t)T * BM * K * 2; u.B = Bt + (size_t)e * bstride + (size_t)pn * BM * K * 2; return true;
    }
    __device__ __forceinline__ void a_voff(const Unit& u, const int (&R)[2], const int (&C)[2], unsigned (&v)[2][2]) const {
        if (GATHER) {
            const int n = tp[208 + u.i0]; int tk[2][2];
#pragma unroll
            for (int h = 0; h < 2; ++h)
#pragma unroll
                for (int i = 0; i < 2; ++i) { const int r = u.i1 * BM + h * HALF + R[i]; tk[h][i] = (r < n) ? list[u.i0 * 16384 + r] : 0; }
            asm volatile("s_waitcnt vmcnt(0)" ::: "memory");
#pragma unroll
            for (int h = 0; h < 2; ++h)
#pragma unroll
                for (int i = 0; i < 2; ++i) v[h][i] = (unsigned)((tk[h][i] >> 1) * K + C[i]) * 2u;
            asm volatile("" : "+v"(v[0][0]), "+v"(v[0][1]), "+v"(v[1][0]), "+v"(v[1][1]));
        } else {
#pragma unroll
            for (int h = 0; h < 2; ++h)
#pragma unroll
                for (int i = 0; i < 2; ++i) v[h][i] = (unsigned)((h * HALF + R[i]) * K + C[i]) * 2u;
        }
    }
};

__device__ __forceinline__ unsigned cvt_pk_bf16(float lo, float hi) { unsigned r; asm volatile("v_cvt_pk_bf16_f32 %0, %1, %2" : "=v"(r) : "v"(lo), "v"(hi)); return r; }

struct EpiBf16 {
    static constexpr bool PERM = true;
    bf16* O; int ldc;
    __device__ __forceinline__ void operator()(const f32x4 (&acc)[2][2][4][2], const Unit& u, int wr, int wc, int fr, int fq) const {
        const int row0 = u.i0 * BM + wr * 64 + fr; const int col0 = u.i1 * BM + wc * 32 + 8 * fq;
#pragma unroll
        for (int ai = 0; ai < 2; ++ai)
#pragma unroll
            for (int m = 0; m < 4; ++m) { bf16* rowp = O + (size_t)(row0 + ai * HALF + m * 16) * ldc + col0;
#pragma unroll
                for (int bj = 0; bj < 2; ++bj) { const f32x4 v0 = acc[ai][bj][m][0], v1 = acc[ai][bj][m][1];
                    u32x4 w; w.x = cvt_pk_bf16(v0[0], v0[1]); w.y = cvt_pk_bf16(v0[2], v0[3]); w.z = cvt_pk_bf16(v1[0], v1[1]); w.w = cvt_pk_bf16(v1[2], v1[3]);
                    *(u32x4*)(rowp + bj * HALF) = w; } }
    }
};

struct EpiX1 {
    static constexpr bool PERM = true;
    const float* x; bf16* out; const float* mod;
    __device__ __forceinline__ void operator()(const f32x4 (&acc)[2][2][4][2], const Unit& u, int wr, int wc, int fr, int fq) const {
        const int row0 = u.i0 * BM + wr * 64 + fr; const int col0 = u.i1 * BM + wc * 32 + 8 * fq;
        const float* gt = mod + (u.i0 >> 3) * 6144 + 2048;
        f32x4 gv[2][2];
#pragma unroll
        for (int bj = 0; bj < 2; ++bj)
#pragma unroll
            for (int n = 0; n < 2; ++n) gv[bj][n] = *(const f32x4*)(gt + col0 + bj * HALF + 4 * n);
#pragma unroll
        for (int ai = 0; ai < 2; ++ai) {
            f32x4 xv[4][2][2];
#pragma unroll
            for (int m = 0; m < 4; ++m) { const size_t off = (size_t)(row0 + ai * HALF + m * 16) * 1024 + col0;
#pragma unroll
                for (int bj = 0; bj < 2; ++bj) { xv[m][bj][0] = *(const f32x4*)(x + off + bj * HALF); xv[m][bj][1] = *(const f32x4*)(x + off + bj * HALF + 4); } }
            asm volatile("" ::: "memory");
#pragma unroll
            for (int m = 0; m < 4; ++m) { const size_t off = (size_t)(row0 + ai * HALF + m * 16) * 1024 + col0;
#pragma unroll
                for (int bj = 0; bj < 2; ++bj) { const f32x4 v0 = xv[m][bj][0] + gv[bj][0] * acc[ai][bj][m][0], v1 = xv[m][bj][1] + gv[bj][1] * acc[ai][bj][m][1];
                    u32x4 w; w.x = cvt_pk_bf16(v0[0], v0[1]); w.y = cvt_pk_bf16(v0[2], v0[3]); w.z = cvt_pk_bf16(v1[0], v1[1]); w.w = cvt_pk_bf16(v1[2], v1[3]);
                    *(u32x4*)(out + off + bj * HALF) = w; } }
        }
    }
};

struct EpiAct {
    static constexpr bool PERM = false;
    bf16* act; const int* cnt; const float* lw; const PG8_LAS int* tp;
    __device__ __forceinline__ void operator()(const f32x4 (&acc)[2][2][4][2], const Unit& u, int wr, int wc, int fr, int fq) const {
        const int e = u.i0, n_e = tp[208 + e]; const int rl0 = u.i1 * BM + wr * 64 + fr; const size_t rbase = (size_t)(tp[e] + u.i1) * BM + wr * 64 + fr;
        const int f0 = u.i2 * 128 + wc * 16 + 4 * fq;
        float wrow[2][4];
#pragma unroll
        for (int ai = 0; ai < 2; ++ai)
#pragma unroll
            for (int m = 0; m < 4; ++m) { const int rl = rl0 + ai * HALF + m * 16; wrow[ai][m] = (rl < n_e) ? lw[e * 16384 + rl] : 0.f; }
        asm volatile("" ::: "memory");
#pragma unroll
        for (int ai = 0; ai < 2; ++ai)
#pragma unroll
            for (int m = 0; m < 4; ++m) { const int rl = rl0 + ai * HALF + m * 16;
                if (rl < n_e) { const float w = wrow[ai][m]; bf16* rowp = act + (rbase + ai * HALF + m * 16) * 256 + f0;
#pragma unroll
                    for (int bj = 0; bj < 2; ++bj) if ((u.qm >> (2 * ai + bj)) & 1) { const f32x4 g = acc[ai][bj][m][0], up = acc[ai][bj][m][1]; u32x2 o;
                        o.x = cvt_pk_bf16(silu_f(g[0]) * up[0] * w, silu_f(g[1]) * up[1] * w); o.y = cvt_pk_bf16(silu_f(g[2]) * up[2] * w, silu_f(g[3]) * up[3] * w);
                        *(u32x2*)(rowp + bj * 64) = o; } } }
    }
};

struct EpiDown {
    static constexpr bool PERM = true;
    bf16* y2; const int* cnt; const int* list; const PG8_LAS int* tp;
    __device__ __forceinline__ void operator()(const f32x4 (&acc)[2][2][4][2], const Unit& u, int wr, int wc, int fr, int fq) const {
        const int e = u.i0, n_e = tp[208 + e]; const int rl0 = u.i1 * BM + wr * 64 + fr; const int col0 = u.i2 * BM + wc * 32 + 8 * fq;
        int tkr[2][4];
#pragma unroll
        for (int ai = 0; ai < 2; ++ai)
#pragma unroll
            for (int m = 0; m < 4; ++m) { const int rl = rl0 + ai * HALF + m * 16; tkr[ai][m] = (rl < n_e) ? list[e * 16384 + rl] : -1; }
        asm volatile("" ::: "memory");
#pragma unroll
        for (int ai = 0; ai < 2; ++ai)
#pragma unroll
            for (int m = 0; m < 4; ++m) { const int tk = tkr[ai][m];
                if (tk >= 0) { bf16* rowp = y2 + (size_t)tk * 1024 + col0;
#pragma unroll
                    for (int bj = 0; bj < 2; ++bj) if ((u.qm >> (2 * ai + bj)) & 1) { const f32x4 v0 = acc[ai][bj][m][0], v1 = acc[ai][bj][m][1];
                        u32x4 w; w.x = cvt_pk_bf16(v0[0], v0[1]); w.y = cvt_pk_bf16(v0[2], v0[3]); w.z = cvt_pk_bf16(v1[0], v1[1]); w.w = cvt_pk_bf16(v1[2], v1[3]);
                        *(u32x4*)(rowp + bj * HALF) = w; } } }
    }
};

template <class Epi, class Sched, bool ALIGN_EPI>
__device__ __forceinline__ void gemm_phase(PG8_LAS unsigned char* lds, const int K, const Sched& S, const Epi& E) {
    const int tid = threadIdx.x, wid = __builtin_amdgcn_readfirstlane(tid >> 6), lane = tid & 63, wr = wid >> 2, wc = wid & 3, fr = lane & 15, fq = lane >> 4;
    const int nt = K / BK;
    int Rr[2], Cc[2]; unsigned voffB[2];
#pragma unroll
    for (int i = 0; i < 2; ++i) { int R, C; stage_rc(tid * 16 + i * 8192, R, C); Rr[i] = R; Cc[i] = C; const int Rb = Epi::PERM ? ((R & ~31) + perm32(R & 31)) : R; voffB[i] = (unsigned)(Rb * K + C) * 2u; }
    const size_t kstep = (size_t)(BK * 2);
    const size_t hstep = (size_t)HALF * K * 2;
    const unsigned ldsw = (unsigned)wid * 1024u;
    const int aoff = lds_byte(wr * 64 + fr, fq * 8), boff = lds_byte(wc * 32 + fr, fq * 8);
#define PG8_SA(b, h) (((b) * 2 + (h)) * HTB)
#define PG8_SB(b, h) ((4 + (b) * 2 + (h)) * HTB)
#define PG8_STG(bufoff, gbase, v0, v1) do { \
        __builtin_amdgcn_global_load_lds((const unsigned*)((const char*)(gbase) + (v0)), (PG8_LAS unsigned*)(lds + (bufoff) + ldsw), 16, 0, 0); \
        __builtin_amdgcn_global_load_lds((const unsigned*)((const char*)(gbase) + (v1)), (PG8_LAS unsigned*)(lds + (bufoff) + ldsw + 8192), 16, 0, 0); } while (0)
#define PG8_STGB(bufoff, gbase) PG8_STG(bufoff, gbase, voffB[0], voffB[1])
#define PG8_LDA(dst, b, h) do { _Pragma("unroll") for (int m = 0; m < 4; ++m) _Pragma("unroll") for (int k = 0; k < 2; ++k) dst[m][k] = *(const PG8_LAS bf16x8*)(lds + PG8_SA(b, h) + aoff + m * 2048 + k * 1024); } while (0)
#define PG8_LDB(dst, b, h) do { _Pragma("unroll") for (int n = 0; n < 2; ++n) _Pragma("unroll") for (int k = 0; k < 2; ++k) dst[n][k] = *(const PG8_LAS bf16x8*)(lds + PG8_SB(b, h) + boff + n * 2048 + k * 1024); } while (0)
#define PG8_MMA(ai, bj, At, Bt) do { __builtin_amdgcn_s_setprio(1); _Pragma("unroll") for (int m = 0; m < 4; ++m) _Pragma("unroll") for (int n = 0; n < 2; ++n) _Pragma("unroll") for (int k = 0; k < 2; ++k) \
        acc[ai][bj][m][n] = __builtin_amdgcn_mfma_f32_16x16x32_bf16(Bt[n][k], At[m][k], acc[ai][bj][m][n], 0, 0, 0); __builtin_amdgcn_s_setprio(0); } while (0)
#define PG8_WAIT_V(n) asm volatile("s_waitcnt vmcnt(" #n ")" ::: "memory")
#define PG8_WAIT_L(n) asm volatile("s_waitcnt lgkmcnt(" #n ")" ::: "memory")
#define PG8_BAR __builtin_amdgcn_s_barrier()
#define PG8_SCHED __builtin_amdgcn_sched_barrier(0)
    Unit cur, nxt; int ui = 0;
    if (!S.next(0, cur)) return;
    unsigned cv[2][2], nv[2][2];
    S.a_voff(cur, Rr, Cc, cv);
#define PG8_QFIX(qm, v) do { if (!((qm) & 3)) { v[0][0] = v[1][0]; v[0][1] = v[1][1]; } if (!((qm) & 12)) { v[1][0] = v[0][0]; v[1][1] = v[0][1]; } } while (0)
    PG8_QFIX(cur.qm, cv);
    size_t chb0 = (cur.qm & 5) ? 0 : hstep, chb1 = (cur.qm & 10) ? hstep : 0;
    f32x4 acc[2][2][4][2];
#pragma unroll
    for (int a = 0; a < 2; ++a)
#pragma unroll
        for (int b = 0; b < 2; ++b)
#pragma unroll
            for (int m = 0; m < 4; ++m)
#pragma unroll
                for (int n = 0; n < 2; ++n) acc[a][b][m][n] = (f32x4){0.f, 0.f, 0.f, 0.f};
    bf16x8 At[4][2], B0[2][2], B1[2][2];
    const char* cA = cur.A; const char* cB = cur.B;
    PG8_STGB(PG8_SB(0, 0), cB + chb0); PG8_STGB(PG8_SB(0, 1), cB + chb1); PG8_STG(PG8_SA(0, 0), cA, cv[0][0], cv[0][1]); PG8_STG(PG8_SA(0, 1), cA, cv[1][0], cv[1][1]);
    if (wr == 1) PG8_BAR;
    PG8_WAIT_V(2); PG8_BAR;
    PG8_STGB(PG8_SB(1, 0), cB + chb0 + kstep); PG8_STG(PG8_SA(1, 0), cA + kstep, cv[0][0], cv[0][1]); PG8_STGB(PG8_SB(1, 1), cB + chb1 + kstep);
    PG8_WAIT_V(6); PG8_BAR;
    for (;;) {
        const bool has_next = S.next(ui + 1, nxt);
        if (has_next) { S.a_voff(nxt, Rr, Cc, nv); PG8_QFIX(nxt.qm, nv); }
        else { nv[0][0] = cv[0][0]; nv[0][1] = cv[0][1]; nv[1][0] = cv[1][0]; nv[1][1] = cv[1][1]; }
        const char* nA = has_next ? nxt.A : cA; const char* nB = has_next ? nxt.B : cB;
        const size_t nhb0 = has_next ? ((nxt.qm & 5) ? 0 : hstep) : chb0, nhb1 = has_next ? ((nxt.qm & 10) ? hstep : 0) : chb1;
        const bool q00 = cur.qm & 1, q01 = cur.qm & 2, q10 = cur.qm & 4, q11 = cur.qm & 8;
#pragma unroll 1
        for (int t = 0; t < nt; t += 2) {
            const bool last = (t == nt - 2);
            const char* a1 = cA + (size_t)(t + 1) * kstep;
            const char* a2 = last ? nA : cA + (size_t)(t + 2) * kstep; const char* b2 = last ? nB : cB + (size_t)(t + 2) * kstep;
            const char* a3 = a2 + kstep; const char* b3 = b2 + kstep;
            const size_t h0 = last ? nhb0 : chb0, h1 = last ? nhb1 : chb1;
            const unsigned x00 = last ? nv[0][0] : cv[0][0], x01 = last ? nv[0][1] : cv[0][1], x10 = last ? nv[1][0] : cv[1][0], x11 = last ? nv[1][1] : cv[1][1];
            PG8_LDB(B0, 0, 0); PG8_LDB(B1, 0, 1); PG8_SCHED; PG8_LDA(At, 0, 0); PG8_STG(PG8_SA(1, 1), a1, cv[1][0], cv[1][1]);
            PG8_WAIT_V(8); PG8_WAIT_L(0); PG8_BAR; if (q00) PG8_MMA(0, 0, At, B0); if (q01) PG8_MMA(0, 1, At, B1); PG8_BAR; PG8_SCHED;
            PG8_LDA(At, 0, 1); PG8_STGB(PG8_SB(0, 0), b2 + h0); PG8_STGB(PG8_SB(0, 1), b2 + h1); PG8_STG(PG8_SA(0, 0), a2, x00, x01);
            PG8_WAIT_V(8); PG8_WAIT_L(0); PG8_BAR; if (q10) PG8_MMA(1, 0, At, B0); if (q11) PG8_MMA(1, 1, At, B1); PG8_BAR; PG8_SCHED;
            PG8_LDB(B0, 1, 0); PG8_LDB(B1, 1, 1); PG8_SCHED; PG8_LDA(At, 1, 0); PG8_STG(PG8_SA(0, 1), a2, x10, x11);
            PG8_WAIT_V(8); PG8_WAIT_L(0); PG8_BAR; if (q00) PG8_MMA(0, 0, At, B0); if (q01) PG8_MMA(0, 1, At, B1); PG8_BAR; PG8_SCHED;
            PG8_LDA(At, 1, 1); PG8_STGB(PG8_SB(1, 0), b3 + h0); PG8_STGB(PG8_SB(1, 1), b3 + h1); PG8_STG(PG8_SA(1, 0), a3, x00, x01);
            PG8_WAIT_V(8); PG8_WAIT_L(0); PG8_BAR; if (q10) PG8_MMA(1, 0, At, B0); if (q11) PG8_MMA(1, 1, At, B1); PG8_BAR; PG8_SCHED;
        }
        if constexpr (ALIGN_EPI) { if (wr == 0) PG8_BAR; }
        E(acc, cur, wr, wc, fr, fq);
        if (!has_next) break;
#pragma unroll
        for (int a = 0; a < 2; ++a)
#pragma unroll
            for (int b = 0; b < 2; ++b)
#pragma unroll
                for (int m = 0; m < 4; ++m)
#pragma unroll
                    for (int n = 0; n < 2; ++n) acc[a][b][m][n] = (f32x4){0.f, 0.f, 0.f, 0.f};
        cur = nxt; cA = nA; cB = nB; ++ui; chb0 = nhb0; chb1 = nhb1;
        cv[0][0] = nv[0][0]; cv[0][1] = nv[0][1]; cv[1][0] = nv[1][0]; cv[1][1] = nv[1][1];
        if constexpr (ALIGN_EPI) { if (wr == 1) PG8_BAR; }
    }
    PG8_WAIT_V(0);
    if constexpr (!ALIGN_EPI) { if (wr == 0) PG8_BAR; }
    PG8_BAR;
#undef PG8_SA
#undef PG8_QFIX
#undef PG8_SB
#undef PG8_STG
#undef PG8_STGB
#undef PG8_LDA
#undef PG8_LDB
#undef PG8_MMA
#undef PG8_WAIT_V
#undef PG8_WAIT_L
#undef PG8_BAR
#undef PG8_SCHED
}
}
#define XB_TMO      128
#define XB_XCNT(j)  (256  + 64 * (j))
#define XB_XSUB(j)  (1280 + 64 * (j))
#define XB_XGEN(j)  (2304 + 64 * (j))
#define XB_TOP      3328
#define XB_TOPGEN   3392
#define XCD_BAR_WORDS 3456
#define XB_SPIN_CAP (1u << 18)

__device__ __forceinline__ unsigned xb_ld(unsigned* p)              { return __hip_atomic_load(p, __ATOMIC_RELAXED, __HIP_MEMORY_SCOPE_AGENT); }
__device__ __forceinline__ unsigned xb_add(unsigned* p, unsigned v) { return __hip_atomic_fetch_add(p, v, __ATOMIC_RELAXED, __HIP_MEMORY_SCOPE_AGENT); }
__device__ __forceinline__ unsigned xb_xcc_id() { return (unsigned)__builtin_amdgcn_s_getreg((3 << 11) | 20) & 0xFu; }
#define XB_SPIN(cond, bar) do { unsigned _sp = 0; while (cond) { __builtin_amdgcn_s_sleep(1); \
    if ((++_sp & 255u) == 0u) { if (xb_ld(&(bar)[XB_TMO])) break; if (_sp > XB_SPIN_CAP) { atomicAdd(&(bar)[XB_TMO], 1u); break; } } } } while (0)

struct XcdBarrier {
    unsigned* bar; unsigned x;
    volatile LAS unsigned* st;
};

__device__ __forceinline__ XcdBarrier xcd_barrier_post(unsigned* bar, volatile LAS unsigned* st) {
    XcdBarrier b; b.bar = bar; b.x = xb_xcc_id(); b.st = st;
    if (threadIdx.x == 0) (void)xb_add(&bar[XB_XCNT(b.x)], 1u);
    return b;
}
__device__ __forceinline__ void xcd_barrier_complete(unsigned* bar, unsigned x, unsigned& nloc, unsigned& nx) {
    const unsigned G = gridDim.x * gridDim.y * gridDim.z;
    unsigned sum, cnt, mine, sp = 0u;
    for (;;) {
        sum = 0u; cnt = 0u; mine = 0u;
#pragma unroll
        for (unsigned j = 0; j < 16; ++j) { const unsigned c = xb_ld(&bar[XB_XCNT(j)]); sum += c; cnt += (c > 0u) ? 1u : 0u; mine = (j == x) ? c : mine; }
        if (sum == G) break;
        __builtin_amdgcn_s_sleep(1);
        if ((++sp & 255u) == 0u) { if (xb_ld(&bar[XB_TMO])) break; if (sp > XB_SPIN_CAP) { atomicAdd(&bar[XB_TMO], 1u); break; } }
    }
    nloc = mine > 0u ? mine : 1u; nx = cnt > 0u ? cnt : 1u;
}

__device__ __forceinline__ void xcd_barrier(const XcdBarrier& b) {
    asm volatile("s_waitcnt vmcnt(0)" ::: "memory");
    __syncthreads();
    if (threadIdx.x == 0) {
        unsigned* bar = b.bar;
        __builtin_amdgcn_s_waitcnt(0);
        unsigned nloc = b.st[0], nx = b.st[1];
        if (nloc == 0u) { xcd_barrier_complete(bar, b.x, nloc, nx); b.st[0] = nloc; b.st[1] = nx; }
        const unsigned old = xb_add(&bar[XB_XSUB(b.x)], 1u);
        const unsigned gen = old / nloc;
        if (old + 1u == (gen + 1u) * nloc) {
            __builtin_amdgcn_fence(__ATOMIC_RELEASE, "agent");
            asm volatile("s_waitcnt vmcnt(0)" ::: "memory");
            const unsigned og = xb_add(&bar[XB_TOP], 1u);
            const unsigned tg = og / nx;
            if (og + 1u == (tg + 1u) * nx) xb_add(&bar[XB_TOPGEN], 1u);
            else XB_SPIN(xb_ld(&bar[XB_TOPGEN]) == tg, bar);
            __builtin_amdgcn_fence(__ATOMIC_ACQUIRE, "agent");
            xb_add(&bar[XB_XGEN(b.x)], 1u);
            asm volatile("s_waitcnt vmcnt(0)" ::: "memory");
        } else {
            __builtin_amdgcn_fence(__ATOMIC_ACQUIRE, "agent");
            XB_SPIN(xb_ld(&bar[XB_XGEN(b.x)]) == gen, bar);
            asm volatile("s_waitcnt vmcnt(0)" ::: "memory");
        }
    }
    __syncthreads();
}
struct RopeTab { float inv_freq[8]; };
struct Args { const void* in[21]; float* out; unsigned char* ws; int ph_lo, ph_hi; RopeTab rt; };

__device__ __forceinline__ void p0_adaln(LAS unsigned char* lds, const float* c, const float* ada_w, const float* ada_b, float* modp, int blk, int tid) {
    LAS float* ca = (LAS float*)lds;
    LAS float* red = (LAS float*)(lds + 4096);
    const int kc = blk >> 5, cc = blk & 31;
    for (int i = tid; i < 1024; i += NTHR) { const int b = i >> 7, k = i & 127; ca[i] = silu_f(c[b * D + kc * 128 + k]); }
    __syncthreads();
    if (tid < 480) {
        const int cq = tid % 48, kr = tid / 48;
        f32x4 acc[8];
#pragma unroll
        for (int b = 0; b < 8; ++b) acc[b] = (f32x4){0.f, 0.f, 0.f, 0.f};
        const float* wp = ada_w + (size_t)(kc * 128) * 6144 + cc * 192 + cq * 4;
        f32x4 wv[13];
#pragma unroll
        for (int i = 0; i < 13; ++i) { const int k = kr + 10 * i; wv[i] = (k < 128) ? *(const f32x4*)(wp + (size_t)k * 6144) : (f32x4){0.f, 0.f, 0.f, 0.f}; }
#pragma unroll
        for (int i = 0; i < 13; ++i) { const int k = (kr + 10 * i) & 127;
#pragma unroll
            for (int b = 0; b < 8; ++b) acc[b] += wv[i] * ca[b * 128 + k]; }
#pragma unroll
        for (int b = 0; b < 8; ++b) *(LAS f32x4*)(red + (kr * 8 + b) * 192 + cq * 4) = acc[b];
    }
    __syncthreads();
    if (tid < 384) { const int b = tid / 48, cq = tid % 48; f32x4 s = (f32x4){0.f, 0.f, 0.f, 0.f};
#pragma unroll
        for (int kr = 0; kr < 10; ++kr) s += *(const LAS f32x4*)(red + (kr * 8 + b) * 192 + cq * 4);
        if (kc == 0) s += *(const f32x4*)(ada_b + cc * 192 + cq * 4);
        *(f32x4*)(modp + (size_t)(kc * 8 + b) * 6144 + cc * 192 + cq * 4) = s; }
    __syncthreads();
}

__device__ __forceinline__ void tr_store(LAS float* scr, bf16* dst, int Kd, int k0, int rowbase, bool gu, int lane) {
    asm volatile("s_waitcnt lgkmcnt(0)" ::: "memory");
    const int c = lane & 7;
#pragma unroll
    for (int j = 0; j < 4; ++j) { const int n = (lane >> 3) + 8 * j; const LAS float* s = scr + (8 * c) * 33 + n;
        u32x4 o; o.x = pk2(s[0 * 33], s[1 * 33]); o.y = pk2(s[2 * 33], s[3 * 33]); o.z = pk2(s[4 * 33], s[5 * 33]); o.w = pk2(s[6 * 33], s[7 * 33]);
        const int row = rowbase + n + ((gu && n >= 16) ? 16 : 0);
        *(u32x4*)(dst + (size_t)row * Kd + k0 + 8 * c) = o; }
    asm volatile("s_waitcnt lgkmcnt(0)" ::: "memory");
}
struct TrItem { const float* src; bf16* dst; int ldw, Kd, k0, rowbase; bool gu; };
__device__ __forceinline__ bool tr_decode(int it, const Args& a, TrItem& t) {
    constexpr int I0 = 16 * 72, I2 = 16 * 32, I3 = 32 * 2 * 128, I4 = 32 * 128, NIT = I0 + I2 + I3 + I4;
    if (it >= NIT) return false;
    unsigned char* ws = a.ws;
    const float* w_in = (const float*)a.in[6]; const float* w_out = (const float*)a.in[11];
    const float* w_gate = (const float*)a.in[17]; const float* w_up = (const float*)a.in[18]; const float* w_down = (const float*)a.in[19];
    bf16* win = (bf16*)(ws + WS_WIN); bf16* wout = (bf16*)(ws + WS_WOUT); bf16* wgu = (bf16*)(ws + WS_WGU); bf16* wd = (bf16*)(ws + WS_WD);
    int r = it;
    if (r < I0) { const int kb = r / 72, nb = r % 72, n0 = nb * 32, k0 = kb * 64; const int sc = n0 + (n0 >= 1536 ? 16 : 0);
        t.src = w_in + (size_t)k0 * INW + sc; t.ldw = INW; t.dst = win; t.Kd = D; t.k0 = k0; t.rowbase = n0; t.gu = false; return true; }
    r -= I0;
    if (r < I2) { const int kb = r / 32, nb = r % 32, n0 = nb * 32, k0 = kb * 64;
        t.src = w_out + (size_t)k0 * D + n0; t.ldw = D; t.dst = wout; t.Kd = D; t.k0 = k0; t.rowbase = n0; t.gu = false; return true; }
    r -= I2;
    if (r < I3) { const int e = r >> 8, ty = (r >> 7) & 1, q = r & 127, kb = q >> 3, nb = q & 7, n0 = nb * 32, k0 = kb * 64;
        t.src = (ty ? w_up : w_gate) + (size_t)e * D * 256 + (size_t)k0 * 256 + n0; t.ldw = 256; t.dst = wgu + (size_t)e * 512 * D; t.Kd = D; t.k0 = k0; t.rowbase = 2 * n0 + 16 * ty; t.gu = true; return true; }
    r -= I3;
    { const int e = r >> 7, q = r & 127, kb = q >> 5, nb = q & 31, n0 = nb * 32, k0 = kb * 64;
        t.src = w_down + (size_t)e * 256 * D + (size_t)k0 * D + n0; t.ldw = D; t.dst = wd + (size_t)e * D * 256; t.Kd = 256; t.k0 = k0; t.rowbase = n0; t.gu = false; return true; }
}
__device__ __forceinline__ void tr_load(const TrItem& t, f32x4 (&v)[8], int lane) {
#pragma unroll
    for (int i = 0; i < 8; ++i) v[i] = *(const f32x4*)(t.src + (size_t)(8 * i + (lane >> 3)) * t.ldw + 4 * (lane & 7));
}
__device__ __forceinline__ void tr_finish(const TrItem& t, const f32x4 (&v)[8], LAS float* scr, int lane) {
#pragma unroll
    for (int i = 0; i < 8; ++i) { LAS float* s = scr + (8 * i + (lane >> 3)) * 33 + 4 * (lane & 7); s[0] = v[i].x; s[1] = v[i].y; s[2] = v[i].z; s[3] = v[i].w; }
    tr_store(scr, t.dst, t.Kd, t.k0, t.rowbase, t.gu, lane);
}
__device__ __forceinline__ void tr_stream(LAS unsigned char* scrbase, const Args& a, int first, int last, int gw, int NGW, int wave, int lane) {
    LAS float* scr = (LAS float*)(scrbase + wave * 8704);
    TrItem cur, nxt; f32x4 va[8], vb[8];
    int it = first + gw;
    bool have = it < last && tr_decode(it, a, cur);
    if (have) tr_load(cur, va, lane);
    while (have) {
        const bool hn = (it + NGW) < last && tr_decode(it + NGW, a, nxt);
        if (hn) tr_load(nxt, vb, lane);
        tr_finish(cur, va, scr, lane);
        if (!hn) break;
        const bool hn2 = (it + 2 * NGW) < last && tr_decode(it + 2 * NGW, a, cur);
        if (hn2) tr_load(cur, va, lane);
        tr_finish(nxt, vb, scr, lane);
        it += 2 * NGW; have = hn2;
    }
}
__device__ __forceinline__ void p0_weights(LAS unsigned char* lds, const Args& a, int blk, int wave, int lane, int tid) {
    unsigned char* ws = a.ws;
    const float* w_in = (const float*)a.in[6]; const float* w_a2 = (const float*)a.in[7]; const float* b_a2 = (const float*)a.in[8];
    bf16* win = (bf16*)(ws + WS_WIN);
    if (tid < 64 && blk < 192) {
        const float* w_grp = (const float*)a.in[13]; const float* w_exp = (const float*)a.in[15]; bf16* wrb = (bf16*)(ws + WS_WRB);
        const int e = blk * 64 + tid, ln = e & 63, hl = (e >> 6) & 1; const bool ex = e < 8192;
        const int k0 = ex ? 128 * (e >> 10) + 16 * ((e >> 7) & 7) + 8 * (ln >> 5) : 128 * ((e - 8192) >> 9) + 32 * ((e >> 7) & 3) + 8 * (ln >> 4);
        const int col = ex ? (ln & 31) : (ln & 15);
        unsigned o[4];
#pragma unroll
        for (int j2 = 0; j2 < 4; ++j2) { unsigned pr[2];
#pragma unroll
            for (int u = 0; u < 2; ++u) { const int k = k0 + 2 * j2 + u; const float wv = ex ? w_exp[k * 32 + col] : (col < 4 ? w_grp[k * 4 + col] : 0.f);
                const unsigned hi = f2bf(wv); const float hf = __uint_as_float(hi << 16); pr[u] = hl ? f2bf(wv - hf) : hi; }
            o[j2] = pr[0] | (pr[1] << 16); }
        *(u32x4*)(wrb + (size_t)e * 8) = (u32x4){o[0], o[1], o[2], o[3]};
    }
    {
        float wa[16];
#pragma unroll
        for (int q = 0; q < 16; ++q) wa[q] = w_a2[q * 256 + blk];
        float s2[2];
#pragma unroll
        for (int u = 0; u < 2; ++u) { const float* wr = w_in + (size_t)(2 * tid + u) * INW + 1536; float s = 0.f;
#pragma unroll
            for (int q4 = 0; q4 < 4; ++q4) { const f32x4 w = *(const f32x4*)(wr + 4 * q4); s = fmaf(w.x, wa[4 * q4], s); s = fmaf(w.y, wa[4 * q4 + 1], s); s = fmaf(w.z, wa[4 * q4 + 2], s); s = fmaf(w.w, wa[4 * q4 + 3], s); }
            s2[u] = s; }
        *(unsigned*)(win + (size_t)(C_Z + blk) * D + 2 * tid) = pk2(s2[0], s2[1]);
    }
}

__device__ __forceinline__ void p1a_rows(LAS unsigned char* lds, const Args& a, int blk, int wave, int lane, int tid, f32x4 (&n0)[4], f32x4 (&n1)[4]) {
    const float* x = (const float*)a.in[0]; const float* g = (const float*)a.in[5];
    const float* modp = (const float*)(a.ws + WS_MODP); float* mod = (float*)(a.ws + WS_MOD); bf16* h = (bf16*)(a.ws + WS_H);
    const int* pos = (const int*)a.in[2]; float* rtab = (float*)(a.ws + WS_ROPE);
    LAS float* ssh = (LAS float*)lds;
    const int b = blk >> 5;
    {
        float pv[4][8];
#pragma unroll
        for (int q = 0; q < 4; ++q)
#pragma unroll
            for (int kc = 0; kc < 8; ++kc) pv[q][kc] = modp[(size_t)(kc * 8 + b) * 6144 + tid + NTHR * q];
#pragma unroll
        for (int q = 0; q < 4; ++q) { const int i = tid + NTHR * q; float s = 0.f;
#pragma unroll
            for (int kc = 0; kc < 8; ++kc) s += pv[q][kc];
            ssh[i] = i < 1024 ? s : (1.f + s) * g[i - 1024]; }
    }
    if (tid < 192) { const int idx = blk * 192 + tid, bb = idx / 6144, col = idx % 6144; float s = 0.f;
#pragma unroll
        for (int kc = 0; kc < 8; ++kc) s += modp[(size_t)(kc * 8 + bb) * 6144 + col];
        mod[idx] = s; }
    { const int m = blk * 64 + (tid >> 3), j = tid & 7; float sn, cs; sincosf((float)pos[m] * a.rt.inv_freq[j], &sn, &cs); rtab[m * 16 + j] = cs; rtab[m * 16 + 8 + j] = sn; }
    __syncthreads();
    for (int r = wave; r < 64; r += NWAVES) {
        const size_t m = (size_t)blk * 64 + r;
        f32x4 v[4]; float ss = 0.f;
#pragma unroll
        for (int j = 0; j < 4; ++j) { v[j] = n0[j]; n0[j] = n1[j]; }
        if (r + 2 * NWAVES < 64) {
#pragma unroll
            for (int j = 0; j < 4; ++j) n1[j] = *(const f32x4*)(x + (m + 2 * NWAVES) * D + 4 * lane + 256 * j);
        }
#pragma unroll
        for (int j = 0; j < 4; ++j) ss += (v[j].x * v[j].x + v[j].y * v[j].y) + (v[j].z * v[j].z + v[j].w * v[j].w);
        const float rinv = rsqrtf(wave_sum(ss) * (1.f / D) + EPS);
#pragma unroll
        for (int j = 0; j < 4; ++j) { const int col = 4 * lane + 256 * j; const f32x4 sh = *(const LAS f32x4*)(ssh + col), gs = *(const LAS f32x4*)(ssh + 1024 + col);
            const f32x4 hv = v[j] * rinv * gs + sh; u32x2 o; o.x = pk2(hv.x, hv.y); o.y = pk2(hv.z, hv.w);
            *(u32x2*)(h + m * D + col) = o; }
    }
    __syncthreads();
}

struct RouteFrags { bf16x8 bh[8], bl[8], gh[4], gl[4]; };
__device__ __forceinline__ void p3b_pre(LAS unsigned char* lds, const Args& a, int blk, int wave, int lane, int tid, RouteFrags& f) {
    const float* g = (const float*)a.in[12]; const float* mod = (const float*)(a.ws + WS_MOD); const bf16* wrb = (const bf16*)(a.ws + WS_WRB);
    const float* b_grp = (const float*)a.in[14]; const float* b_exp = (const float*)a.in[16];
    LAS float* ssh = (LAS float*)(lds + 131072);
    LAS float* biasL = (LAS float*)(lds + 139264) + 448;
    const int b = blk >> 5;
#pragma unroll
    for (int s = 0; s < 8; ++s) { const size_t e = (size_t)(((wave * 8 + s) * 2) * 64 + lane) * 8; f.bh[s] = *(const bf16x8*)(wrb + e); f.bl[s] = *(const bf16x8*)(wrb + e + 512); }
#pragma unroll
    for (int s = 0; s < 4; ++s) { const size_t e = (size_t)(8192 + ((wave * 4 + s) * 2) * 64 + lane) * 8; f.gh[s] = *(const bf16x8*)(wrb + e); f.gl[s] = *(const bf16x8*)(wrb + e + 512); }
    float mv[4], gv[4];
#pragma unroll
    for (int q = 0; q < 4; ++q) { const int i = tid + NTHR * q; mv[q] = mod[b * 6144 + 3 * D + i]; gv[q] = i < 1024 ? 0.f : g[i - 1024]; }
#pragma unroll
    for (int q = 0; q < 4; ++q) { const int i = tid + NTHR * q; ssh[i] = i < 1024 ? mv[q] : (1.f + mv[q]) * gv[q]; }
    if (tid >= 64 && tid < 100) biasL[tid - 64] = (tid < 96) ? b_exp[tid - 64] : b_grp[tid - 96];
}
__device__ __forceinline__ void p3b_route(LAS unsigned char* lds, const Args& a, int blk, int wave, int lane, int tid, const RouteFrags& f) {
    const bf16* x1 = (const bf16*)(a.ws + WS_X1); const float* g = (const float*)a.in[12];
    const float* b_grp = (const float*)a.in[14]; const float* b_exp = (const float*)a.in[16];
    const float* mod = (const float*)(a.ws + WS_MOD); bf16* h2 = (bf16*)(a.ws + WS_H); const bf16* wrb = (const bf16*)(a.ws + WS_WRB);
    int* cnt = (int*)(a.ws + WS_CTL) + CW_CNT; int* list = (int*)(a.ws + WS_ROUTE); float* lw = (float*)(a.ws + WS_ROUTE + 2 * MiB);
    LAS unsigned char* Ahi = lds; LAS unsigned char* Alo = lds + 65536;
    LAS float* red = (LAS float*)lds;
    LAS float* lgt = (LAS float*)(lds + 65536);
    LAS float* ssh = (LAS float*)(lds + 131072);
    LAS int* rsel = (LAS int*)(lds + 139264); LAS int* rslot = rsel + 128; LAS float* rwt = (LAS float*)(rslot + 128); LAS int* lcnt = (LAS int*)(rwt + 128); LAS int* lbase = lcnt + 32;
    LAS float* biasL = (LAS float*)(lbase + 32);
    const int b = blk >> 5, l31 = lane & 31, hh = lane >> 5;
    u32x2 nx[4][4];
#pragma unroll
    for (int rr = 0; rr < 4; ++rr)
#pragma unroll
        for (int j = 0; j < 4; ++j) nx[rr][j] = *(const u32x2*)(x1 + ((size_t)blk * 64 + wave * 4 + rr) * D + 4 * lane + 256 * j);
    if (tid < 32) lcnt[tid] = 0;
    __syncthreads();
#pragma unroll 1
    for (int pass = 0; pass < 2; ++pass) {
#pragma unroll
        for (int rr = 0; rr < 4; ++rr) {
            const int rl = wave * 4 + rr; const int m = blk * 64 + pass * 32 + rl;
            f32x4 v[4]; float ss = 0.f;
#pragma unroll
            for (int j = 0; j < 4; ++j) { v[j].x = lo_bf16(nx[rr][j].x); v[j].y = hi_bf16(nx[rr][j].x); v[j].z = lo_bf16(nx[rr][j].y); v[j].w = hi_bf16(nx[rr][j].y); }
            if (pass == 0) {
#pragma unroll
              for (int j = 0; j < 4; ++j) nx[rr][j] = *(const u32x2*)(x1 + (size_t)(m + 32) * D + 4 * lane + 256 * j); }
#pragma unroll
            for (int j = 0; j < 4; ++j) ss += (v[j].x * v[j].x + v[j].y * v[j].y) + (v[j].z * v[j].z + v[j].w * v[j].w);
            const float rinv = rsqrtf(wave_sum(ss) * (1.f / D) + EPS);
#pragma unroll
            for (int j = 0; j < 4; ++j) { const int col = 4 * lane + 256 * j; const f32x4 sh = *(const LAS f32x4*)(ssh + col), sc = *(const LAS f32x4*)(ssh + 1024 + col);
                v[j] = v[j] * rinv * sc + sh;
                u32x2 hi; hi.x = pk2(v[j].x, v[j].y); hi.y = pk2(v[j].z, v[j].w);
                *(u32x2*)(h2 + (size_t)m * D + col) = hi;
                u32x2 lo; lo.x = pk2(v[j].x - lo_bf16(hi.x), v[j].y - hi_bf16(hi.x)); lo.y = pk2(v[j].z - lo_bf16(hi.y), v[j].w - hi_bf16(hi.y));
                const int c = (lane >> 1) + 32 * j; const int off = rl * 2048 + ((c ^ (rl & 15)) * 16) + 8 * (lane & 1);
                *(LAS u32x2*)(Ahi + off) = hi; *(LAS u32x2*)(Alo + off) = lo; }
        }
        __syncthreads();
        f32x16 acc0; f32x4 accg[2];
#pragma unroll
        for (int r = 0; r < 16; ++r) acc0[r] = 0.f;
        accg[0] = (f32x4){0.f, 0.f, 0.f, 0.f}; accg[1] = (f32x4){0.f, 0.f, 0.f, 0.f};
#pragma unroll
        for (int s = 0; s < 8; ++s) { const int c = 2 * (wave * 8 + s) + hh; const int off = l31 * 2048 + ((c ^ (l31 & 15)) * 16);
            const bf16x8 ah = *(const LAS bf16x8*)(Ahi + off), al = *(const LAS bf16x8*)(Alo + off);
            acc0 = __builtin_amdgcn_mfma_f32_32x32x16_bf16(ah, f.bh[s], acc0, 0, 0, 0); acc0 = __builtin_amdgcn_mfma_f32_32x32x16_bf16(ah, f.bl[s], acc0, 0, 0, 0); acc0 = __builtin_amdgcn_mfma_f32_32x32x16_bf16(al, f.bh[s], acc0, 0, 0, 0); }
#pragma unroll
        for (int s = 0; s < 4; ++s)
#pragma unroll
            for (int mt = 0; mt < 2; ++mt) { const int row = 16 * mt + (lane & 15), c = 16 * wave + 4 * s + (lane >> 4); const int off = row * 2048 + ((c ^ (row & 15)) * 16);
                const bf16x8 ah = *(const LAS bf16x8*)(Ahi + off), al = *(const LAS bf16x8*)(Alo + off);
                accg[mt] = __builtin_amdgcn_mfma_f32_16x16x32_bf16(ah, f.gh[s], accg[mt], 0, 0, 0); accg[mt] = __builtin_amdgcn_mfma_f32_16x16x32_bf16(ah, f.gl[s], accg[mt], 0, 0, 0); accg[mt] = __builtin_amdgcn_mfma_f32_16x16x32_bf16(al, f.gh[s], accg[mt], 0, 0, 0); }
        __syncthreads();
#pragma unroll
        for (int r = 0; r < 16; ++r) { const int row = (r & 3) + 8 * (r >> 2) + 4 * hh; red[(wave * 32 + row) * 36 + l31] = acc0[r]; }
        if ((lane & 15) < 4) {
#pragma unroll
            for (int mt = 0; mt < 2; ++mt)
#pragma unroll
                for (int r = 0; r < 4; ++r) red[(wave * 32 + 16 * mt + 4 * (lane >> 4) + r) * 36 + 32 + (lane & 15)] = accg[mt][r];
        }
        __syncthreads();
#pragma unroll
        for (int q = 0; q < 3; ++q) { const int p = tid + NTHR * q;
            if (p < 32 * 36) { float s = 0.f;
#pragma unroll
                for (int w = 0; w < 8; ++w) s += red[w * (32 * 36) + p];
                lgt[p] = s + biasL[p % 36]; } }
        __syncthreads();
        if (tid < 32) {
            const int row = tid;
            float lg[4];
#pragma unroll
            for (int o = 0; o < 4; ++o) lg[o] = lgt[row * 36 + 32 + o];
            int gi = 0; float gm = lg[0];
#pragma unroll
            for (int o = 1; o < 4; ++o) if (lg[o] > gm) { gm = lg[o]; gi = o; }
            float den = 0.f;
#pragma unroll
            for (int o = 0; o < 4; ++o) den += __expf(lg[o] - gm);
            const float gate = 1.f / den;
            float sl[8];
#pragma unroll
            for (int i = 0; i < 8; ++i) sl[i] = lgt[row * 36 + gi * 8 + i];
            int i1 = 0; float v1 = sl[0];
#pragma unroll
            for (int i = 1; i < 8; ++i) if (sl[i] > v1) { v1 = sl[i]; i1 = i; }
            int i2 = 0; float v2 = -INFINITY;
#pragma unroll
            for (int i = 0; i < 8; ++i) if (i != i1 && sl[i] > v2) { v2 = sl[i]; i2 = i; }
            const float e2 = __expf(v2 - v1), w1 = gate / (1.f + e2), w2 = gate * e2 / (1.f + e2);
            const int ea = gi * 8 + i1, eb = gi * 8 + i2, r2 = 2 * (pass * 32 + row);
            rsel[r2] = ea; rslot[r2] = atomicAdd((int*)(lcnt + ea), 1); rwt[r2] = w1;
            rsel[r2 + 1] = eb; rslot[r2 + 1] = atomicAdd((int*)(lcnt + eb), 1); rwt[r2 + 1] = w2;
        }
        __syncthreads();
    }
    if (tid < 32) { const int c = lcnt[tid]; lbase[tid] = c ? atomicAdd(&cnt[tid * CNT_STRIDE], c) : 0; }
    __syncthreads();
    if (tid < 128) { const int e = rsel[tid], slot = lbase[e] + rslot[tid]; list[e * LCAP + slot] = (blk * 64 + (tid >> 1)) * 2 + (tid & 1); lw[e * LCAP + slot] = rwt[tid]; }
    __syncthreads();
}

__device__ __forceinline__ void moe_prefix(LAS int* tp, const int* cnt, int tid) {
    if (tid < 64) {
        const int craw = __hip_atomic_load(cnt + (tid & 31) * CNT_STRIDE, __ATOMIC_RELAXED, __HIP_MEMORY_SCOPE_AGENT);
        if (tid < NEXP) tp[208 + tid] = craw;
        const int c = tid < NEXP ? ((craw + 255) >> 8) : 0;
        int s = c;
#pragma unroll
        for (int o = 1; o < 32; o <<= 1) { const int t = __shfl_up(s, o); if ((tid & 63) >= o) s += t; }
        if (tid < NEXP) { tp[tid] = s - c; for (int t = s - c; t < s; ++t) tp[40 + t] = tid; }
        if (tid == NEXP - 1) tp[NEXP] = s;
    }
    __syncthreads();
}

__device__ __forceinline__ void p6_final(LAS unsigned char* lds, const Args& a, int blk, int wave, int lane, int tid) {
    float* out = a.out; const bf16* x1 = (const bf16*)(a.ws + WS_X1); const float* fg = (const float*)a.in[20]; const float* mod = (const float*)(a.ws + WS_MOD); const bf16* y2 = (const bf16*)(a.ws + WS_Y2);
    LAS float* gt = (LAS float*)lds;
    const int b = blk >> 5;
    for (int i = tid; i < 1024; i += NTHR) gt[i] = mod[b * 6144 + 5 * D + i];
    __syncthreads();
    f32x4 gg[4];
#pragma unroll
    for (int j = 0; j < 4; ++j) gg[j] = *(const f32x4*)(fg + 4 * lane + 256 * j);
    u32x2 nx[4]; u32x2 nya[4], nyb[4];
    {
        const size_t m = (size_t)blk * 64 + wave;
#pragma unroll
        for (int j = 0; j < 4; ++j) { const int col = 4 * lane + 256 * j; nx[j] = *(const u32x2*)(x1 + m * D + col); nya[j] = *(const u32x2*)(y2 + (m * 2) * D + col); nyb[j] = *(const u32x2*)(y2 + (m * 2 + 1) * D + col); }
    }
    for (int r = wave; r < 64; r += NWAVES) {
        const size_t m = (size_t)blk * 64 + r;
        f32x4 v[4]; u32x2 ya4[4], yb4[4]; float ss = 0.f;
#pragma unroll
        for (int j = 0; j < 4; ++j) { v[j].x = lo_bf16(nx[j].x); v[j].y = hi_bf16(nx[j].x); v[j].z = lo_bf16(nx[j].y); v[j].w = hi_bf16(nx[j].y); ya4[j] = nya[j]; yb4[j] = nyb[j]; }
        if (r + NWAVES < 64) {
            const size_t mn = m + NWAVES;
#pragma unroll
            for (int j = 0; j < 4; ++j) { const int col = 4 * lane + 256 * j; nx[j] = *(const u32x2*)(x1 + mn * D + col); nya[j] = *(const u32x2*)(y2 + (mn * 2) * D + col); nyb[j] = *(const u32x2*)(y2 + (mn * 2 + 1) * D + col); }
        }
#pragma unroll
        for (int j = 0; j < 4; ++j) { const int col = 4 * lane + 256 * j; const u32x2 ya = ya4[j], yb = yb4[j];
            f32x4 y; y.x = __uint_as_float(ya.x << 16) + __uint_as_float(yb.x << 16); y.y = __uint_as_float(ya.x & 0xffff0000u) + __uint_as_float(yb.x & 0xffff0000u);
            y.z = __uint_as_float(ya.y << 16) + __uint_as_float(yb.y << 16); y.w = __uint_as_float(ya.y & 0xffff0000u) + __uint_as_float(yb.y & 0xffff0000u);
            v[j] += *(const LAS f32x4*)(gt + col) * y; ss += (v[j].x * v[j].x + v[j].y * v[j].y) + (v[j].z * v[j].z + v[j].w * v[j].w); }
        const float rinv = rsqrtf(wave_sum(ss) * (1.f / D) + EPS);
#pragma unroll
        for (int j = 0; j < 4; ++j) *(f32x4*)(out + m * D + 4 * lane + 256 * j) = v[j] * rinv * gg[j];
    }
    __syncthreads();
}
typedef short v4i16_t __attribute__((ext_vector_type(4)));
constexpr float LOG2E = 1.4426950408889634f;
__device__ __forceinline__ f32x16 mfma32(bf16x8 a, bf16x8 b, f32x16 c) { return __builtin_amdgcn_mfma_f32_32x32x16_bf16(a, b, c, 0, 0, 0); }
__device__ __forceinline__ v4i16_t tr_read(LAS unsigned char* p) { return __builtin_amdgcn_ds_read_tr16_b64_v4i16((LAS v4i16_t*)p); }
__device__ __forceinline__ bf16x8 cat8(v4i16_t a, v4i16_t b) { return (bf16x8){a[0], a[1], a[2], a[3], b[0], b[1], b[2], b[3]}; }
__device__ __forceinline__ unsigned cvtpk(float lo, float hi) { const f32x2_t v = {lo, hi}; const bf16x2_t b = __builtin_convertvector(v, bf16x2_t); return __builtin_bit_cast(unsigned, b); }
__device__ __forceinline__ bf16x8 pack8(const f32x16& v, int s) {
    u32x4 w; w.x = cvtpk(v[8 * s + 0], v[8 * s + 1]); w.y = cvtpk(v[8 * s + 2], v[8 * s + 3]); w.z = cvtpk(v[8 * s + 4], v[8 * s + 5]); w.w = cvtpk(v[8 * s + 6], v[8 * s + 7]);
    return __builtin_bit_cast(bf16x8, w);
}
__device__ __forceinline__ unsigned xor32_u(unsigned x) { const auto r = __builtin_amdgcn_permlane32_swap(x, x, false, false); return (threadIdx.x & 32) ? r[0] : r[1]; }
__device__ __forceinline__ float sum32(float x) { const auto r = __builtin_amdgcn_permlane32_swap(__float_as_uint(x), __float_as_uint(x), false, false); return __uint_as_float(r[0]) + __uint_as_float(r[1]); }
__device__ __forceinline__ float max32(float x) { const auto r = __builtin_amdgcn_permlane32_swap(__float_as_uint(x), __float_as_uint(x), false, false); return fmaxf(__uint_as_float(r[0]), __uint_as_float(r[1])); }
__device__ __forceinline__ float lo_bf(unsigned w) { return __uint_as_float(w << 16); }
__device__ __forceinline__ float hi_bf(unsigned w) { return __uint_as_float(w & 0xffff0000u); }
__device__ __forceinline__ int off256(int row, int ch) { return 256 * row + 16 * (ch ^ (((row & 3) << 2) | ((row >> 2) & 3))); }
__device__ __forceinline__ int off128(int row, int c) { return 128 * row + 16 * (c ^ ((row >> 1) & 7)); }

__device__ __forceinline__ void swa_unit(LAS unsigned char* lds, const bf16* proj, const float* rtab, const float* sinks, bf16* o, int unit, int tid, int lane, int wave) {
    const int b = unit >> 5, kh = (unit >> 4) & 1, qb = unit & 15;
    LAS unsigned char* Ks = lds; LAS unsigned char* Vs = lds + 32768;
    const int g = wave >> 1, qhf = wave & 1, qh = kh * 4 + g;
    const int l31 = lane & 31, h = lane >> 5, i16 = lane & 15, g16 = (lane >> 4) & 1, tq = i16 >> 2, tp = i16 & 3;
    bf16x8 qfa[2][4]; f32x4 qrt[2][4];
#pragma unroll
    for (int qs = 0; qs < 2; ++qs) { const size_t m = (size_t)b * SEQ + qb * 128 + 64 * qhf + 32 * qs + l31; const bf16* qp = proj + m * PW + C_SQ + qh * 64 + 8 * h;
#pragma unroll
        for (int s = 0; s < 4; ++s) qfa[qs][s] = *(const bf16x8*)(qp + 16 * s);
#pragma unroll
        for (int s = 0; s < 4; ++s) qrt[qs][s] = *(const f32x4*)(rtab + m * 16 + 4 * s); }
    {
        const int key = tid >> 1, half = tid & 1;
        const int jpos = (qb - 1) * 128 + key; const bool valid = jpos >= 0;
        const size_t m = (size_t)b * SEQ + (valid ? jpos : 0);
        const bf16* kp = proj + m * PW + C_SK + kh * 64 + half * 32; const bf16* vp = proj + m * PW + C_SV + kh * 64 + half * 32;
        u32x4 kc[4], vc[4];
#pragma unroll
        for (int c = 0; c < 4; ++c) { kc[c] = *(const u32x4*)(kp + 8 * c); vc[c] = *(const u32x4*)(vp + 8 * c); }
        if (half == 0) {
            const f32x4 c0 = *(const f32x4*)(rtab + m * 16), c1 = *(const f32x4*)(rtab + m * 16 + 4), s0 = *(const f32x4*)(rtab + m * 16 + 8), s1 = *(const f32x4*)(rtab + m * 16 + 12);
            const float cs[8] = {c0.x, c0.y, c0.z, c0.w, c1.x, c1.y, c1.z, c1.w}, sn[8] = {s0.x, s0.y, s0.z, s0.w, s1.x, s1.y, s1.z, s1.w};
#pragma unroll
            for (int w = 0; w < 4; ++w) {
                const float a0 = lo_bf(kc[0][w]), a1 = hi_bf(kc[0][w]), b0 = lo_bf(kc[1][w]), b1 = hi_bf(kc[1][w]);
                kc[0][w] = cvtpk(a0 * cs[2 * w] - b0 * sn[2 * w], a1 * cs[2 * w + 1] - b1 * sn[2 * w + 1]);
                kc[1][w] = cvtpk(b0 * cs[2 * w] + a0 * sn[2 * w], b1 * cs[2 * w + 1] + a1 * sn[2 * w + 1]);
            }
        }
        if (!valid) {
#pragma unroll
            for (int c = 0; c < 4; ++c) { kc[c] = (u32x4){0u, 0u, 0u, 0u}; vc[c] = (u32x4){0u, 0u, 0u, 0u}; }
        }
        const int vsw = (key >> 1) & 1;
#pragma unroll
        for (int c = 0; c < 4; ++c) { const int cc = 4 * half + c;
            *(LAS u32x4*)(Ks + off128(key, cc)) = kc[c];
            *(LAS u32x4*)(Vs + key * 128 + (((cc >> 2) ^ vsw) * 64) + (cc & 3) * 16) = vc[c]; }
    }
#pragma unroll
    for (int qs = 0; qs < 2; ++qs) {
        const f32x4 c0 = qrt[qs][0], c1 = qrt[qs][1], s0 = qrt[qs][2], s1 = qrt[qs][3];
        const float cs[8] = {c0.x, c0.y, c0.z, c0.w, c1.x, c1.y, c1.z, c1.w}, sn[8] = {s0.x, s0.y, s0.z, s0.w, s1.x, s1.y, s1.z, s1.w};
        u32x4 own = __builtin_bit_cast(u32x4, qfa[qs][0]), res;
#pragma unroll
        for (int w = 0; w < 4; ++w) { const unsigned pw = xor32_u(own[w]);
            const float o0 = lo_bf(own[w]), o1 = hi_bf(own[w]), p0 = lo_bf(pw), p1 = hi_bf(pw);
            const float sg = h ? 1.f : -1.f;
            res[w] = cvtpk(o0 * cs[2 * w] + sg * p0 * sn[2 * w], o1 * cs[2 * w + 1] + sg * p1 * sn[2 * w + 1]); }
        qfa[qs][0] = __builtin_bit_cast(bf16x8, res);
    }
    __syncthreads();
    const float sink2 = sinks[qh] * LOG2E, sc = 0.125f * LOG2E;
    const int vbase = (4 * h + tq) * 128 + 32 * g16 + 8 * tp;
#pragma unroll 1
    for (int qs = 0; qs < 2; ++qs) {
        const int q0 = 64 * qhf + 32 * qs;
        const size_t m = (size_t)b * SEQ + qb * 128 + q0 + l31;
        bf16x8 qf[4];
#pragma unroll
        for (int s = 0; s < 4; ++s) qf[s] = qs ? qfa[1][s] : qfa[0][s];
        const int kt0 = q0 >> 5;
        f32x16 st[5];
#pragma unroll
        for (int i = 0; i < 5; ++i) {
            f32x16 acc;
#pragma unroll
            for (int r = 0; r < 16; ++r) acc[r] = 0.f;
            const int row = 32 * (kt0 + i) + l31;
#pragma unroll
            for (int s = 0; s < 4; ++s) { const bf16x8 kf = *(const LAS bf16x8*)(Ks + off128(row, 2 * s + h)); acc = mfma32(kf, qf[s], acc); }
            st[i] = acc;
        }
        float mx = sink2;
#pragma unroll
        for (int i = 0; i < 5; ++i)
#pragma unroll
            for (int r = 0; r < 16; ++r) { const int krow = (r & 3) + 8 * (r >> 2) + 4 * h; const int dj = 32 * i + krow - l31;
                bool ok = (dj > 0) && (dj <= 128); if (qb == 0) ok = ok && (q0 + 32 * i + krow >= 128);
                const float x = ok ? st[i][r] * sc : -1e30f; st[i][r] = x; mx = fmaxf(mx, x); }
        mx = max32(mx);
        float l = 0.f;
#pragma unroll
        for (int i = 0; i < 5; ++i)
#pragma unroll
            for (int r = 0; r < 16; ++r) { const float p = __builtin_amdgcn_exp2f(st[i][r] - mx); st[i][r] = p; l += p; }
        l = sum32(l); l += __builtin_amdgcn_exp2f(sink2 - mx);
        f32x16 ot[2];
#pragma unroll
        for (int r = 0; r < 16; ++r) { ot[0][r] = 0.f; ot[1][r] = 0.f; }
#pragma unroll
        for (int i = 0; i < 5; ++i)
#pragma unroll
            for (int s2 = 0; s2 < 2; ++s2) { const bf16x8 pf = pack8(st[i], s2);
                LAS unsigned char* vb = Vs + (32 * (kt0 + i) + 16 * s2) * 128 + vbase;
#pragma unroll
                for (int dt = 0; dt < 2; ++dt) { const int xo = (dt ^ (tq >> 1)) * 64;
                    const bf16x8 vf = cat8(tr_read(vb + xo), tr_read(vb + 8 * 128 + xo));
                    ot[dt] = mfma32(vf, pf, ot[dt]); } }
        const float inv = __builtin_amdgcn_rcpf(l);
        bf16* op = o + m * D + 512 + qh * 64 + 4 * h;
#pragma unroll
        for (int dt = 0; dt < 2; ++dt)
#pragma unroll
            for (int gq = 0; gq < 4; ++gq) { u32x2 w; w.x = cvtpk(ot[dt][4 * gq] * inv, ot[dt][4 * gq + 1] * inv); w.y = cvtpk(ot[dt][4 * gq + 2] * inv, ot[dt][4 * gq + 3] * inv);
                *(u32x2*)(op + dt * 32 + 8 * gq) = w; }
    }
    __syncthreads();
}

constexpr int GLA_CH = 32768, GLA_QD = 16384, GLA_KD = 24576, GLA_K2T = 131072  , GLA_SEG = 147456  , GLA_DECL = 151552  , GLA_DECP = 152064, GLA_S = 131072, GLA_SSQ = 153088;
__device__ __forceinline__ float logsig16(float z) { return (fminf(z, 0.f) - __logf(1.f + __expf(-fabsf(z)))) * (1.f / 16.f); }
struct GlaRaw { bf16 la[2][8], qv[2][8], kv[2][8]; u32x4 v[2][2]; };
__device__ __forceinline__ void gla_kv_load(GlaRaw& r, const bf16* proj, int bh, int g, int jp, int tid) {
    const int b = bh >> 2, hd = bh & 3, d = tid & 63, seg = tid >> 6;
#pragma unroll
    for (int c2 = 0; c2 < 2; ++c2) { const size_t m0 = (size_t)b * SEQ + (4 * g + 2 * jp + c2) * 64;
#pragma unroll
        for (int i = 0; i < 8; ++i) { const size_t mr = (m0 + seg * 8 + i) * PW; r.la[c2][i] = proj[mr + C_Z + hd * 64 + d]; r.qv[c2][i] = proj[mr + C_GQ + hd * 64 + d]; r.kv[c2][i] = proj[mr + C_GK + hd * 64 + d]; }
#pragma unroll
        for (int i = 0; i < 2; ++i) { const int idx = tid + NTHR * i; r.v[c2][i] = *(const u32x4*)(proj + (m0 + (idx >> 4)) * PW + C_GV + hd * 128 + (idx & 15) * 8); } }
}
__device__ __forceinline__ void gla_kv_group(LAS unsigned char* lds, const bf16* proj, const float* b_a2, bf16* KV, bf16* KVG, float* DECG, int bh, int g, int tid, int lane, int wave, const GlaRaw& r0) {
    const int b = bh >> 2, hd = bh & 3;
    LAS float* decP = (LAS float*)(lds + GLA_DECP);
    const int et = wave >> 1, dt = wave & 1, l31 = lane & 31, hh = lane >> 5, i16 = lane & 15, g16 = (lane >> 4) & 1, tq = i16 >> 2, tp = i16 & 3;
    const int d = tid & 63, seg = tid >> 6;
    const float zb = b_a2[hd * 64 + d];
    f32x16 grp; float gdec = 1.f;
#pragma unroll
    for (int r = 0; r < 16; ++r) grp[r] = 0.f;
    GlaRaw r1; gla_kv_load(r1, proj, bh, g, 1, tid);
#pragma unroll
    for (int jp = 0; jp < 2; ++jp) {
        float la[2][8], qv[2][8], kv[2][8]; u32x4 vld[2][2];
#pragma unroll
        for (int c2 = 0; c2 < 2; ++c2) {
#pragma unroll
            for (int i = 0; i < 8; ++i) { la[c2][i] = bf2f(jp ? r1.la[c2][i] : r0.la[c2][i]); qv[c2][i] = bf2f(jp ? r1.qv[c2][i] : r0.qv[c2][i]) * 0.125f; kv[c2][i] = bf2f(jp ? r1.kv[c2][i] : r0.kv[c2][i]); }
#pragma unroll
            for (int i = 0; i < 2; ++i) vld[c2][i] = jp ? r1.v[c2][i] : r0.v[c2][i]; }
#pragma unroll
        for (int c2 = 0; c2 < 2; ++c2) { LAS float* segtot = (LAS float*)(lds + GLA_SEG + 2048 * c2);
#pragma unroll
            for (int i = 0; i < 8; ++i) la[c2][i] = logsig16(la[c2][i] + zb);
#pragma unroll
            for (int i = 1; i < 8; ++i) la[c2][i] += la[c2][i - 1];
            segtot[seg * 64 + d] = la[c2][7]; }
        __syncthreads();
#pragma unroll
        for (int c2 = 0; c2 < 2; ++c2) { const int jn = 2 * jp + c2;
            LAS unsigned char* vS = lds + GLA_CH * jn; LAS unsigned char* qdS = vS + GLA_QD; LAS unsigned char* kdS = vS + GLA_KD;
            LAS unsigned char* k2T = lds + GLA_K2T + 8192 * c2; LAS float* segtot = (LAS float*)(lds + GLA_SEG + 2048 * c2); LAS float* decL = (LAS float*)(lds + GLA_DECL + 256 * c2);
            float pre = 0.f, tot = 0.f;
#pragma unroll
            for (int s = 0; s < 8; ++s) { const float v = segtot[s * 64 + d]; tot += v; pre += (s < seg) ? v : 0.f; }
            u32x4 w; float e[8]; const float etot = __expf(tot);
#pragma unroll
            for (int i = 0; i < 8; ++i) { const int t = seg * 8 + i; const float bb = pre + la[c2][i]; const float en = __expf(-bb);
                e[i] = kv[c2][i] * en * etot;
                *(LAS bf16*)(qdS + off128(t, d >> 3) + (d & 7) * 2) = (bf16)f2bf(qv[c2][i] * __expf(bb));
                *(LAS bf16*)(kdS + off128(t, d >> 3) + (d & 7) * 2) = (bf16)f2bf(kv[c2][i] * en); }
            w.x = cvtpk(e[0], e[1]); w.y = cvtpk(e[2], e[3]); w.z = cvtpk(e[4], e[5]); w.w = cvtpk(e[6], e[7]);
            *(LAS u32x4*)(k2T + off128(d, seg)) = w;
            if (seg == 0) { decL[d] = etot; decP[jn * 64 + d] = etot; }
#pragma unroll
            for (int i = 0; i < 2; ++i) { const int idx = tid + NTHR * i; *(LAS u32x4*)(vS + off256(idx >> 4, idx & 15)) = vld[c2][i]; } }
        __syncthreads();
#pragma unroll
        for (int c2 = 0; c2 < 2; ++c2) { const int jn = 2 * jp + c2; const size_t unit = (size_t)(bh * 32 + 4 * g + jn);
            LAS unsigned char* vS = lds + GLA_CH * jn; LAS unsigned char* k2T = lds + GLA_K2T + 8192 * c2; LAS float* decL = (LAS float*)(lds + GLA_DECL + 256 * c2);
            f32x16 acc;
#pragma unroll
            for (int r = 0; r < 16; ++r) acc[r] = 0.f;
#pragma unroll
            for (int kk = 0; kk < 4; ++kk) {
                const int kb = 16 * kk + 8 * hh;
                const int ch = et * 4 + 2 * g16 + (tp >> 1);
                const bf16x8 af = cat8(tr_read(vS + off256(kb + tq, ch) + 8 * (tp & 1)), tr_read(vS + off256(kb + 4 + tq, ch) + 8 * (tp & 1)));
                const bf16x8 bfr = *(const LAS bf16x8*)(k2T + off128(dt * 32 + l31, 2 * kk + hh));
                acc = mfma32(af, bfr, acc);
            }
            const float dcl = decL[dt * 32 + l31];
            __builtin_amdgcn_sched_barrier(0);
            asm volatile("s_nop 15\n\ts_nop 15" ::: "memory");
            __builtin_amdgcn_sched_barrier(0);
            if (jn < 3 || g < 7) {
                bf16* sp = KV + unit * 8192 + (dt * 32 + l31) * 128 + et * 32 + 4 * hh;
#pragma unroll
                for (int gq = 0; gq < 4; ++gq) { u32x2 w; w.x = cvtpk(acc[4 * gq], acc[4 * gq + 1]); w.y = cvtpk(acc[4 * gq + 2], acc[4 * gq + 3]); *(u32x2*)(sp + 8 * gq) = w; }
            }
#pragma unroll
            for (int r = 0; r < 16; ++r) grp[r] = dcl * grp[r] + acc[r];
            gdec *= dcl; }
        __syncthreads();
    }
    {
        bf16* sp = KVG + (size_t)(bh * 8 + g) * 8192 + (dt * 32 + l31) * 128 + et * 32 + 4 * hh;
#pragma unroll
        for (int gq = 0; gq < 4; ++gq) { u32x2 w; w.x = cvtpk(grp[4 * gq], grp[4 * gq + 1]); w.y = cvtpk(grp[4 * gq + 2], grp[4 * gq + 3]); *(u32x2*)(sp + 8 * gq) = w; }
        if (et == 0 && hh == 0) DECG[(size_t)(bh * 8 + g) * 64 + dt * 32 + l31] = gdec;
    }
}

__device__ __forceinline__ void gla_out_block(LAS unsigned char* lds, const bf16* proj, const bf16* KV, const bf16* KVG, const float* DECG, const float* gn, bf16* o, int bh, int g, int tid, int lane, int wave) {
    const int b = bh >> 2, hd = bh & 3, n0 = 4 * g;
    LAS unsigned char* sS = lds + GLA_S; LAS float* ssq = (LAS float*)(lds + GLA_SSQ); LAS float* decP = (LAS float*)(lds + GLA_DECP);
    const int et = wave >> 1, tt = wave & 1, l31 = lane & 31, hh = lane >> 5, i16 = lane & 15, g16 = (lane >> 4) & 1, tq = i16 >> 2, tp = i16 & 3;
    const int srow = tid >> 4, sch = tid & 15;
    u32x4 kvn[2]; u32x2 gate[4];
#define GLA_LOAD(JN) do { const int n_ = n0 + (JN); const size_t m0_ = (size_t)b * SEQ + n_ * 64; const size_t unit_ = (size_t)(bh * 32 + n_); \
        _Pragma("unroll") for (int i = 0; i < 2; ++i) kvn[i] = ((JN) < 3) ? *(const u32x4*)(KV + unit_ * 8192 + (srow + 32 * i) * 128 + sch * 8) : (u32x4){0u, 0u, 0u, 0u}; \
        _Pragma("unroll") for (int gq = 0; gq < 4; ++gq) gate[gq] = *(const u32x2*)(proj + (m0_ + tt * 32 + l31) * PW + C_GG + hd * 128 + et * 32 + 8 * gq + 4 * hh); } while (0)
    GLA_LOAD(0);
    f32x4 gnv[4];
#pragma unroll
    for (int gq = 0; gq < 4; ++gq) gnv[gq] = *(const f32x4*)(gn + hd * 128 + et * 32 + 4 * hh + 8 * gq);
    float sst[2][8];
#pragma unroll
    for (int i = 0; i < 2; ++i)
#pragma unroll
        for (int j = 0; j < 8; ++j) sst[i][j] = 0.f;
    {
        u32x4 kvl[7][2]; float dcl[7][2];
#pragma unroll
        for (int m = 0; m < 7; ++m)
#pragma unroll
            for (int i = 0; i < 2; ++i) { const size_t u = (size_t)(bh * 8 + m);
                kvl[m][i] = (m < g) ? *(const u32x4*)(KVG + u * 8192 + (srow + 32 * i) * 128 + sch * 8) : (u32x4){0u, 0u, 0u, 0u};
                dcl[m][i] = (m < g) ? DECG[u * 64 + srow + 32 * i] : 1.f; }
#pragma unroll
        for (int m = 0; m < 7; ++m)
#pragma unroll
            for (int i = 0; i < 2; ++i)
#pragma unroll
                for (int w = 0; w < 4; ++w) { sst[i][2 * w] = dcl[m][i] * sst[i][2 * w] + lo_bf(kvl[m][i][w]); sst[i][2 * w + 1] = dcl[m][i] * sst[i][2 * w + 1] + hi_bf(kvl[m][i][w]); }
    }
#pragma unroll 1
    for (int jn = 0; jn < 4; ++jn) {
        const int n = n0 + jn;
        const size_t mt = (size_t)b * SEQ + n * 64 + tt * 32 + l31;
        LAS unsigned char* vS = lds + GLA_CH * jn; LAS unsigned char* qdS = vS + GLA_QD; LAS unsigned char* kdS = vS + GLA_KD;
#pragma unroll
        for (int i = 0; i < 2; ++i) { u32x4 sw; sw.x = cvtpk(sst[i][0], sst[i][1]); sw.y = cvtpk(sst[i][2], sst[i][3]); sw.z = cvtpk(sst[i][4], sst[i][5]); sw.w = cvtpk(sst[i][6], sst[i][7]);
            *(LAS u32x4*)(sS + off256(srow + 32 * i, sch)) = sw; }
        __syncthreads();
        if (jn < 3) {
#pragma unroll
            for (int i = 0; i < 2; ++i) { const float dc = decP[jn * 64 + srow + 32 * i];
#pragma unroll
                for (int w = 0; w < 4; ++w) { sst[i][2 * w] = dc * sst[i][2 * w] + lo_bf(kvn[i][w]); sst[i][2 * w + 1] = dc * sst[i][2 * w + 1] + hi_bf(kvn[i][w]); } }
        }
        u32x2 gcur[4];
#pragma unroll
        for (int gq = 0; gq < 4; ++gq) gcur[gq] = gate[gq];
        if (jn < 3) GLA_LOAD(jn + 1);
        bf16x8 qf[4];
#pragma unroll
        for (int kk = 0; kk < 4; ++kk) qf[kk] = *(const LAS bf16x8*)(qdS + off128(tt * 32 + l31, 2 * kk + hh));
        f32x16 ot;
#pragma unroll
        for (int r = 0; r < 16; ++r) ot[r] = 0.f;
        const int chv = et * 4 + 2 * g16 + (tp >> 1), sub = 8 * (tp & 1);
#pragma unroll
        for (int kk = 0; kk < 4; ++kk) { const int kb = 16 * kk + 8 * hh;
            const bf16x8 af = cat8(tr_read(sS + off256(kb + tq, chv) + sub), tr_read(sS + off256(kb + 4 + tq, chv) + sub));
            ot = mfma32(af, qf[kk], ot); }
#pragma unroll
        for (int st = 0; st < 2; ++st) {
            if (st <= tt) {
                f32x16 at;
#pragma unroll
                for (int r = 0; r < 16; ++r) at[r] = 0.f;
#pragma unroll
                for (int kk = 0; kk < 4; ++kk) { const bf16x8 kf = *(const LAS bf16x8*)(kdS + off128(st * 32 + l31, 2 * kk + hh)); at = mfma32(kf, qf[kk], at); }
                if (st == tt) {
#pragma unroll
                    for (int r = 0; r < 16; ++r) { const int sr = (r & 3) + 8 * (r >> 2) + 4 * hh; at[r] = (sr <= l31) ? at[r] : 0.f; }
                }
#pragma unroll
                for (int s2 = 0; s2 < 2; ++s2) { const bf16x8 pf = pack8(at, s2); const int kb = 32 * st + 16 * s2 + 4 * hh;
                    const bf16x8 vf = cat8(tr_read(vS + off256(kb + tq, chv) + sub), tr_read(vS + off256(kb + 8 + tq, chv) + sub));
                    ot = mfma32(vf, pf, ot); }
            }
        }
        float ss = 0.f;
#pragma unroll
        for (int r = 0; r < 16; ++r) ss += ot[r] * ot[r];
        ss = sum32(ss);
        if (hh == 0) ssq[et * 64 + tt * 32 + l31] = ss;
        __syncthreads();
        const int tl = tt * 32 + l31;
        const float rinv = rsqrtf(((ssq[tl] + ssq[64 + tl]) + (ssq[128 + tl] + ssq[192 + tl])) * (1.f / 128.f) + EPS);
        bf16* op = o + mt * D + hd * 128 + et * 32 + 4 * hh;
#pragma unroll
        for (int gq = 0; gq < 4; ++gq) { const f32x4 gg = gnv[gq];
            const float g0 = lo_bf(gcur[gq].x), g1 = hi_bf(gcur[gq].x), g2 = lo_bf(gcur[gq].y), g3 = hi_bf(gcur[gq].y);
            u32x2 w; w.x = cvtpk(ot[4 * gq] * rinv * gg.x * silu_f(g0), ot[4 * gq + 1] * rinv * gg.y * silu_f(g1)); w.y = cvtpk(ot[4 * gq + 2] * rinv * gg.z * silu_f(g2), ot[4 * gq + 3] * rinv * gg.w * silu_f(g3));
            *(u32x2*)(op + 8 * gq) = w; }
        __syncthreads();
    }
#undef GLA_LOAD
}
constexpr int NPH = 10;
__global__ void __launch_bounds__(NTHR, 2) mk_fwd(Args a) {
    extern __shared__ __attribute__((aligned(16))) unsigned char lds_raw[];
    LAS unsigned char* lds = (LAS unsigned char*)lds_raw;
    volatile LAS unsigned* MISC = (volatile LAS unsigned*)(lds + MISC_OFF);
    const int tid = threadIdx.x, lane = tid & 63, wave = __builtin_amdgcn_readfirstlane(tid >> 6), blk = blockIdx.x;
    if (tid < 128) MISC[tid] = 0u;
    __syncthreads();
    unsigned char* ws = a.ws;
    unsigned* ctl = (unsigned*)(ws + WS_CTL);
    const int lo = a.ph_lo, hi = a.ph_hi;
    XcdBarrier bar = xcd_barrier_post(ctl + CW_BAR + lo * XCD_BAR_WORDS, MISC);
#define IN(k) (lo <= (k) && (k) < hi)
#define SEAM(k) do { if (IN(k) && IN((k) + 1)) xcd_barrier(bar); } while (0)
    LAS int* tp = (LAS int*)(lds + 132096);

    if (IN(0)) {
        TrItem t0; f32x4 tv[8]; const int it0 = blk * NWAVES + wave; const bool h0 = it0 < 16 * 72 + 16 * 32 && tr_decode(it0, a, t0);
        if (h0) tr_load(t0, tv, lane);
        p0_adaln(lds, (const float*)a.in[1], (const float*)a.in[3], (const float*)a.in[4], (float*)(ws + WS_MODP), blk, tid);
        p0_weights(lds, a, blk, wave, lane, tid);
        if (h0) tr_finish(t0, tv, (LAS float*)(lds + 65536 + wave * 8704), lane);
    }
    f32x4 xa[4], xb[4];
    if (IN(1)) {
        const float* x = (const float*)a.in[0]; const size_t mb = (size_t)blk * 64 + wave;
#pragma unroll
        for (int j = 0; j < 4; ++j) { xa[j] = *(const f32x4*)(x + mb * D + 4 * lane + 256 * j); xb[j] = *(const f32x4*)(x + (mb + NWAVES) * D + 4 * lane + 256 * j); }
    }
    SEAM(0);
    if (IN(1)) p1a_rows(lds, a, blk, wave, lane, tid, xa, xb);
    SEAM(1);
    if (IN(2)) {
        pg8::DenseOrder S; S.init(ws + WS_H, ws + WS_WIN, M, PW, D, GRID, blk);
        pg8::EpiBf16 E{(bf16*)(ws + WS_PROJ), PW};
        constexpr int TG0 = 16 * 72 + 16 * 32, TG1 = TG0 + 32 * 2 * 128, TGM = TG0 + 32 * 128;
        if (blk >= 128) { tr_stream(lds, a, TG0, TGM, (blk - 128) * NWAVES + wave, 128 * NWAVES, wave, lane); __syncthreads(); }
        pg8::gemm_phase<pg8::EpiBf16, pg8::DenseOrder, true>(lds, D, S, E);
        if (blk >= 128) tr_stream(lds, a, TGM, TG1, (blk - 128) * NWAVES + wave, 128 * NWAVES, wave, lane);
    }
    SEAM(2);
    if (IN(3)) {
        const bf16* proj = (const bf16*)(ws + WS_PROJ); bf16* o = (bf16*)(ws + WS_O);
        GlaRaw r0; gla_kv_load(r0, proj, blk >> 3, blk & 7, 0, tid);
        swa_unit(lds, proj, (const float*)(ws + WS_ROPE), (const float*)a.in[10], o, blk, tid, lane, wave);
        gla_kv_group(lds, proj, (const float*)a.in[8], (bf16*)(ws + WS_SG), (bf16*)(ws + WS_KVG), (float*)(ws + WS_DECG), blk >> 3, blk & 7, tid, lane, wave, r0);
    }
    SEAM(3);
    if (IN(4)) {
        const bf16* proj = (const bf16*)(ws + WS_PROJ); bf16* o = (bf16*)(ws + WS_O);
        gla_out_block(lds, proj, (const bf16*)(ws + WS_SG), (const bf16*)(ws + WS_KVG), (const float*)(ws + WS_DECG), (const float*)a.in[9], o, blk >> 3, blk & 7, tid, lane, wave);
    }
    SEAM(4);
    if (IN(5)) {
        pg8::DenseOrder S; S.init(ws + WS_O, ws + WS_WOUT, M, D, D, GRID, blk);
        pg8::EpiX1 E{(const float*)a.in[0], (bf16*)(ws + WS_X1), (const float*)(ws + WS_MOD)};
        pg8::gemm_phase<pg8::EpiX1, pg8::DenseOrder, false>(lds, D, S, E);
    }
    RouteFrags rf;
    if (IN(6)) p3b_pre(lds, a, blk, wave, lane, tid, rf);
    SEAM(5);
    if (IN(6)) p3b_route(lds, a, blk, wave, lane, tid, rf);
    SEAM(6);
    if (IN(7)) {
        moe_prefix(tp, (const int*)ctl + CW_CNT, tid);
        pg8::MoeOrder<true> S; S.A = (const char*)(ws + WS_H); S.Bt = (const char*)(ws + WS_WGU); S.K = D; S.npn = 2; S.G = GRID; S.c = blk; S.bstride = (size_t)512 * D * 2;
        S.tp = tp; S.cnt = (const int*)ctl + CW_CNT; S.list = (const int*)(ws + WS_ROUTE);
        pg8::EpiAct E{(bf16*)(ws + WS_PROJ), (const int*)ctl + CW_CNT, (const float*)(ws + WS_ROUTE + 2 * MiB), tp};
        pg8::gemm_phase<pg8::EpiAct, pg8::MoeOrder<true>, true>(lds, D, S, E);
        if (blk >= 128) tr_stream(lds, a, 16 * 72 + 16 * 32 + 32 * 2 * 128, 16 * 72 + 16 * 32 + 32 * 2 * 128 + 32 * 128, (blk - 128) * NWAVES + wave, 128 * NWAVES, wave, lane);
    }
    SEAM(7);
    if (IN(8)) {
        pg8::MoeOrder<false> S; S.A = (const char*)(ws + WS_PROJ); S.Bt = (const char*)(ws + WS_WD); S.K = 256; S.npn = 4; S.G = GRID; S.c = blk; S.bstride = (size_t)D * 256 * 2;
        S.tp = tp; S.cnt = (const int*)ctl + CW_CNT; S.list = (const int*)(ws + WS_ROUTE);
        pg8::EpiDown E{(bf16*)(ws + WS_Y2), (const int*)ctl + CW_CNT, (const int*)(ws + WS_ROUTE), tp};
        pg8::gemm_phase<pg8::EpiDown, pg8::MoeOrder<false>, true>(lds, 256, S, E);
    }
    SEAM(8);
    if (IN(9)) p6_final(lds, a, blk, wave, lane, tid);
#undef IN
#undef SEAM
}

extern "C" void kernel_launch(void* const* d_in, const int* in_sizes, int n_in, void* d_out, int out_size, void* d_ws, size_t ws_size, hipStream_t stream) {
    static int grid = 0;
    if (grid == 0) {
        if (n_in != 21 || in_sizes[0] != M * D || out_size != M * D || ws_size < WS_END) { fprintf(stderr, "kernel_launch: unexpected shapes (n_in %d, in0 %d, out %d, ws %zu)\n", n_in, n_in > 0 ? in_sizes[0] : -1, out_size, ws_size); grid = -1; return; }
        int dev = 0, cus = 0, per_cu = 0;
        if (hipGetDevice(&dev) != hipSuccess || hipDeviceGetAttribute(&cus, hipDeviceAttributeMultiprocessorCount, dev) != hipSuccess) { fprintf(stderr, "kernel_launch: device query failed\n"); grid = -1; return; }
        if (hipFuncSetAttribute((const void*)mk_fwd, hipFuncAttributeMaxDynamicSharedMemorySize, LDS_BYTES) != hipSuccess) { fprintf(stderr, "kernel_launch: hipFuncSetAttribute failed\n"); grid = -1; return; }
        if (hipOccupancyMaxActiveBlocksPerMultiprocessor(&per_cu, (const void*)mk_fwd, NTHR, LDS_BYTES) != hipSuccess || per_cu < 1) { fprintf(stderr, "kernel_launch: occupancy query says %d workgroups per CU\n", per_cu); grid = -1; return; }
        if (cus * per_cu < GRID) { fprintf(stderr, "kernel_launch: needs %d co-resident workgroups, device holds %d x %d\n", GRID, cus, per_cu); grid = -1; return; }
        grid = GRID;
    }
    if (grid < 0) return;
    (void)hipMemsetAsync((char*)d_ws + WS_CTL, 0, CTL_ZERO_BYTES, stream);
    Args a{};
    for (int i = 0; i < 21; ++i) a.in[i] = d_in[i];
    a.out = (float*)d_out; a.ws = (unsigned char*)d_ws;
    for (int i = 0; i < 8; ++i) a.rt.inv_freq[i] = (float)pow(500000.0, -(double)(2 * i) / 16.0);
    a.ph_lo = 0; a.ph_hi = NPH;
    void* args[] = {&a};
    const hipError_t e = hipLaunchCooperativeKernel((const void*)mk_fwd, dim3(GRID), dim3(NTHR), args, LDS_BYTES, stream);
    if (e != hipSuccess) fprintf(stderr, "kernel_launch: cooperative launch failed: %s\n", hipGetErrorString(e));
}
```
